# Optimizing an MI355X kernel written in HIP

```python
import math
import jax, jax.numpy as jnp
from jax import lax
import numpy as np

D_MODEL = 2048
BATCH = 8
SEQ = 2048
DEPTH = 2

A_HEADS = 8
A_HALF_DIM = 64
A_V_DIM = 2 * A_HALF_DIM
B_HEADS = 8
B_NOPE_DIM = 128
B_ROPE_DIM = 64
B_QK_DIM = B_NOPE_DIM + B_ROPE_DIM
B_V_DIM = 128
B_Q_RANK = 512
B_KV_RANK = 256
ROPE_THETA = 10000.0
REL_BUCKETS = 32
REL_MAX_DIST = 128
D_FF = 5632
Q_BLOCK = 128
EPS = 1e-6

N_EVEN = (DEPTH + 1) // 2
N_ODD = DEPTH // 2

A_Q_W = A_HEADS * 2 * A_HALF_DIM
A_K_W = A_HEADS * 2 * A_HALF_DIM
A_V_W = A_HEADS * A_V_DIM
ATTN_IN_W = A_Q_W + A_K_W + A_V_W + B_Q_RANK + B_KV_RANK + B_ROPE_DIM
ATTN_OUT_W = A_HEADS * A_V_DIM + B_HEADS * B_V_DIM
ATTN_SPLITS = [A_Q_W, A_Q_W + A_K_W, A_Q_W + A_K_W + A_V_W,
               A_Q_W + A_K_W + A_V_W + B_Q_RANK,
               A_Q_W + A_K_W + A_V_W + B_Q_RANK + B_KV_RANK]

kernel_name = "hybrid_diffattn_mla_shortconv_encoder"


def rms_norm(x, g):
    xf = x.astype(jnp.float32)
    y = xf * lax.rsqrt(jnp.mean(xf * xf, axis=-1, keepdims=True) + EPS)
    return (y * g.astype(jnp.float32)).astype(x.dtype)


def dwconv3(x, w, b=None):
    xp = jnp.pad(x, ((0, 0), (1, 1), (0, 0)))
    y = w[0] * xp[:, :-2] + w[1] * xp[:, 1:-1] + w[2] * xp[:, 2:]
    return y if b is None else y + b


def t5_bucket(rel):
    nb = REL_BUCKETS // 2
    max_exact = nb // 2
    bucket = jnp.where(rel > 0, nb, 0).astype(jnp.int32)
    n = jnp.abs(rel)
    nf = jnp.maximum(n, max_exact).astype(jnp.float32)
    large = max_exact + (jnp.log(nf / max_exact) / math.log(REL_MAX_DIST / max_exact)
                         * (nb - max_exact)).astype(jnp.int32)
    large = jnp.minimum(large, nb - 1)
    return bucket + jnp.where(n < max_exact, n, large)


def rope_cos_sin(positions):
    inv = 1.0 / (ROPE_THETA ** (jnp.arange(0, B_ROPE_DIM, 2, dtype=jnp.float32) / B_ROPE_DIM))
    ang = positions.astype(jnp.float32)[..., None] * inv
    return jnp.cos(ang), jnp.sin(ang)


def apply_rope(x, cos, sin):
    x1, x2 = jnp.split(x.astype(jnp.float32), 2, axis=-1)
    return jnp.concatenate([x1 * cos - x2 * sin, x2 * cos + x1 * sin], axis=-1).astype(x.dtype)


def diff_attention(q, k, v, positions, rel_table, lam):
    b, h, _, s, dh = q.shape
    nblk = s // Q_BLOCK
    qb = jnp.moveaxis(q.reshape(b, h, 2, nblk, Q_BLOCK, dh), 3, 0)
    starts = jnp.arange(nblk, dtype=jnp.int32) * Q_BLOCK
    scale = dh ** -0.5

    def one_block(args):
        q_blk, start = args
        q_pos = lax.dynamic_slice_in_dim(positions, start, Q_BLOCK, axis=1)
        rel = positions[:, None, :] - q_pos[:, :, None]
        bias = jnp.moveaxis(rel_table[t5_bucket(rel)], -1, 1)
        logits = (jnp.einsum('bhjqd,bhjkd->bhjqk', q_blk, k).astype(jnp.float32) * scale
                  + bias[:, :, None].astype(jnp.float32))
        p = jax.nn.softmax(logits, axis=-1)
        w = p[:, :, 0] - lam * p[:, :, 1]
        return jnp.einsum('bhqk,bhkd->bhqd', w.astype(v.dtype), v)

    out = lax.map(one_block, (qb, starts))
    return jnp.moveaxis(out, 0, 2).reshape(b, h, s, -1)


def mla_attention(q, k, v):
    b, h, s, dqk = q.shape
    nblk = s // Q_BLOCK
    qb = jnp.moveaxis(q.reshape(b, h, nblk, Q_BLOCK, dqk), 2, 0)
    scale = dqk ** -0.5

    def one_block(q_blk):
        logits = jnp.einsum('bhqd,bhkd->bhqk', q_blk, k).astype(jnp.float32) * scale
        p = jax.nn.softmax(logits, axis=-1)
        return jnp.einsum('bhqk,bhkd->bhqd', p.astype(v.dtype), v)

    out = lax.map(one_block, qb)
    return jnp.moveaxis(out, 0, 2).reshape(b, h, s, -1)


def attn_mixer(h, positions, cos, sin, rel_table, layer_idx, w_in, dq_g, dk_g,
               lq1, lk1, lq2, lk2, subln_g, q_a_g, w_uq, kv_a_g, w_ukv, mq_g, mk_g, w_out):
    b, s, _ = h.shape
    aq, ak, av, cq, ckv, kr = jnp.split(h @ w_in, ATTN_SPLITS, axis=-1)

    aq = rms_norm(aq.reshape(b, s, A_HEADS, 2, A_HALF_DIM), dq_g).transpose(0, 2, 3, 1, 4)
    ak = rms_norm(ak.reshape(b, s, A_HEADS, 2, A_HALF_DIM), dk_g).transpose(0, 2, 3, 1, 4)
    av = av.reshape(b, s, A_HEADS, A_V_DIM).transpose(0, 2, 1, 3)
    lam_init = 0.8 - 0.6 * math.exp(-0.3 * layer_idx)
    lam = (jnp.exp(jnp.sum(lq1.astype(jnp.float32) * lk1.astype(jnp.float32)))
           - jnp.exp(jnp.sum(lq2.astype(jnp.float32) * lk2.astype(jnp.float32))) + lam_init)
    oa = diff_attention(aq, ak, av, positions, rel_table, lam)
    oa = rms_norm(oa, subln_g) * (1.0 - lam_init)
    oa = oa.transpose(0, 2, 1, 3).reshape(b, s, A_HEADS * A_V_DIM)

    q = (rms_norm(cq, q_a_g) @ w_uq).reshape(b, s, B_HEADS, B_QK_DIM)
    q = rms_norm(q, mq_g)
    q = jnp.concatenate([q[..., :B_NOPE_DIM],
                         apply_rope(q[..., B_NOPE_DIM:], cos[:, :, None], sin[:, :, None])], axis=-1)
    kv = (rms_norm(ckv, kv_a_g) @ w_ukv).reshape(b, s, B_HEADS, B_NOPE_DIM + B_V_DIM)
    k_nope, vb = jnp.split(kv, [B_NOPE_DIM], axis=-1)
    k_rope = jnp.broadcast_to(kr[:, :, None, :], (b, s, B_HEADS, B_ROPE_DIM))
    k = rms_norm(jnp.concatenate([k_nope, k_rope], axis=-1), mk_g)
    k = jnp.concatenate([k[..., :B_NOPE_DIM],
                         apply_rope(k[..., B_NOPE_DIM:], cos[:, :, None], sin[:, :, None])], axis=-1)
    ob = mla_attention(q.transpose(0, 2, 1, 3), k.transpose(0, 2, 1, 3), vb.transpose(0, 2, 1, 3))
    ob = ob.transpose(0, 2, 1, 3).reshape(b, s, B_HEADS * B_V_DIM)

    return jnp.concatenate([oa, ob], axis=-1) @ w_out


def short_conv_mixer(h, w_in, conv_w, w_out):
    bg, cg, hv = jnp.split(h @ w_in, 3, axis=-1)
    return (bg * dwconv3(cg * hv, conv_w)) @ w_out


def conv_ffn(h, w_gate, w_up, dw_w, dw_b, w_down):
    g = dwconv3(h @ w_gate, dw_w, dw_b)
    return (jax.nn.silu(g) * (h @ w_up)) @ w_down


def setup_inputs(seed: int = 0) -> dict:
    key = jax.random.key(seed)
    ks = iter(jax.random.split(key, 40))

    def dense(shape):
        return jax.random.normal(next(ks), shape, jnp.float32) * (shape[-2] ** -0.5)

    def gain(shape):
        return 1.0 + 0.02 * jax.random.normal(next(ks), shape, jnp.float32)

    def small(shape, scale):
        return scale * jax.random.normal(next(ks), shape, jnp.float32)

    x = jax.random.normal(next(ks), (BATCH, SEQ, D_MODEL), jnp.float32)
    positions = (jnp.arange(SEQ, dtype=jnp.int32)[None, :]
                 + jax.random.randint(next(ks), (BATCH, 1), 0, SEQ, dtype=jnp.int32))
    return {
        "x": x,
        "positions": positions,
        "rel_bias_table": small((REL_BUCKETS, A_HEADS), 0.2),
        "attn_norm_g": gain((N_EVEN, D_MODEL)),
        "attn_w_in": dense((N_EVEN, D_MODEL, ATTN_IN_W)),
        "diff_q_norm_g": gain((N_EVEN, A_HALF_DIM)),
        "diff_k_norm_g": gain((N_EVEN, A_HALF_DIM)),
        "diff_lambda_q1": small((N_EVEN, A_HALF_DIM), 0.1),
        "diff_lambda_k1": small((N_EVEN, A_HALF_DIM), 0.1),
        "diff_lambda_q2": small((N_EVEN, A_HALF_DIM), 0.1),
        "diff_lambda_k2": small((N_EVEN, A_HALF_DIM), 0.1),
        "diff_subln_g": gain((N_EVEN, A_V_DIM)),
        "mla_q_a_norm_g": gain((N_EVEN, B_Q_RANK)),
        "mla_w_uq": dense((N_EVEN, B_Q_RANK, B_HEADS * B_QK_DIM)),
        "mla_kv_a_norm_g": gain((N_EVEN, B_KV_RANK)),
        "mla_w_ukv": dense((N_EVEN, B_KV_RANK, B_HEADS * (B_NOPE_DIM + B_V_DIM))),
        "mla_q_norm_g": gain((N_EVEN, B_QK_DIM)),
        "mla_k_norm_g": gain((N_EVEN, B_QK_DIM)),
        "attn_w_out": dense((N_EVEN, ATTN_OUT_W, D_MODEL)),
        "conv_norm_g": gain((N_ODD, D_MODEL)),
        "conv_w_in": dense((N_ODD, D_MODEL, 3 * D_MODEL)),
        "conv_w": jax.random.normal(next(ks), (N_ODD, 3, D_MODEL), jnp.float32) * (3 ** -0.5),
        "conv_w_out": dense((N_ODD, D_MODEL, D_MODEL)),
        "ffn_norm_g": gain((DEPTH, D_MODEL)),
        "ffn_w_gate": dense((DEPTH, D_MODEL, D_FF)),
        "ffn_w_up": dense((DEPTH, D_MODEL, D_FF)),
        "ffn_dwconv_w": jax.random.normal(next(ks), (DEPTH, 3, D_FF), jnp.float32) * (3 ** -0.5),
        "ffn_dwconv_b": small((DEPTH, D_FF), 0.02),
        "ffn_w_down": dense((DEPTH, D_FF, D_MODEL)),
    }


def reference(x, positions, rel_bias_table, attn_norm_g, attn_w_in, diff_q_norm_g, diff_k_norm_g,
              diff_lambda_q1, diff_lambda_k1, diff_lambda_q2, diff_lambda_k2, diff_subln_g,
              mla_q_a_norm_g, mla_w_uq, mla_kv_a_norm_g, mla_w_ukv, mla_q_norm_g, mla_k_norm_g,
              attn_w_out, conv_norm_g, conv_w_in, conv_w, conv_w_out, ffn_norm_g, ffn_w_gate,
              ffn_w_up, ffn_dwconv_w, ffn_dwconv_b, ffn_w_down):
    cos, sin = rope_cos_sin(positions)
    for layer in range(DEPTH):
        i = layer // 2
        if layer % 2 == 0:
            x = x + attn_mixer(rms_norm(x, attn_norm_g[i]), positions, cos, sin, rel_bias_table, layer,
                               attn_w_in[i], diff_q_norm_g[i], diff_k_norm_g[i],
                               diff_lambda_q1[i], diff_lambda_k1[i], diff_lambda_q2[i], diff_lambda_k2[i],
                               diff_subln_g[i], mla_q_a_norm_g[i], mla_w_uq[i], mla_kv_a_norm_g[i],
                               mla_w_ukv[i], mla_q_norm_g[i], mla_k_norm_g[i], attn_w_out[i])
        else:
            x = x + short_conv_mixer(rms_norm(x, conv_norm_g[i]), conv_w_in[i], conv_w[i], conv_w_out[i])
        x = x + conv_ffn(rms_norm(x, ffn_norm_g[layer]), ffn_w_gate[layer], ffn_w_up[layer],
                         ffn_dwconv_w[layer], ffn_dwconv_b[layer], ffn_w_down[layer])
    return x
```

```cpp
#include <hip/hip_runtime.h>
#include <hip/hip_cooperative_groups.h>
#include <cstdio>
#include <cstdint>
namespace cg = cooperative_groups;
namespace pg8 {
#define PG8_LAS __attribute__((address_space(3)))
typedef unsigned short bf16_t;
typedef short bf16x8 __attribute__((ext_vector_type(8)));
typedef float f32x4 __attribute__((ext_vector_type(4)));
typedef unsigned u32x4 __attribute__((ext_vector_type(4)));
constexpr int BM = 256, BK = 64, HALF = 128, HTB = HALF * BK * 2  , STAGE_BYTES = 8 * HTB, NXCD = 8, WGM = 8;

__host__ __device__ __forceinline__ int lds_byte(int r, int c) { const int st = (r >> 4) * 2 + (c >> 5), rr = r & 15, cc = c & 31, ob = rr * 64 + cc * 2; return st * 1024 + (ob ^ (((ob >> 9) & 1) << 5)); }
__host__ __device__ __forceinline__ void stage_rc(int b, int& R, int& C) { const int st = b / 1024, sb = b % 1024, swz = sb ^ (((sb >> 9) & 1) << 5); R = (st >> 1) * 16 + swz / 64; C = (st & 1) * 32 + (swz % 64) / 2; }
__host__ __device__ __forceinline__ int perm32(int rho) { const int n = rho >> 4, i = rho & 15; return 8 * (i >> 2) + 4 * n + (i & 3); }

struct Unit { int pm, pn; };
struct Gemm { const bf16_t* A; const bf16_t* Bt; int M, N, K; };

struct StaticOrder {
    int nM, nN, nwg, G, c;
    __host__ __device__ void init(int M, int N, int G_, int c_) { nM = M / BM; nN = N / BM; nwg = nM * nN; G = G_; c = c_; }
    __host__ __device__ bool next(int i, Unit& u) const {
        const long L = (long)i * G + c; if (L >= nwg) return false;
        int wgid = (int)L; { const int q = nwg / NXCD, r = nwg % NXCD, xcd = wgid % NXCD, off = wgid / NXCD; wgid = (xcd < r ? xcd * (q + 1) : r * (q + 1) + (xcd - r) * q) + off; }
        const int nig = WGM * nN, gid = wgid / nig, fm = gid * WGM, gsz = (nM - fm) < WGM ? (nM - fm) : WGM;
        u.pm = fm + ((wgid % nig) % gsz); u.pn = (wgid % nig) / gsz; return true;
    }
    __device__ __forceinline__ void a_ready(const Unit&) const {}
    __device__ __forceinline__ void done(const Unit&) const {}
};


typedef __bf16 bf16x2_t __attribute__((ext_vector_type(2)));
typedef float f32x2_t __attribute__((ext_vector_type(2)));
__device__ __forceinline__ unsigned cvt_pk_bf16(float lo, float hi) { f32x2_t f = {lo, hi}; bf16x2_t r = __builtin_convertvector(f, bf16x2_t); return __builtin_bit_cast(unsigned, r); }
__device__ __forceinline__ float bf_lo(unsigned w) { return __uint_as_float(w << 16); }
__device__ __forceinline__ float bf_hi(unsigned w) { return __uint_as_float(w & 0xffff0000u); }

struct SubsetOrder {
    int n, nN, R, r;
    __device__ __forceinline__ bool next(int i, Unit& u) const { const int k = r + i * R; if (k >= n) return false; u.pm = k / nN; u.pn = k % nN; return true; }
    __device__ __forceinline__ void a_ready(const Unit&) const {}
    __device__ __forceinline__ void done(const Unit&) const {}
};
__device__ __forceinline__ float row_rstd(const float* ss, int row) { return ss ? 1.0f / sqrtf(ss[row] * (1.0f / 2048.0f) + 1e-6f) : 1.0f; }
struct EpiStoreBf16 {
    static constexpr bool PERM = true, AFTER_DRAIN = false;
    bf16_t* O; int ldc; int ncols; const float* ss;
    __device__ __forceinline__ void operator()(f32x4 (&acc)[2][2][4][2], const Unit& u, int wr, int wc, int fr, int fq) const {
        const int row0 = u.pm * BM + wr * 64 + fr; const int col0 = u.pn * BM + wc * 32 + 8 * fq;
        float rs[2][4];
#pragma unroll
        for (int ai = 0; ai < 2; ++ai)
#pragma unroll
            for (int m = 0; m < 4; ++m) rs[ai][m] = row_rstd(ss, row0 + ai * HALF + m * 16);
#pragma unroll
        for (int ai = 0; ai < 2; ++ai)
#pragma unroll
            for (int m = 0; m < 4; ++m) { const int row = row0 + ai * HALF + m * 16; bf16_t* rowp = O + (size_t)row * ldc + col0;
#pragma unroll
                for (int bj = 0; bj < 2; ++bj) { const f32x4 v0 = acc[ai][bj][m][0] * rs[ai][m], v1 = acc[ai][bj][m][1] * rs[ai][m];
                    u32x4 w; w.x = cvt_pk_bf16(v0[0], v0[1]); w.y = cvt_pk_bf16(v0[2], v0[3]); w.z = cvt_pk_bf16(v1[0], v1[1]); w.w = cvt_pk_bf16(v1[2], v1[3]);
                    if (col0 + bj * HALF < ncols) *(u32x4*)(rowp + bj * HALF) = w; } }
    }
};
typedef unsigned u32x2e __attribute__((ext_vector_type(2)));
struct EpiResidF32 {
    static constexpr bool PERM = true, AFTER_DRAIN = false;
    const float* base; float* out; int ldc; bf16_t* xb; float* ss;
    __device__ __forceinline__ void operator()(f32x4 (&acc)[2][2][4][2], const Unit& u, int wr, int wc, int fr, int fq) const {
        const int row0 = u.pm * BM + wr * 64 + fr; const int col0 = u.pn * BM + wc * 32 + 8 * fq;
#pragma unroll
        for (int ai = 0; ai < 2; ++ai)
#pragma unroll
            for (int m = 0; m < 4; ++m) { const size_t off = (size_t)(row0 + ai * HALF + m * 16) * ldc + col0;
#pragma unroll
                for (int bj = 0; bj < 2; ++bj)
#pragma unroll
                    for (int n = 0; n < 2; ++n) acc[ai][bj][m][n] += *(const f32x4*)(base + off + bj * HALF + n * 4);
                if (m == 3) asm volatile("" : "+v"(acc[ai][0][0][0]), "+v"(acc[ai][0][0][1]), "+v"(acc[ai][1][0][0]), "+v"(acc[ai][1][0][1]), "+v"(acc[ai][0][1][0]), "+v"(acc[ai][0][1][1]), "+v"(acc[ai][1][1][0]), "+v"(acc[ai][1][1][1]),
                                             "+v"(acc[ai][0][2][0]), "+v"(acc[ai][0][2][1]), "+v"(acc[ai][1][2][0]), "+v"(acc[ai][1][2][1]), "+v"(acc[ai][0][3][0]), "+v"(acc[ai][0][3][1]), "+v"(acc[ai][1][3][0]), "+v"(acc[ai][1][3][1]) :: "memory"); }
        asm volatile("" ::: "memory");
#pragma unroll
        for (int ai = 0; ai < 2; ++ai)
#pragma unroll
            for (int m = 0; m < 4; ++m) { const int row = row0 + ai * HALF + m * 16; const size_t off = (size_t)row * ldc + col0; float sq = 0.f;
#pragma unroll
                for (int bj = 0; bj < 2; ++bj) { const f32x4 v0 = acc[ai][bj][m][0], v1 = acc[ai][bj][m][1];
                    *(f32x4*)(out + off + bj * HALF) = v0; *(f32x4*)(out + off + bj * HALF + 4) = v1;
                    if (xb) { u32x4 w; w.x = cvt_pk_bf16(v0[0], v0[1]); w.y = cvt_pk_bf16(v0[2], v0[3]); w.z = cvt_pk_bf16(v1[0], v1[1]); w.w = cvt_pk_bf16(v1[2], v1[3]); *(u32x4*)(xb + off + bj * HALF) = w;
                        sq += (v0[0] * v0[0] + v0[1] * v0[1]) + (v0[2] * v0[2] + v0[3] * v0[3]) + (v1[0] * v1[0] + v1[1] * v1[1]) + (v1[2] * v1[2] + v1[3] * v1[3]); } }
                if (xb) { sq += __shfl_xor(sq, 16); sq += __shfl_xor(sq, 32); if (fq == 0) atomicAdd(ss + row, sq); } }
    }
};
struct EpiMulBf16 {
    static constexpr bool PERM = true, AFTER_DRAIN = false;
    bf16_t* O; int ldc; const float* ss;
    __device__ __forceinline__ void operator()(f32x4 (&acc)[2][2][4][2], const Unit& u, int wr, int wc, int fr, int fq) const {
        const int row0 = u.pm * BM + wr * 64 + fr; const int col0 = u.pn * HALF + wc * 32 + 8 * fq;
        float rs[2][4];
#pragma unroll
        for (int ai = 0; ai < 2; ++ai)
#pragma unroll
            for (int m = 0; m < 4; ++m) rs[ai][m] = row_rstd(ss, row0 + ai * HALF + m * 16);
#pragma unroll
        for (int ai = 0; ai < 2; ++ai)
#pragma unroll
            for (int m = 0; m < 4; ++m) { const int row = row0 + ai * HALF + m * 16; bf16_t* rowp = O + (size_t)row * ldc + col0; const float rs2 = rs[ai][m] * rs[ai][m];
                const f32x4 v0 = acc[ai][0][m][0] * acc[ai][1][m][0] * rs2, v1 = acc[ai][0][m][1] * acc[ai][1][m][1] * rs2;
                u32x4 w; w.x = cvt_pk_bf16(v0[0], v0[1]); w.y = cvt_pk_bf16(v0[2], v0[3]); w.z = cvt_pk_bf16(v1[0], v1[1]); w.w = cvt_pk_bf16(v1[2], v1[3]);
                *(u32x4*)rowp = w; }
    }
};
#define PG8_DPP(old_, src_, ctrl_) ((unsigned)__builtin_amdgcn_update_dpp((int)(old_), (int)(src_), (ctrl_), 0xf, 0xf, false))
template <bool SILU> struct EpiConvGate {
    static constexpr bool PERM = true, AFTER_DRAIN = false;
    const bf16_t* G; const float* cw; const float* bias; bf16_t* O; int ldc; int seq; const float* ss;
    __device__ __forceinline__ void operator()(f32x4 (&acc)[2][2][4][2], const Unit& u, int wr, int wc, int fr, int fq) const {
        const int row0 = u.pm * BM + wr * 64 + fr;
        float rs[2][4];
#pragma unroll
        for (int ai = 0; ai < 2; ++ai)
#pragma unroll
            for (int m = 0; m < 4; ++m) rs[ai][m] = row_rstd(ss, row0 + ai * HALF + m * 16);
        u32x4 own[1][4], halo[1];
        const u32x4 z4 = {0u, 0u, 0u, 0u};
#define PG8_ISSUE(g_, buf_) do { const int bj_ = (g_) >> 1, ai_ = (g_) & 1; const int col0_ = u.pn * BM + bj_ * HALF + wc * 32 + 8 * fq; \
            const int rowb_ = row0 + ai_ * HALF; const bf16_t* gp_ = G + (size_t)rowb_ * ldc + col0_; \
            _Pragma("unroll") for (int m_ = 0; m_ < 4; ++m_) own[buf_][m_] = *(const u32x4*)(gp_ + (size_t)(16 * m_) * ldc); \
            const int blk_ = rowb_ - fr; u32x4 hv_ = z4; \
            if (fr == 0) { if ((blk_ & (seq - 1)) != 0) hv_ = *(const u32x4*)(gp_ - ldc); } \
            else if (fr == 15) { if (((blk_ + 64) & (seq - 1)) != 0) hv_ = *(const u32x4*)(gp_ + (size_t)49 * ldc); } \
            halo[buf_] = hv_; } while (0)
#pragma unroll
        for (int g = 0; g < 4; ++g) {
            const int bj = g >> 1, ai = g & 1, buf = 0; const int col0 = u.pn * BM + bj * HALF + wc * 32 + 8 * fq;
            PG8_ISSUE(g, 0);
            float w0[8], w1[8], w2[8], bb[8];
#pragma unroll
            for (int q = 0; q < 2; ++q) { const f32x4 a = *(const f32x4*)(cw + col0 + 4 * q), b = *(const f32x4*)(cw + ldc + col0 + 4 * q), c = *(const f32x4*)(cw + 2 * ldc + col0 + 4 * q);
                const f32x4 d = bias ? *(const f32x4*)(bias + col0 + 4 * q) : (f32x4){0.f, 0.f, 0.f, 0.f};
#pragma unroll
                for (int j = 0; j < 4; ++j) { w0[4 * q + j] = a[j]; w1[4 * q + j] = b[j]; w2[4 * q + j] = c[j]; bb[4 * q + j] = d[j]; } }
#pragma unroll
            for (int m = 0; m < 4; ++m) {
                u32x4 gm, gn; const u32x4 g0 = own[buf][m];
#pragma unroll
                for (int q = 0; q < 4; ++q) {
                    const unsigned oldp = m > 0 ? PG8_DPP(0u, own[buf][m > 0 ? m - 1 : 0][q], 0x121) : halo[buf][q];
                    const unsigned oldn = m < 3 ? PG8_DPP(0u, own[buf][m < 3 ? m + 1 : 3][q], 0x12F) : halo[buf][q];
                    gm[q] = PG8_DPP(oldp, g0[q], 0x111);
                    gn[q] = PG8_DPP(oldn, g0[q], 0x101);
                }
                float r[8];
#pragma unroll
                for (int q = 0; q < 4; ++q) {
                    const float c0 = w0[2 * q] * bf_lo(gm[q]) + w1[2 * q] * bf_lo(g0[q]) + w2[2 * q] * bf_lo(gn[q]) + bb[2 * q];
                    const float c1 = w0[2 * q + 1] * bf_hi(gm[q]) + w1[2 * q + 1] * bf_hi(g0[q]) + w2[2 * q + 1] * bf_hi(gn[q]) + bb[2 * q + 1];
                    float f0 = c0, f1 = c1;
                    if (SILU) { f0 = c0 * __builtin_amdgcn_rcpf(1.0f + __builtin_amdgcn_exp2f(-1.44269504089f * c0)); f1 = c1 * __builtin_amdgcn_rcpf(1.0f + __builtin_amdgcn_exp2f(-1.44269504089f * c1)); }
                    r[2 * q] = f0 * rs[ai][m]; r[2 * q + 1] = f1 * rs[ai][m]; }
                const f32x4 v0 = acc[ai][bj][m][0], v1 = acc[ai][bj][m][1];
                f32x4 pk; pk[0] = __uint_as_float(cvt_pk_bf16(v0[0] * r[0], v0[1] * r[1])); pk[1] = __uint_as_float(cvt_pk_bf16(v0[2] * r[2], v0[3] * r[3]));
                pk[2] = __uint_as_float(cvt_pk_bf16(v1[0] * r[4], v1[1] * r[5])); pk[3] = __uint_as_float(cvt_pk_bf16(v1[2] * r[6], v1[3] * r[7]));
                acc[ai][bj][m][0] = pk;
            }
            asm volatile("" : "+v"(acc[ai][bj][0][0]), "+v"(acc[ai][bj][1][0]), "+v"(acc[ai][bj][2][0]), "+v"(acc[ai][bj][3][0]) :: "memory");
        }
#pragma unroll
        for (int bj = 0; bj < 2; ++bj) {
            const int col0 = u.pn * BM + bj * HALF + wc * 32 + 8 * fq;
#pragma unroll
            for (int ai = 0; ai < 2; ++ai)
#pragma unroll
                for (int m = 0; m < 4; ++m) { const int row = row0 + ai * HALF + m * 16; *(f32x4*)(O + (size_t)row * ldc + col0) = acc[ai][bj][m][0]; }
        }
    }
};

template <class Epi, class Sched, bool ALIGN_EPI = false, bool SP2 = false>
__device__ __forceinline__ void gemm_phase(PG8_LAS unsigned char* lds, const Gemm g, const Sched& S, const Epi& E) {
    int tid_ = threadIdx.x; asm volatile("" : "+v"(tid_));
    const int tid = tid_, wid = __builtin_amdgcn_readfirstlane(tid >> 6), lane = tid & 63, wr = wid >> 2, wc = wid & 3, fr = lane & 15, fq = lane >> 4;
    const int K = g.K, nt = K / BK;
    unsigned voffA[2], voffB[2];
#pragma unroll
    for (int i = 0; i < 2; ++i) { int R, C; stage_rc(tid * 16 + i * 8192, R, C); const int Rb = Epi::PERM ? ((R & ~31) + perm32(R & 31)) : R;
        voffA[i] = (unsigned)(R * K + C) * 2u; voffB[i] = (unsigned)(Rb * K + C) * 2u; }
    const size_t kstep = (size_t)(BK * 2);
    const size_t hstep = (size_t)HALF * K * 2;
    const size_t tstep = 2 * hstep;
    const unsigned ldsw = (unsigned)wid * 1024u;
    const int aoff = lds_byte(wr * 64 + fr, fq * 8), boff = lds_byte(wc * 32 + fr, fq * 8);
#define PG8_SA(b, h) (((b) * 2 + (h)) * HTB)
#define PG8_SB(b, h) ((4 + (b) * 2 + (h)) * HTB)
#define PG8_STAGE(bufoff, gbase, voff) do { _Pragma("unroll") for (int _i = 0; _i < 2; ++_i) \
        __builtin_amdgcn_global_load_lds((const unsigned*)((const char*)(gbase) + (voff)[_i]), (PG8_LAS unsigned*)(lds + (bufoff) + ldsw + _i * 8192), 16, 0, 0); } while (0)
#define PG8_LDA(dst, b, h) do { _Pragma("unroll") for (int m = 0; m < 4; ++m) _Pragma("unroll") for (int k = 0; k < 2; ++k) dst[m][k] = *(const PG8_LAS bf16x8*)(lds + PG8_SA(b, h) + aoff + m * 2048 + k * 1024); } while (0)
#define PG8_LDB(dst, b, h) do { _Pragma("unroll") for (int n = 0; n < 2; ++n) _Pragma("unroll") for (int k = 0; k < 2; ++k) dst[n][k] = *(const PG8_LAS bf16x8*)(lds + PG8_SB(b, h) + boff + n * 2048 + k * 1024); } while (0)
#define PG8_MMA(ai, bj, At, Bt) do { __builtin_amdgcn_s_setprio(1); _Pragma("unroll") for (int m = 0; m < 4; ++m) _Pragma("unroll") for (int n = 0; n < 2; ++n) _Pragma("unroll") for (int k = 0; k < 2; ++k) \
        acc[ai][bj][m][n] = __builtin_amdgcn_mfma_f32_16x16x32_bf16(Bt[n][k], At[m][k], acc[ai][bj][m][n], 0, 0, 0); __builtin_amdgcn_s_setprio(0); } while (0)
#define PG8_WAIT_V(n) asm volatile("s_waitcnt vmcnt(" #n ")" ::: "memory")
#define PG8_WAIT_L(n) asm volatile("s_waitcnt lgkmcnt(" #n ")" ::: "memory")
#define PG8_BAR __builtin_amdgcn_s_barrier()
#define PG8_SCHED __builtin_amdgcn_sched_barrier(0)
    Unit cur, nxt; int ui = 0;
    if (!S.next(0, cur)) return;
    f32x4 acc[2][2][4][2];
#pragma unroll
    for (int a = 0; a < 2; ++a)
#pragma unroll
        for (int b = 0; b < 2; ++b)
#pragma unroll
            for (int m = 0; m < 4; ++m)
#pragma unroll
                for (int n = 0; n < 2; ++n) acc[a][b][m][n] = (f32x4){0.f, 0.f, 0.f, 0.f};
    bf16x8 At[4][2], B0[2][2], B1[2][2];
    const char* cA = (const char*)g.A + (size_t)cur.pm * tstep; const char* cB = (const char*)g.Bt + (size_t)cur.pn * tstep;
    S.a_ready(cur);
    if constexpr (SP2) {
        PG8_STAGE(PG8_SB(0, 0), cB, voffB); PG8_STAGE(PG8_SB(0, 1), cB + hstep, voffB); PG8_STAGE(PG8_SA(0, 0), cA, voffA); PG8_STAGE(PG8_SA(0, 1), cA + hstep, voffA);
        if (wr == 1) PG8_BAR;
        PG8_WAIT_V(2); PG8_BAR;
        PG8_STAGE(PG8_SB(1, 0), cB + kstep, voffB); PG8_STAGE(PG8_SA(1, 0), cA + kstep, voffA); PG8_STAGE(PG8_SB(1, 1), cB + hstep + kstep, voffB);
        PG8_WAIT_V(6); PG8_BAR;
    } else {
        PG8_STAGE(PG8_SB(0, 0), cB, voffB); PG8_STAGE(PG8_SA(0, 0), cA, voffA); PG8_STAGE(PG8_SB(0, 1), cB + hstep, voffB); PG8_STAGE(PG8_SA(0, 1), cA + hstep, voffA);
        if (wr == 1) PG8_BAR;
        PG8_WAIT_V(4); PG8_BAR;
        PG8_STAGE(PG8_SB(1, 0), cB + kstep, voffB); PG8_STAGE(PG8_SA(1, 0), cA + kstep, voffA); PG8_STAGE(PG8_SB(1, 1), cB + hstep + kstep, voffB);
        PG8_WAIT_V(6); PG8_BAR;
    }
    for (;;) {
        const bool has_next = S.next(ui + 1, nxt);
        const char* nA = has_next ? (const char*)g.A + (size_t)nxt.pm * tstep : cA; const char* nB = has_next ? (const char*)g.Bt + (size_t)nxt.pn * tstep : cB;
        for (int t = 0; t < nt; t += 2) {
            const bool last = (t == nt - 2);
            const char* a1 = cA + (size_t)(t + 1) * kstep;
            const char* a2 = last ? nA : cA + (size_t)(t + 2) * kstep; const char* b2 = last ? nB : cB + (size_t)(t + 2) * kstep;
            const char* a3 = a2 + kstep; const char* b3 = b2 + kstep;
            if (last && has_next) S.a_ready(nxt);
            if constexpr (SP2) {
            PG8_LDB(B0, 0, 0); PG8_LDB(B1, 0, 1); PG8_SCHED; PG8_LDA(At, 0, 0); PG8_STAGE(PG8_SA(1, 1), a1 + hstep, voffA);
            PG8_WAIT_V(8); PG8_WAIT_L(0); PG8_BAR; PG8_MMA(0, 0, At, B0); PG8_MMA(0, 1, At, B1); PG8_BAR; PG8_SCHED;
            PG8_LDA(At, 0, 1); PG8_STAGE(PG8_SB(0, 0), b2, voffB); PG8_STAGE(PG8_SB(0, 1), b2 + hstep, voffB); PG8_STAGE(PG8_SA(0, 0), a2, voffA);
            PG8_WAIT_V(8); PG8_WAIT_L(0); PG8_BAR; PG8_MMA(1, 0, At, B0); PG8_MMA(1, 1, At, B1); PG8_BAR; PG8_SCHED;
            PG8_LDB(B0, 1, 0); PG8_LDB(B1, 1, 1); PG8_SCHED; PG8_LDA(At, 1, 0); PG8_STAGE(PG8_SA(0, 1), a2 + hstep, voffA);
            PG8_WAIT_V(8); PG8_WAIT_L(0); PG8_BAR; PG8_MMA(0, 0, At, B0); PG8_MMA(0, 1, At, B1); PG8_BAR; PG8_SCHED;
            PG8_LDA(At, 1, 1); PG8_STAGE(PG8_SB(1, 0), b3, voffB); PG8_STAGE(PG8_SB(1, 1), b3 + hstep, voffB); PG8_STAGE(PG8_SA(1, 0), a3, voffA);
            PG8_WAIT_V(8); PG8_WAIT_L(0); PG8_BAR; PG8_MMA(1, 0, At, B0); PG8_MMA(1, 1, At, B1); PG8_BAR; PG8_SCHED;
            } else {
            PG8_LDB(B0, 0, 0); PG8_SCHED; PG8_LDA(At, 0, 0); PG8_STAGE(PG8_SA(1, 1), a1 + hstep, voffA);
            PG8_WAIT_L(8); PG8_BAR; PG8_WAIT_L(0); PG8_MMA(0, 0, At, B0); PG8_BAR; PG8_SCHED;
            PG8_LDB(B1, 0, 1); PG8_STAGE(PG8_SB(0, 0), b2, voffB);
            PG8_BAR; PG8_WAIT_L(0); PG8_MMA(0, 1, At, B1); PG8_BAR;
            PG8_LDA(At, 0, 1); PG8_STAGE(PG8_SA(0, 0), a2, voffA);
            PG8_BAR; PG8_WAIT_L(0); PG8_MMA(1, 0, At, B0); PG8_BAR; PG8_SCHED;
            PG8_STAGE(PG8_SB(0, 1), b2 + hstep, voffB);
            PG8_WAIT_V(6); PG8_BAR; PG8_MMA(1, 1, At, B1); PG8_BAR;
            PG8_LDB(B0, 1, 0); PG8_SCHED; PG8_LDA(At, 1, 0); PG8_STAGE(PG8_SA(0, 1), a2 + hstep, voffA);
            PG8_WAIT_L(8); PG8_BAR; PG8_WAIT_L(0); PG8_MMA(0, 0, At, B0); PG8_BAR; PG8_SCHED;
            PG8_LDB(B1, 1, 1); PG8_STAGE(PG8_SB(1, 0), b3, voffB);
            PG8_BAR; PG8_WAIT_L(0); PG8_MMA(0, 1, At, B1); PG8_BAR;
            PG8_LDA(At, 1, 1); PG8_STAGE(PG8_SA(1, 0), a3, voffA);
            PG8_BAR; PG8_WAIT_L(0); PG8_MMA(1, 0, At, B0); PG8_BAR; PG8_SCHED;
            PG8_STAGE(PG8_SB(1, 1), b3 + hstep, voffB);
            PG8_WAIT_V(6); PG8_BAR; PG8_MMA(1, 1, At, B1); PG8_BAR;
            }
        }
        if constexpr (ALIGN_EPI) { if (wr == 0) PG8_BAR; }
        if constexpr (!Epi::AFTER_DRAIN) { E(acc, cur, wr, wc, fr, fq); S.done(cur); }
        if (!has_next) break;
#pragma unroll
        for (int a = 0; a < 2; ++a)
#pragma unroll
            for (int b = 0; b < 2; ++b)
#pragma unroll
                for (int m = 0; m < 4; ++m)
#pragma unroll
                    for (int n = 0; n < 2; ++n) acc[a][b][m][n] = (f32x4){0.f, 0.f, 0.f, 0.f};
        cur = nxt; cA = nA; cB = nB; ++ui;
        if constexpr (ALIGN_EPI) { if (wr == 1) PG8_BAR; }
    }
    PG8_WAIT_V(0);
    if constexpr (!ALIGN_EPI) { if (wr == 0) PG8_BAR; }
    PG8_BAR;
    if constexpr (Epi::AFTER_DRAIN) { E.fused(acc, cur, wr, wc, fr, fq, lds, wid, lane); S.done(cur); }
#undef PG8_SA
#undef PG8_SB
#undef PG8_STAGE
#undef PG8_LDA
#undef PG8_LDB
#undef PG8_MMA
#undef PG8_WAIT_V
#undef PG8_WAIT_L
#undef PG8_BAR
#undef PG8_SCHED
}
}

#define GAS __attribute__((address_space(1)))
#define LAS __attribute__((address_space(3)))
typedef unsigned short bf16_t;
typedef unsigned u32x4 __attribute__((ext_vector_type(4)));
typedef unsigned u32x2 __attribute__((ext_vector_type(2)));
typedef int i32x4 __attribute__((ext_vector_type(4)));
typedef float f32x4 __attribute__((ext_vector_type(4)));
typedef float f32x16 __attribute__((ext_vector_type(16)));
typedef short bf16x8 __attribute__((ext_vector_type(8)));
using pg8::cvt_pk_bf16; using pg8::bf_lo; using pg8::bf_hi;

constexpr int NWAVES = 8, NTHREADS = 512;
constexpr int BATCH = 8, SEQ = 2048, DM = 2048, M = BATCH * SEQ, DFF = 5632;
constexpr int NIN = 3904, NIN_PAD = 4096;
constexpr float EPS = 1e-6f, LOG2E = 1.44269504088896f;
constexpr float QSCALE_A = 0.125f * LOG2E;
constexpr float QSCALE_B = 0.07216878364870322f * LOG2E;
constexpr float LAM_INIT = 0.2f;

constexpr size_t MiB = 1u << 20;
constexpr size_t WS_WGATE = 1 * MiB, WS_WUP = 23 * MiB, WS_WDOWN = 45 * MiB;
constexpr size_t WS_H = 67 * MiB;
constexpr size_t WS_BIG = 131 * MiB;
constexpr size_t WS_WIN = WS_BIG + 0, WS_WUQ = WS_BIG + 16 * MiB, WS_WUKV = WS_BIG + 18 * MiB, WS_WOUT = WS_BIG + 19 * MiB;
constexpr size_t WS_PROJ = WS_BIG + 27 * MiB;
constexpr size_t WS_QLAT = WS_BIG + 27 * MiB, WS_KVRAW = WS_BIG + 75 * MiB;
constexpr size_t WS_AO = WS_BIG + 27 * MiB;
constexpr size_t WS_DQ = WS_BIG + 149 * MiB, WS_DK = WS_BIG + 181 * MiB, WS_DVT = WS_BIG + 213 * MiB;
constexpr size_t WS_CQN = WS_BIG + 245 * MiB, WS_CKVN = WS_BIG + 261 * MiB, WS_KR = WS_BIG + 269 * MiB;
constexpr size_t DO_MQ = 0, DO_MK = 48 * MiB, DO_MVT = 96 * MiB;
constexpr size_t WS_G = WS_BIG, WS_ACT = WS_BIG + 176 * MiB;
constexpr size_t WS_WCIN = WS_BIG, WS_WCOUT = WS_BIG + 24 * MiB, WS_P = WS_BIG + 32 * MiB, WS_Z = WS_BIG + 96 * MiB;
constexpr size_t WS_END = WS_BIG + 352 * MiB;

constexpr int RING_BYTES = 131072;
constexpr int LDS_BYTES = 147456;

struct Args {
    const float* in[29]; float* out; unsigned char* ws;
};
#define CAS __attribute__((address_space(4)))
typedef const CAS Args* ArgP;

__device__ __forceinline__ float wave_sum(float v) {
#pragma unroll
    for (int o = 1; o < 64; o <<= 1) v += __shfl_xor(v, o);
    return v;
}
#define LDS_WAIT() asm volatile("s_waitcnt lgkmcnt(0)" ::: "memory")

#define TW_LOAD(it_, dst_, g0_, g1_) do { const int kb_ = (it_) / nblk, nb_ = (it_) % nblk, k0_ = 64 * kb_, n0_ = 32 * nb_; \
        _Pragma("unroll") for (int i_ = 0; i_ < 32; ++i_) { const int kk_ = 2 * i_ + (lane >> 5); dst_[i_] = W[(size_t)(k0_ + kk_) * N + n0_ + (lane & 31)]; } \
        if (gk) { g0_ = *(const f32x4*)(gk + k0_ + 8 * c); g1_ = *(const f32x4*)(gk + k0_ + 8 * c + 4); } } while (0)
template <int MODE>
__device__ __forceinline__ void transpose_weight(const float* W, int K, int N, bf16_t* WT, LAS float* scr, int gw, int NGW, int lane, const float* gk = nullptr) {
    const int nblk = N / 32, nitems = (K / 64) * nblk;
    const int c = lane & 7;
    float cur[32], nxt[32];
    f32x4 gc0 = {1.f, 1.f, 1.f, 1.f}, gc1 = gc0, gn0 = gc0, gn1 = gc0;
    int it = gw;
    if (it < nitems) TW_LOAD(it, cur, gc0, gc1);
    while (it < nitems) {
        const int itn = it + NGW;
        if (itn < nitems) TW_LOAD(itn, nxt, gn0, gn1);
        const int kb = it / nblk, nb = it % nblk, k0 = 64 * kb, n0 = 32 * nb;
        int drow = n0;
        if (MODE == 1) { if (n0 < 2048) drow = 4096 + n0; else if (n0 < 4096) { const int cc = n0 - 2048; drow = (cc >> 7) * 256 + (cc & 127); } else { const int cc = n0 - 4096; drow = (cc >> 7) * 256 + 128 + (cc & 127); } }
#pragma unroll
        for (int i = 0; i < 32; ++i) { const int kk = 2 * i + (lane >> 5); scr[kk * 33 + (lane & 31)] = cur[i]; }
        LDS_WAIT(); asm volatile("" ::: "memory");
#pragma unroll
        for (int j = 0; j < 4; ++j) { const int n = (lane >> 3) + 8 * j; const LAS float* sp = scr + (8 * c) * 33 + n;
            u32x4 o; o.x = cvt_pk_bf16(sp[0 * 33] * gc0[0], sp[1 * 33] * gc0[1]); o.y = cvt_pk_bf16(sp[2 * 33] * gc0[2], sp[3 * 33] * gc0[3]);
            o.z = cvt_pk_bf16(sp[4 * 33] * gc1[0], sp[5 * 33] * gc1[1]); o.w = cvt_pk_bf16(sp[6 * 33] * gc1[2], sp[7 * 33] * gc1[3]);
            *(u32x4*)(WT + (size_t)(drow + n) * K + k0 + 8 * c) = o; }
        LDS_WAIT(); asm volatile("" ::: "memory");
#pragma unroll
        for (int i = 0; i < 32; ++i) cur[i] = nxt[i];
        gc0 = gn0; gc1 = gn1; it = itn;
    }
}
__device__ __forceinline__ void rms_row_to_bf16(const float* xrow, const float* g, bf16_t* orow, int lane) {
    const f32x4* xr = (const f32x4*)xrow + lane; const f32x4* gr = (const f32x4*)g + lane;
    f32x4 v[8]; float s = 0.f;
#pragma unroll
    for (int j = 0; j < 8; ++j) { v[j] = xr[64 * j]; s += (v[j].x * v[j].x + v[j].y * v[j].y) + (v[j].z * v[j].z + v[j].w * v[j].w); }
    const float rstd = 1.0f / sqrtf(wave_sum(s) * (1.0f / DM) + EPS);
    u32x2* o8 = (u32x2*)orow + lane;
#pragma unroll
    for (int j = 0; j < 8; ++j) { const f32x4 gg = gr[64 * j]; u32x2 w; w.x = cvt_pk_bf16(v[j].x * rstd * gg.x, v[j].y * rstd * gg.y); w.y = cvt_pk_bf16(v[j].z * rstd * gg.z, v[j].w * rstd * gg.w); o8[64 * j] = w; }
}
__device__ __forceinline__ void rms_phase(const float* X, const float* g, bf16_t* H, int gw, int NGW, int lane) {
    for (int m = gw; m < M; m += 2 * NGW) {
        const int m2 = m + NGW; const bool two = m2 < M;
        const f32x4* xa = (const f32x4*)(X + (size_t)m * DM) + lane; const f32x4* xb = (const f32x4*)(X + (size_t)(two ? m2 : m) * DM) + lane; const f32x4* gr = (const f32x4*)g + lane;
        f32x4 va[8], vb[8]; float sa = 0.f, sb = 0.f;
#pragma unroll
        for (int j = 0; j < 8; ++j) { va[j] = xa[64 * j]; vb[j] = xb[64 * j]; }
#pragma unroll
        for (int j = 0; j < 8; ++j) { sa += (va[j].x * va[j].x + va[j].y * va[j].y) + (va[j].z * va[j].z + va[j].w * va[j].w); sb += (vb[j].x * vb[j].x + vb[j].y * vb[j].y) + (vb[j].z * vb[j].z + vb[j].w * vb[j].w); }
        const float ra = 1.0f / sqrtf(wave_sum(sa) * (1.0f / DM) + EPS), rb = 1.0f / sqrtf(wave_sum(sb) * (1.0f / DM) + EPS);
        u32x2* oa = (u32x2*)(H + (size_t)m * DM) + lane; u32x2* ob = (u32x2*)(H + (size_t)m2 * DM) + lane;
#pragma unroll
        for (int j = 0; j < 8; ++j) { const f32x4 gg = gr[64 * j]; u32x2 w; w.x = cvt_pk_bf16(va[j].x * ra * gg.x, va[j].y * ra * gg.y); w.y = cvt_pk_bf16(va[j].z * ra * gg.z, va[j].w * ra * gg.w); oa[64 * j] = w;
            if (two) { u32x2 w2; w2.x = cvt_pk_bf16(vb[j].x * rb * gg.x, vb[j].y * rb * gg.y); w2.y = cvt_pk_bf16(vb[j].z * rb * gg.z, vb[j].w * rb * gg.w); ob[64 * j] = w2; } }
    }
}

__device__ __forceinline__ int perm16(int w) { return (w & 3) | (((w >> 3) & 1) << 2) | (((w >> 2) & 1) << 3); }

__device__ __forceinline__ void vt_tile8(const bf16_t* src, int ld, int hstride, bf16_t* vt, int t0, LAS unsigned char* lds, int tid) {
    LAS bf16_t* T = (LAS bf16_t*)lds;
    u32x4 v[2][8];
#pragma unroll
    for (int hb = 0; hb < 2; ++hb)
#pragma unroll
        for (int i = 0; i < 8; ++i) { const int c = tid + i * NTHREADS, r = c >> 6, hc = c & 63, hq = hc >> 4, cc = hc & 15; v[hb][i] = *(const u32x4*)(src + (size_t)r * ld + (hb * 4 + hq) * hstride + cc * 8); }
#pragma unroll
    for (int hb = 0; hb < 2; ++hb) {
#pragma unroll
        for (int i = 0; i < 8; ++i) { const int c = tid + i * NTHREADS, r = c >> 6, hc = c & 63; *(LAS u32x4*)(T + r * 520 + hc * 8) = v[hb][i]; }
        __syncthreads();
#pragma unroll
        for (int i = 0; i < 8; ++i) { const int c = tid + i * NTHREADS, hq = c >> 10, dv = (c >> 3) & 127, q8 = c & 7, blk = q8 >> 1, hh = q8 & 1;
            unsigned e[8];
#pragma unroll
            for (int j = 0; j < 8; ++j) { const int key = blk * 16 + 8 * (j >> 2) + 4 * hh + (j & 3); e[j] = T[key * 520 + hq * 128 + dv]; }
            u32x4 o; o.x = e[0] | (e[1] << 16); o.y = e[2] | (e[3] << 16); o.z = e[4] | (e[5] << 16); o.w = e[6] | (e[7] << 16);
            *(u32x4*)(vt + (size_t)((hb * 4 + hq) * 128 + dv) * SEQ + t0 + blk * 16 + hh * 8) = o; }
        __syncthreads();
    }
}

__device__ __forceinline__ void p2_phase(ArgP ap, LAS unsigned char* lds, int tid, int wid, int lane) {
    unsigned char* ws = ap->ws;
    const bf16_t* PROJ = (const bf16_t*)(ws + WS_PROJ);
    bf16_t* DQ = (bf16_t*)(ws + WS_DQ); bf16_t* DK = (bf16_t*)(ws + WS_DK); bf16_t* DVT = (bf16_t*)(ws + WS_DVT);
    bf16_t* CQN = (bf16_t*)(ws + WS_CQN); bf16_t* CKVN = (bf16_t*)(ws + WS_CKVN); bf16_t* KR = (bf16_t*)(ws + WS_KR);
    const float* dq_g = ap->in[5]; const float* dk_g = ap->in[6]; const float* qa_g = ap->in[12]; const float* kva_g = ap->in[14];
    for (int u = blockIdx.x; u < M / 64; u += gridDim.x) {
        const int tok0 = u * 64;
        for (int i = 0; i < 8; ++i) {
            const int row = tok0 + wid * 8 + i; const bf16_t* p = PROJ + (size_t)row * NIN;
#pragma unroll
            for (int part = 0; part < 2; ++part) {
                const float* g = part ? dk_g : dq_g; const float sc = part ? 1.0f : QSCALE_A; bf16_t* dst = (part ? DK : DQ) + (size_t)row * 1024;
#pragma unroll
                for (int c = 0; c < 2; ++c) {
                    const u32x4 v = *(const u32x4*)(p + part * 1024 + c * 512 + lane * 8);
                    float f[8]; float ss = 0.f;
#pragma unroll
                    for (int q = 0; q < 4; ++q) { f[2 * q] = bf_lo(v[q]); f[2 * q + 1] = bf_hi(v[q]); ss += f[2 * q] * f[2 * q] + f[2 * q + 1] * f[2 * q + 1]; }
                    ss += __shfl_xor(ss, 1); ss += __shfl_xor(ss, 2); ss += __shfl_xor(ss, 4);
                    const float rstd = sc / sqrtf(ss * (1.0f / 64.0f) + EPS);
                    const float* gg = g + (lane & 7) * 8;
                    u32x4 o;
#pragma unroll
                    for (int q = 0; q < 4; ++q) o[q] = cvt_pk_bf16(f[2 * q] * rstd * gg[2 * q], f[2 * q + 1] * rstd * gg[2 * q + 1]);
                    *(u32x4*)(dst + c * 512 + lane * 8) = o;
                }
            }
            {
                const u32x4 v = *(const u32x4*)(p + 3072 + lane * 8); float f[8]; float ss = 0.f;
#pragma unroll
                for (int q = 0; q < 4; ++q) { f[2 * q] = bf_lo(v[q]); f[2 * q + 1] = bf_hi(v[q]); ss += f[2 * q] * f[2 * q] + f[2 * q + 1] * f[2 * q + 1]; }
                const float rstd = 1.0f / sqrtf(wave_sum(ss) * (1.0f / 512.0f) + EPS); const float* gg = qa_g + lane * 8; u32x4 o;
#pragma unroll
                for (int q = 0; q < 4; ++q) o[q] = cvt_pk_bf16(f[2 * q] * rstd * gg[2 * q], f[2 * q + 1] * rstd * gg[2 * q + 1]);
                *(u32x4*)(CQN + (size_t)row * 512 + lane * 8) = o;
            }
            {
                const int l2 = lane & 31; const u32x4 v = *(const u32x4*)(p + 3584 + l2 * 8); float f[8]; float ss = 0.f;
#pragma unroll
                for (int q = 0; q < 4; ++q) { f[2 * q] = bf_lo(v[q]); f[2 * q + 1] = bf_hi(v[q]); ss += f[2 * q] * f[2 * q] + f[2 * q + 1] * f[2 * q + 1]; }
                if (lane >= 32) ss = 0.f;
                const float rstd = 1.0f / sqrtf(wave_sum(ss) * (1.0f / 256.0f) + EPS); const float* gg = kva_g + l2 * 8; u32x4 o;
#pragma unroll
                for (int q = 0; q < 4; ++q) o[q] = cvt_pk_bf16(f[2 * q] * rstd * gg[2 * q], f[2 * q + 1] * rstd * gg[2 * q + 1]);
                if (lane < 32) *(u32x4*)(CKVN + (size_t)row * 256 + l2 * 8) = o;
            }
            if (lane < 8) *(u32x4*)(KR + (size_t)row * 64 + lane * 8) = *(const u32x4*)(p + 3840 + lane * 8);
        }
        const int b = tok0 / SEQ, t0 = tok0 % SEQ;
        vt_tile8(PROJ + (size_t)tok0 * NIN + 2048, NIN, 128, DVT + (size_t)(b * 8) * 128 * SEQ, t0, lds, tid);
    }
}

__device__ __forceinline__ float bfld(const bf16_t* p) { return __uint_as_float((unsigned)(*p) << 16); }
__device__ __forceinline__ void bfst(bf16_t* p, float v) { *p = (bf16_t)(cvt_pk_bf16(v, 0.f) & 0xffffu); }
__device__ __forceinline__ void p4_phase(ArgP ap, LAS unsigned char* lds, int tid, int wid, int lane) {
    unsigned char* ws = ap->ws;
    const bf16_t* QLAT = (const bf16_t*)(ws + WS_QLAT); const bf16_t* KVRAW = (const bf16_t*)(ws + WS_KVRAW); const bf16_t* KR = (const bf16_t*)(ws + WS_KR);
    bf16_t* MQ = (bf16_t*)((unsigned char*)ap->out + DO_MQ); bf16_t* MK = (bf16_t*)((unsigned char*)ap->out + DO_MK); bf16_t* MVT = (bf16_t*)((unsigned char*)ap->out + DO_MVT);
    const int* pos = (const int*)ap->in[1]; const float* mq_g = ap->in[16]; const float* mk_g = ap->in[17];
    const int l2 = lane & 31; const bool lo = lane < 32;
    const float inv_freq = __builtin_amdgcn_exp2f(-(float)l2 * 0.41524101186092029f);
    const float gq0 = mq_g[lane], gq1 = mq_g[64 + lane], gq2 = mq_g[128 + l2], gq3 = mq_g[160 + l2];
    const float gk0 = mk_g[lane], gk1 = mk_g[64 + lane], gk2 = mk_g[128 + l2], gk3 = mk_g[160 + l2];
    for (int u = blockIdx.x; u < M / 64; u += gridDim.x) {
        const int tok0 = u * 64;
        for (int i = 0; i < 8; i += 2) {
            float qe0[2][8], qe1[2][8], qx1[2][8], qx2[2][8], ke0[2][8], ke1[2][8], kr1[2], kr2[2], cs[2], sn[2];
#pragma unroll
            for (int t = 0; t < 2; ++t) {
                const int row = tok0 + wid * 8 + i + t;
                const float ang = (float)pos[row] * inv_freq;
                const double rev = (double)ang * 0.15915494309189535; const float fr = (float)(rev - floor(rev));
                cs[t] = __builtin_amdgcn_cosf(fr); sn[t] = __builtin_amdgcn_sinf(fr);
                kr1[t] = bfld(KR + (size_t)row * 64 + l2); kr2[t] = bfld(KR + (size_t)row * 64 + 32 + l2);
#pragma unroll
                for (int h = 0; h < 8; ++h) {
                    const bf16_t* sq = QLAT + (size_t)row * 1536 + h * 192; const bf16_t* sk = KVRAW + (size_t)row * 2048 + h * 256;
                    qe0[t][h] = bfld(sq + lane); qe1[t][h] = bfld(sq + 64 + lane); qx1[t][h] = bfld(sq + 128 + l2); qx2[t][h] = bfld(sq + 160 + l2);
                    ke0[t][h] = bfld(sk + lane); ke1[t][h] = bfld(sk + 64 + lane); }
            }
#pragma unroll
            for (int t = 0; t < 2; ++t) {
                const int row = tok0 + wid * 8 + i + t;
#pragma unroll
                for (int h = 0; h < 8; ++h) {
                    {
                        const float e0 = qe0[t][h], e1 = qe1[t][h], x1 = qx1[t][h], x2 = qx2[t][h];
                        float ss = e0 * e0 + e1 * e1 + (lo ? x1 * x1 + x2 * x2 : 0.f);
                        const float rstd = QSCALE_B / sqrtf(wave_sum(ss) * (1.0f / 192.0f) + EPS);
                        const float n1 = x1 * rstd * gq2, n2 = x2 * rstd * gq3;
                        bf16_t* d = MQ + (size_t)row * 1536 + h * 192;
                        bfst(d + lane, e0 * rstd * gq0); bfst(d + 64 + lane, e1 * rstd * gq1);
                        if (lo) { bfst(d + 128 + l2, n1 * cs[t] - n2 * sn[t]); bfst(d + 160 + l2, n2 * cs[t] + n1 * sn[t]); }
                    }
                    {
                        const float e0 = ke0[t][h], e1 = ke1[t][h];
                        float ss = e0 * e0 + e1 * e1 + (lo ? kr1[t] * kr1[t] + kr2[t] * kr2[t] : 0.f);
                        const float rstd = 1.0f / sqrtf(wave_sum(ss) * (1.0f / 192.0f) + EPS);
                        const float n1 = kr1[t] * rstd * gk2, n2 = kr2[t] * rstd * gk3;
                        bf16_t* d = MK + (size_t)row * 1536 + h * 192;
                        bfst(d + lane, e0 * rstd * gk0); bfst(d + 64 + lane, e1 * rstd * gk1);
                        if (lo) { bfst(d + 128 + l2, n1 * cs[t] - n2 * sn[t]); bfst(d + 160 + l2, n2 * cs[t] + n1 * sn[t]); }
                    }
                }
            }
        }
        const int b = tok0 / SEQ, t0 = tok0 % SEQ;
        vt_tile8(KVRAW + (size_t)tok0 * 2048 + 128, 2048, 256, MVT + (size_t)(b * 8) * 128 * SEQ, t0, lds, tid);
    }
}


constexpr size_t WS_CTL = 0, CTL_ZERO_BYTES = 262144, WS_SS = 65536;
constexpr int MISC_OFF = RING_BYTES + 320;
#define XB_TMO      128
#define XB_XCNT(j)  (256  + 64 * (j))
#define XB_XSUB(j)  (1280 + 64 * (j))
#define XB_XGEN(j)  (2304 + 64 * (j))
#define XB_TOP      3328
#define XB_TOPGEN   3392
#define XCD_BAR_WORDS 3456
#define XB_SPIN_CAP (1u << 18)

__device__ __forceinline__ unsigned xb_ld(unsigned* p)              { return __hip_atomic_load(p, __ATOMIC_RELAXED, __HIP_MEMORY_SCOPE_AGENT); }
__device__ __forceinline__ unsigned xb_add(unsigned* p, unsigned v) { return __hip_atomic_fetch_add(p, v, __ATOMIC_RELAXED, __HIP_MEMORY_SCOPE_AGENT); }
__device__ __forceinline__ unsigned xb_xcc_id() { return (unsigned)__builtin_amdgcn_s_getreg((3 << 11) | 20) & 0xFu; }
#define XB_SPIN(cond, bar) do { unsigned _sp = 0; while (cond) { __builtin_amdgcn_s_sleep(1); \
    if ((++_sp & 255u) == 0u) { if (xb_ld(&(bar)[XB_TMO])) break; if (_sp > XB_SPIN_CAP) { atomicAdd(&(bar)[XB_TMO], 1u); break; } } } } while (0)

struct XcdBarrier {
    unsigned* bar; unsigned x;
    volatile LAS unsigned* st;
};

__device__ __forceinline__ XcdBarrier xcd_barrier_post(unsigned* bar, volatile LAS unsigned* st) {
    XcdBarrier b; b.bar = bar; b.x = xb_xcc_id(); b.st = st;
    if (threadIdx.x == 0) (void)xb_add(&bar[XB_XCNT(b.x)], 1u);
    return b;
}
__device__ __forceinline__ void xcd_barrier_complete(unsigned* bar, unsigned x, unsigned& nloc, unsigned& nx) {
    const unsigned G = gridDim.x * gridDim.y * gridDim.z;
    unsigned sum, cnt, mine, sp = 0u;
    for (;;) {
        sum = 0u; cnt = 0u; mine = 0u;
#pragma unroll
        for (unsigned j = 0; j < 16; ++j) { const unsigned c = xb_ld(&bar[XB_XCNT(j)]); sum += c; cnt += (c > 0u) ? 1u : 0u; mine = (j == x) ? c : mine; }
        if (sum == G) break;
        __builtin_amdgcn_s_sleep(1);
        if ((++sp & 255u) == 0u) { if (xb_ld(&bar[XB_TMO])) break; if (sp > XB_SPIN_CAP) { atomicAdd(&bar[XB_TMO], 1u); break; } }
    }
    nloc = mine > 0u ? mine : 1u; nx = cnt > 0u ? cnt : 1u;
}

__device__ __forceinline__ void xcd_barrier(const XcdBarrier& b) {
    asm volatile("s_waitcnt vmcnt(0)" ::: "memory");
    __syncthreads();
    if (threadIdx.x == 0) {
        unsigned* bar = b.bar; asm volatile("" : "+s"(bar));
        __builtin_amdgcn_s_waitcnt(0);
        unsigned nloc = b.st[0], nx = b.st[1];
        if (nloc == 0u) { xcd_barrier_complete(bar, b.x, nloc, nx); b.st[0] = nloc; b.st[1] = nx; }
        const unsigned old = xb_add(&bar[XB_XSUB(b.x)], 1u);
        const unsigned gen = old / nloc;
        if (old + 1u == (gen + 1u) * nloc) {
            __builtin_amdgcn_fence(__ATOMIC_RELEASE, "agent");
            asm volatile("s_waitcnt vmcnt(0)" ::: "memory");
            const unsigned og = xb_add(&bar[XB_TOP], 1u);
            const unsigned tg = og / nx;
            if (og + 1u == (tg + 1u) * nx) xb_add(&bar[XB_TOPGEN], 1u);
            else XB_SPIN(xb_ld(&bar[XB_TOPGEN]) == tg, bar);
            __builtin_amdgcn_fence(__ATOMIC_ACQUIRE, "agent");
            xb_add(&bar[XB_XGEN(b.x)], 1u);
            asm volatile("s_waitcnt vmcnt(0)" ::: "memory");
        } else {
            XB_SPIN(xb_ld(&bar[XB_XGEN(b.x)]) == gen, bar);
            __builtin_amdgcn_fence(__ATOMIC_ACQUIRE, "agent");
            asm volatile("s_waitcnt vmcnt(0)" ::: "memory");
        }
    }
    __syncthreads();
}

#define MFMA32(a, b, c) __builtin_amdgcn_mfma_f32_32x32x16_bf16((a), (b), (c), 0, 0, 0)
template <bool DIFF>
__device__ __forceinline__ void attn_unit(LAS unsigned char* lds, const bf16_t* Qg, const bf16_t* Kg, const bf16_t* VTg, bf16_t* AO,
                                          const int* pos, const float* rel_table, const float* subln_g, float lam,
                                          int b, int h, int qb, int tid_in, int wid, int lane_in, bool fresh) {
    int tid = tid_in; asm volatile("" : "+v"(tid)); const int lane = tid & 63; (void)lane_in;
    constexpr int DKH = DIFF ? 64 : 192, KROW = DIFF ? 128 : 192, KSTR = KROW + 8, VSTR = 72;
    constexpr int K_BYTES = 64 * KSTR * 2, V_BYTES = 128 * VSTR * 2, BUF = K_BYTES + V_BYTES;
    constexpr int POS_OFF = 2 * BUF, LUT_OFF = POS_OFF + 8192, TMM_OFF = LUT_OFF + 1280;
    constexpr int ROWS = DIFF ? 128 : 256, QLD = DIFF ? 1024 : 1536, KLD = QLD, CPR = KROW / 8, NKC = (64 * CPR) / NTHREADS, NKS = DKH / 16;
    static_assert(TMM_OFF + 256 <= RING_BYTES, "attention LDS");
    const int r = lane & 31, hh = lane >> 5;
    const int rg = DIFF ? (wid >> 1) : wid, hf = DIFF ? (wid & 1) : 0;
    const int qrow = b * SEQ + qb * ROWS + rg * 32 + r;
    const bf16_t* Kb = Kg + (size_t)b * SEQ * KLD + h * KROW;
    const bf16_t* Vb = VTg + (size_t)(b * 8 + h) * 128 * SEQ;

    int pq4 = 0;
    if (DIFF) {
        LAS int* P4 = (LAS int*)(lds + POS_OFF); LAS float* LUT = (LAS float*)(lds + LUT_OFF);
        if (fresh) for (int i = tid; i < SEQ; i += NTHREADS) P4[i] = 4 * pos[b * SEQ + i];
        if (fresh && tid < 257) { const int rel = tid - 128, n = rel < 0 ? -rel : rel;
            const int large = 8 + (n >= 12) + (n >= 16) + (n >= 23) + (n >= 32) + (n >= 46) + (n >= 64) + (n >= 91);
            const int bucket = (rel > 0 ? 16 : 0) + (n < 8 ? n : (large < 15 ? large : 15));
            LUT[tid] = rel_table[bucket * 8 + h] * LOG2E; }
        pq4 = 4 * pos[qrow];
    }
    bf16x8 qf[NKS];
    { const bf16_t* qp = Qg + (size_t)qrow * QLD + h * KROW + hf * 64 + 8 * hh;
#pragma unroll
      for (int ks = 0; ks < NKS; ++ks) qf[ks] = *(const bf16x8*)(qp + 16 * ks); }

    u32x4 kreg[NKC], vreg[2];
    auto load_tile = [&](int kt) {
#pragma unroll
        for (int i = 0; i < NKC; ++i) { const int c = tid + i * NTHREADS, row = c / CPR, cc = c % CPR; kreg[i] = *(const u32x4*)(Kb + (size_t)(kt * 64 + row) * KLD + cc * 8); }
#pragma unroll
        for (int i = 0; i < 2; ++i) { const int c = tid + i * NTHREADS, dv = c >> 3, cc = c & 7; vreg[i] = *(const u32x4*)(Vb + (size_t)dv * SEQ + kt * 64 + cc * 8); }
    };
    auto store_tile = [&](int buf) {
        LAS unsigned char* kb_ = lds + buf * BUF; LAS unsigned char* vb_ = kb_ + K_BYTES;
#pragma unroll
        for (int i = 0; i < NKC; ++i) { const int c = tid + i * NTHREADS, row = c / CPR, cc = c % CPR; *(LAS u32x4*)(kb_ + (row * KSTR + cc * 8) * 2) = kreg[i]; }
#pragma unroll
        for (int i = 0; i < 2; ++i) { const int c = tid + i * NTHREADS, dv = c >> 3, cc = c & 7; *(LAS u32x4*)(vb_ + (dv * VSTR + cc * 8) * 2) = vreg[i]; }
    };
    load_tile(0); store_tile(0);
    __syncthreads();
    int qmin4 = 0, qmax4 = 0; float bias_lo = 0.f, bias_hi = 0.f;
    if (DIFF) {
        if (fresh && tid < SEQ / 64) { const LAS int* P4 = (const LAS int*)(lds + POS_OFF) + tid * 64; int mn = P4[0], mx_ = P4[0];
            for (int i = 1; i < 64; ++i) { const int v = P4[i]; mn = v < mn ? v : mn; mx_ = v > mx_ ? v : mx_; }
            ((LAS int*)(lds + TMM_OFF))[2 * tid] = mn; ((LAS int*)(lds + TMM_OFF))[2 * tid + 1] = mx_; }
        qmin4 = pq4; qmax4 = pq4;
#pragma unroll
        for (int o = 1; o < 64; o <<= 1) { const int a_ = __shfl_xor(qmin4, o), b_ = __shfl_xor(qmax4, o); qmin4 = a_ < qmin4 ? a_ : qmin4; qmax4 = b_ > qmax4 ? b_ : qmax4; }
        bias_lo = *(const LAS float*)(lds + LUT_OFF);
        bias_hi = *(const LAS float*)(lds + LUT_OFF + 1024);
        __syncthreads();
    }

    f32x16 O[4];
#pragma unroll
    for (int d = 0; d < 4; ++d)
#pragma unroll
        for (int i = 0; i < 16; ++i) O[d][i] = 0.f;
    float m_used = -INFINITY, lsum = 0.f;

    for (int kt = 0; kt < SEQ / 64; ++kt) {
        const bool more = kt + 1 < SEQ / 64;
        if (more) load_tile(kt + 1);
        LAS unsigned char* kbuf = lds + (kt & 1) * BUF; LAS unsigned char* vbuf = kbuf + K_BYTES;
        f32x16 s[2];
        if (DIFF) {
            const int tmn = ((const LAS int*)(lds + TMM_OFF))[2 * kt], tmx = ((const LAS int*)(lds + TMM_OFF))[2 * kt + 1];
            const bool far_hi = __builtin_amdgcn_readfirstlane(tmn - qmax4) >= 512, far_lo = __builtin_amdgcn_readfirstlane(tmx - qmin4) <= -512;
            if (far_hi || far_lo) {
                const float cb = far_hi ? bias_hi : bias_lo;
#pragma unroll
                for (int kb = 0; kb < 2; ++kb)
#pragma unroll
                    for (int i = 0; i < 16; ++i) s[kb][i] = cb;
            } else {
#pragma unroll
                for (int kb = 0; kb < 2; ++kb) {
                    const LAS int* P4 = (const LAS int*)(lds + POS_OFF) + kt * 64 + 32 * kb + 4 * hh;
#pragma unroll
                    for (int g = 0; g < 4; ++g) { const i32x4 pk = *(const LAS i32x4*)(P4 + 8 * g);
#pragma unroll
                        for (int j = 0; j < 4; ++j) { int d = pk[j] - pq4; d = d < -512 ? -512 : (d > 512 ? 512 : d); s[kb][4 * g + j] = *(const LAS float*)(lds + LUT_OFF + 512 + d); } }
                }
            }
        } else {
#pragma unroll
            for (int kb = 0; kb < 2; ++kb)
#pragma unroll
                for (int i = 0; i < 16; ++i) s[kb][i] = 0.f;
        }
        {
            const LAS unsigned char* kp0 = kbuf + (r * KSTR + hf * 64 + 8 * hh) * 2; const LAS unsigned char* kp1 = kp0 + 32 * KSTR * 2;
#pragma unroll
            for (int ks = 0; ks < NKS; ++ks) { const bf16x8 kf0 = *(const LAS bf16x8*)(kp0 + 32 * ks), kf1 = *(const LAS bf16x8*)(kp1 + 32 * ks);
                s[0] = MFMA32(kf0, qf[ks], s[0]); s[1] = MFMA32(kf1, qf[ks], s[1]); }
        }
        float mx = s[0][0];
#pragma unroll
        for (int i = 1; i < 16; ++i) mx = fmaxf(mx, s[0][i]);
#pragma unroll
        for (int i = 0; i < 16; ++i) mx = fmaxf(mx, s[1][i]);
        mx = fmaxf(mx, __shfl_xor(mx, 32));
        const bool need = mx > m_used + 8.0f;
        if (__builtin_amdgcn_ballot_w64(need) != 0ull) {
            const float m_new = need ? mx : m_used;
            const float alpha = __builtin_amdgcn_exp2f(m_used - m_new);
            lsum *= alpha;
#pragma unroll
            for (int d = 0; d < 4; ++d) O[d] = O[d] * alpha;
            m_used = m_new;
        }
#pragma unroll
        for (int kb = 0; kb < 2; ++kb)
#pragma unroll
            for (int i = 0; i < 16; ++i) { const float p = __builtin_amdgcn_exp2f(s[kb][i] - m_used); s[kb][i] = p; lsum += p; }
#pragma unroll
        for (int kb = 0; kb < 2; ++kb)
#pragma unroll
            for (int st = 0; st < 2; ++st) {
                u32x4 pw;
#pragma unroll
                for (int q = 0; q < 4; ++q) pw[q] = cvt_pk_bf16(s[kb][8 * st + 2 * q], s[kb][8 * st + 2 * q + 1]);
                const bf16x8 pf = __builtin_bit_cast(bf16x8, pw);
                const LAS unsigned char* vp = vbuf + (r * VSTR + (2 * kb + st) * 16 + 8 * hh) * 2;
#pragma unroll
                for (int d = 0; d < 4; ++d) { const bf16x8 vf = *(const LAS bf16x8*)(vp + d * 32 * VSTR * 2); O[d] = MFMA32(vf, pf, O[d]); }
            }
        if (more) store_tile((kt + 1) & 1);
        __syncthreads();
    }
    const float ltot = lsum + __shfl_xor(lsum, 32);
    const float inv = 1.0f / ltot;
    if (DIFF) {
        LAS float* XO = (LAS float*)lds + (size_t)rg * 64 * 64 + lane;
        if (hf == 1) {
#pragma unroll
            for (int d = 0; d < 4; ++d)
#pragma unroll
                for (int i = 0; i < 16; ++i) XO[(d * 16 + i) * 64] = O[d][i] * inv;
        }
        __syncthreads();
        if (hf == 0) {
            float ss = 0.f;
#pragma unroll
            for (int d = 0; d < 4; ++d)
#pragma unroll
                for (int i = 0; i < 16; ++i) { const float o = O[d][i] * inv - lam * XO[(d * 16 + i) * 64]; O[d][i] = o; ss += o * o; }
            ss += __shfl_xor(ss, 32);
            const float rstd = (1.0f - LAM_INIT) / sqrtf(ss * (1.0f / 128.0f) + EPS);
            bf16_t* op = AO + (size_t)qrow * 2048 + h * 128 + 4 * hh;
#pragma unroll
            for (int d = 0; d < 4; ++d)
#pragma unroll
                for (int g = 0; g < 4; ++g) { const f32x4 gg = *(const f32x4*)(subln_g + 32 * d + 8 * g + 4 * hh);
                    u32x2 w; w.x = cvt_pk_bf16(O[d][4 * g] * rstd * gg.x, O[d][4 * g + 1] * rstd * gg.y); w.y = cvt_pk_bf16(O[d][4 * g + 2] * rstd * gg.z, O[d][4 * g + 3] * rstd * gg.w);
                    *(u32x2*)(op + 32 * d + 8 * g) = w; }
        }
        __syncthreads();
    } else {
        bf16_t* op = AO + (size_t)qrow * 2048 + 1024 + h * 128 + 4 * hh;
#pragma unroll
        for (int d = 0; d < 4; ++d)
#pragma unroll
            for (int g = 0; g < 4; ++g) { u32x2 w; w.x = cvt_pk_bf16(O[d][4 * g] * inv, O[d][4 * g + 1] * inv); w.y = cvt_pk_bf16(O[d][4 * g + 2] * inv, O[d][4 * g + 3] * inv);
                *(u32x2*)(op + 32 * d + 8 * g) = w; }
    }
}

__device__ __forceinline__ void attn_phase_mla(ArgP ap, LAS unsigned char* lds, int tid, int wid, int lane) {
    const bf16_t* MQ = (const bf16_t*)((unsigned char*)ap->out + DO_MQ); const bf16_t* MK = (const bf16_t*)((unsigned char*)ap->out + DO_MK); const bf16_t* MVT = (const bf16_t*)((unsigned char*)ap->out + DO_MVT);
    bf16_t* AO = (bf16_t*)(ap->ws + WS_AO);
    const int G = gridDim.x, bx = blockIdx.x, v = (G % 8 == 0) ? (bx % 8) * (G / 8) + bx / 8 : bx;
    const bool fast = (512 % G == 0); const int per = fast ? 512 / G : 0;
    for (int i = 0; ; ++i) { int u; if (fast) { if (i >= per) break; u = v * per + i; } else { u = bx + i * G; if (u >= 512) break; }
        const int qb = u & 7, h = (u >> 3) & 7, b = u >> 6;
        attn_unit<false>(lds, MQ, MK, MVT, AO, nullptr, nullptr, nullptr, 0.f, b, h, qb, tid, wid, lane, true); }
}
__device__ __forceinline__ void attn_phase_diff(ArgP ap, LAS unsigned char* lds, int tid, int wid, int lane) {
    unsigned char* ws = ap->ws;
    const bf16_t* DQ = (const bf16_t*)(ws + WS_DQ); const bf16_t* DK = (const bf16_t*)(ws + WS_DK); const bf16_t* DVT = (const bf16_t*)(ws + WS_DVT);
    bf16_t* AO = (bf16_t*)(ws + WS_AO);
    const int* pos = (const int*)ap->in[1];
    float d1 = 0.f, d2 = 0.f;
    { const float q1 = ap->in[7][lane], k1 = ap->in[8][lane], q2 = ap->in[9][lane], k2 = ap->in[10][lane]; d1 = wave_sum(q1 * k1); d2 = wave_sum(q2 * k2); }
    const float lam = expf(d1) - expf(d2) + LAM_INIT;
    const int G = gridDim.x, bx = blockIdx.x, v = (G % 8 == 0) ? (bx % 8) * (G / 8) + bx / 8 : bx;
    const bool fast = (1024 % G == 0 && 1024 / G <= 16 && 16 % (1024 / G) == 0); const int per = fast ? 1024 / G : 0;
    for (int i = 0; ; ++i) { int u; bool fresh; if (fast) { if (i >= per) break; u = v * per + i; fresh = (i == 0); } else { u = bx + i * G; if (u >= 1024) break; fresh = true; }
        const int qb = u & 15, h = (u >> 4) & 7, b = u >> 7;
        attn_unit<true>(lds, DQ, DK, DVT, AO, pos, ap->in[2], ap->in[11], lam, b, h, qb, tid, wid, lane, fresh); }
}

__global__ void __launch_bounds__(NTHREADS, 2) fwd_megakernel(Args a) {
    extern __shared__ __attribute__((aligned(16))) unsigned char lds_raw[];
    LAS unsigned char* lds = (LAS unsigned char*)lds_raw;
    cg::grid_group grid = cg::this_grid();
    if (gridDim.x == 0x7fffffffu) grid.sync();
    { int t_ = threadIdx.x; if (t_ < 32) ((volatile LAS unsigned*)(lds + MISC_OFF))[t_] = 0u; }
    __syncthreads();
    XcdBarrier bar;
    { ArgP ap0 = (ArgP)__builtin_amdgcn_kernarg_segment_ptr(); bar = xcd_barrier_post((unsigned*)(ap0->ws + WS_CTL), (volatile LAS unsigned*)(lds + MISC_OFF) + 8); }
#define ARGP() ArgP ap = (ArgP)__builtin_amdgcn_kernarg_segment_ptr(); asm volatile("" : "+s"(ap)); unsigned char* ws = ap->ws; (void)ws; bf16_t* H = (bf16_t*)(ws + WS_H); bf16_t* WG = (bf16_t*)(ws + WS_WGATE); bf16_t* WU = (bf16_t*)(ws + WS_WUP); bf16_t* WD = (bf16_t*)(ws + WS_WDOWN); (void)H; (void)WG; (void)WU; (void)WD;
#define FRESH_IDS() int tid = threadIdx.x; asm volatile("" : "+v"(tid)); const int lane = tid & 63, wid = __builtin_amdgcn_readfirstlane(tid >> 6); const int gw = blockIdx.x * NWAVES + wid; (void)gw; (void)lane;
    const int G = gridDim.x, NGW = G * NWAVES;
    typedef pg8::StaticOrder SO;

#ifndef PH_MASK
#define PH_MASK 0xffffffffu
#endif
#define PH(k) if ((PH_MASK >> (k)) & 1u)
    PH(0) { FRESH_IDS(); ARGP(); LAS float* scr = (LAS float*)(lds + wid * 16384);
    transpose_weight<0>(ap->in[4], DM, NIN, (bf16_t*)(ws + WS_WIN), scr, gw, NGW, lane);
    transpose_weight<0>(ap->in[13], 512, 1536, (bf16_t*)(ws + WS_WUQ), scr, gw, NGW, lane);
    transpose_weight<0>(ap->in[15], 256, 2048, (bf16_t*)(ws + WS_WUKV), scr, gw, NGW, lane);
    transpose_weight<0>(ap->in[18], DM, DM, (bf16_t*)(ws + WS_WOUT), scr, gw, NGW, lane);
    transpose_weight<0>(ap->in[24], DM, DFF, WG, scr, gw, NGW, lane, ap->in[23]);
    transpose_weight<0>(ap->in[25], DM, DFF, WU, scr, gw, NGW, lane, ap->in[23]);
    transpose_weight<0>(ap->in[28], DFF, DM, WD, scr, gw, NGW, lane);
    rms_phase(ap->in[0], ap->in[3], H, gw, NGW, lane); }
    xcd_barrier(bar);
    PH(1) { ARGP(); pg8::Gemm g{H, (const bf16_t*)(ws + WS_WIN), M, NIN_PAD, DM}; SO S; S.init(M, NIN_PAD, G, (int)blockIdx.x);
      pg8::EpiStoreBf16 E{(bf16_t*)(ws + WS_PROJ), NIN, NIN, nullptr};
      pg8::gemm_phase<pg8::EpiStoreBf16, SO, true, true>(lds, g, S, E); }
    xcd_barrier(bar);
    PH(2) { FRESH_IDS(); ARGP(); p2_phase(ap, lds, tid, wid, lane); }
    xcd_barrier(bar);
    PH(3) { ARGP(); pg8::Gemm g{(const bf16_t*)(ws + WS_CQN), (const bf16_t*)(ws + WS_WUQ), M, 1536, 512}; SO S; S.init(M, 1536, G, (int)blockIdx.x);
      pg8::EpiStoreBf16 E{(bf16_t*)(ws + WS_QLAT), 1536, 1536, nullptr};
      pg8::gemm_phase<pg8::EpiStoreBf16, SO, true, true>(lds, g, S, E); }
    PH(3) { ARGP(); pg8::Gemm g{(const bf16_t*)(ws + WS_CKVN), (const bf16_t*)(ws + WS_WUKV), M, 2048, 256}; SO S; S.init(M, 2048, G, (int)blockIdx.x);
      pg8::EpiStoreBf16 E{(bf16_t*)(ws + WS_KVRAW), 2048, 2048, nullptr};
      pg8::gemm_phase<pg8::EpiStoreBf16, SO, true, true>(lds, g, S, E); }
    xcd_barrier(bar);
    PH(4) { FRESH_IDS(); ARGP(); p4_phase(ap, lds, tid, wid, lane); }
    xcd_barrier(bar);
    PH(5) { FRESH_IDS(); ARGP(); attn_phase_mla(ap, lds, tid, wid, lane); }
    PH(5) { FRESH_IDS(); ARGP(); attn_phase_diff(ap, lds, tid, wid, lane); }
    xcd_barrier(bar);
    PH(6) { ARGP(); pg8::Gemm g{(const bf16_t*)(ws + WS_AO), (const bf16_t*)(ws + WS_WOUT), M, DM, DM}; SO S; S.init(M, DM, G, (int)blockIdx.x);
      pg8::EpiResidF32 E{ap->in[0], ap->out, DM, H, (float*)(ws + WS_SS)};
      pg8::gemm_phase<pg8::EpiResidF32, SO, true, true>(lds, g, S, E); }
    xcd_barrier(bar);
    {
        if (0 == 1) {
            PH(7) { FRESH_IDS(); ARGP(); LAS float* scr = (LAS float*)(lds + wid * 16384);
            transpose_weight<1>(ap->in[20], DM, 3 * DM, (bf16_t*)(ws + WS_WCIN), scr, gw, NGW, lane, ap->in[19]);
            transpose_weight<0>(ap->in[22], DM, DM, (bf16_t*)(ws + WS_WCOUT), scr, gw, NGW, lane);
            transpose_weight<0>(ap->in[24] + (size_t)DM * DFF, DM, DFF, WG, scr, gw, NGW, lane, ap->in[23] + DM);
            transpose_weight<0>(ap->in[25] + (size_t)DM * DFF, DM, DFF, WU, scr, gw, NGW, lane, ap->in[23] + DM);
            transpose_weight<0>(ap->in[28] + (size_t)DM * DFF, DFF, DM, WD, scr, gw, NGW, lane); }
            xcd_barrier(bar);
            PH(8) { ARGP(); pg8::Gemm g{H, (const bf16_t*)(ws + WS_WCIN), M, 2 * DM, DM}; SO S; S.init(M, 2 * DM, G, (int)blockIdx.x);
              pg8::EpiMulBf16 E{(bf16_t*)(ws + WS_P), DM, (const float*)(ws + WS_SS) + M};
              pg8::gemm_phase<pg8::EpiMulBf16, SO, true, true>(lds, g, S, E); }
            xcd_barrier(bar);
            PH(9) { ARGP(); pg8::Gemm g{H, (const bf16_t*)(ws + WS_WCIN) + (size_t)2 * DM * DM, M, DM, DM}; SO S; S.init(M, DM, G, (int)blockIdx.x);
              pg8::EpiConvGate<false> E{(const bf16_t*)(ws + WS_P), ap->in[21], nullptr, (bf16_t*)(ws + WS_Z), DM, SEQ, (const float*)(ws + WS_SS) + M};
              pg8::gemm_phase<pg8::EpiConvGate<false>, SO, true, true>(lds, g, S, E); }
            xcd_barrier(bar);
            PH(10) { ARGP(); pg8::Gemm g{(const bf16_t*)(ws + WS_Z), (const bf16_t*)(ws + WS_WCOUT), M, DM, DM}; SO S; S.init(M, DM, G, (int)blockIdx.x);
              pg8::EpiResidF32 E{ap->out, ap->out, DM, H, (float*)(ws + WS_SS) + 2 * M};
              pg8::gemm_phase<pg8::EpiResidF32, SO, true, true>(lds, g, S, E); }
            xcd_barrier(bar);
        }
        constexpr int NA = 20 * 256, NR = 2 * 256;
        PH(12) { ARGP(); pg8::Gemm g{H, WG, M, NA, DM}; SO S; S.init(M, NA, G, (int)blockIdx.x);
          pg8::EpiStoreBf16 E{(bf16_t*)(ws + WS_G), DFF, NA, (const float*)(ws + WS_SS) + (0 ? 2 * M : 0)};
          pg8::gemm_phase<pg8::EpiStoreBf16, SO, true, true>(lds, g, S, E); }
        xcd_barrier(bar);
        PH(12) { ARGP(); const int half = G / 2; const float* ssp = (const float*)(ws + WS_SS) + (0 ? 2 * M : 0);
          if ((int)blockIdx.x < half) {
            pg8::Gemm g{H, WG + (size_t)NA * DM, M, NR, DM}; pg8::SubsetOrder S{(M / 256) * 2, 2, half, (int)blockIdx.x};
            pg8::EpiStoreBf16 E{(bf16_t*)(ws + WS_G) + NA, DFF, NR, ssp};
            pg8::gemm_phase<pg8::EpiStoreBf16, pg8::SubsetOrder, true, true>(lds, g, S, E);
          } else {
            pg8::Gemm g{H, WU, M, NR, DM}; pg8::SubsetOrder S{(M / 256) * 2, 2, G - half, (int)blockIdx.x - half};
            pg8::EpiConvGate<true> E{(const bf16_t*)(ws + WS_G), ap->in[26] + (size_t)0 * 3 * DFF, ap->in[27] + (size_t)0 * DFF, (bf16_t*)(ws + WS_ACT), DFF, SEQ, ssp};
            pg8::gemm_phase<pg8::EpiConvGate<true>, pg8::SubsetOrder, true, true>(lds, g, S, E);
          } }
        xcd_barrier(bar);
        PH(13) { ARGP(); pg8::Gemm g{H, WU + (size_t)NR * DM, M, NA, DM}; SO S; S.init(M, NA, G, (int)blockIdx.x);
          pg8::EpiConvGate<true> E{(const bf16_t*)(ws + WS_G) + NR, ap->in[26] + (size_t)0 * 3 * DFF + NR, ap->in[27] + (size_t)0 * DFF + NR, (bf16_t*)(ws + WS_ACT) + NR, DFF, SEQ, (const float*)(ws + WS_SS) + (0 ? 2 * M : 0)};
          pg8::gemm_phase<pg8::EpiConvGate<true>, SO, true, true>(lds, g, S, E); }
        xcd_barrier(bar);
        PH(14) { ARGP(); pg8::Gemm g{(const bf16_t*)(ws + WS_ACT), WD, M, DM, DFF}; SO S; S.init(M, DM, G, (int)blockIdx.x);
          pg8::EpiResidF32 E{ap->out, ap->out, DM, 0 ? (bf16_t*)nullptr : H, (float*)(ws + WS_SS) + M};
          pg8::gemm_phase<pg8::EpiResidF32, SO, true, true>(lds, g, S, E); }
        if (0 == 0) xcd_barrier(bar);
    }
    {
        if (1 == 1) {
            PH(7) { FRESH_IDS(); ARGP(); LAS float* scr = (LAS float*)(lds + wid * 16384);
            transpose_weight<1>(ap->in[20], DM, 3 * DM, (bf16_t*)(ws + WS_WCIN), scr, gw, NGW, lane, ap->in[19]);
            transpose_weight<0>(ap->in[22], DM, DM, (bf16_t*)(ws + WS_WCOUT), scr, gw, NGW, lane);
            transpose_weight<0>(ap->in[24] + (size_t)DM * DFF, DM, DFF, WG, scr, gw, NGW, lane, ap->in[23] + DM);
            transpose_weight<0>(ap->in[25] + (size_t)DM * DFF, DM, DFF, WU, scr, gw, NGW, lane, ap->in[23] + DM);
            transpose_weight<0>(ap->in[28] + (size_t)DM * DFF, DFF, DM, WD, scr, gw, NGW, lane); }
            xcd_barrier(bar);
            PH(8) { ARGP(); pg8::Gemm g{H, (const bf16_t*)(ws + WS_WCIN), M, 2 * DM, DM}; SO S; S.init(M, 2 * DM, G, (int)blockIdx.x);
              pg8::EpiMulBf16 E{(bf16_t*)(ws + WS_P), DM, (const float*)(ws + WS_SS) + M};
              pg8::gemm_phase<pg8::EpiMulBf16, SO, true, true>(lds, g, S, E); }
            xcd_barrier(bar);
            PH(9) { ARGP(); pg8::Gemm g{H, (const bf16_t*)(ws + WS_WCIN) + (size_t)2 * DM * DM, M, DM, DM}; SO S; S.init(M, DM, G, (int)blockIdx.x);
              pg8::EpiConvGate<false> E{(const bf16_t*)(ws + WS_P), ap->in[21], nullptr, (bf16_t*)(ws + WS_Z), DM, SEQ, (const float*)(ws + WS_SS) + M};
              pg8::gemm_phase<pg8::EpiConvGate<false>, SO, true, true>(lds, g, S, E); }
            xcd_barrier(bar);
            PH(10) { ARGP(); pg8::Gemm g{(const bf16_t*)(ws + WS_Z), (const bf16_t*)(ws + WS_WCOUT), M, DM, DM}; SO S; S.init(M, DM, G, (int)blockIdx.x);
              pg8::EpiResidF32 E{ap->out, ap->out, DM, H, (float*)(ws + WS_SS) + 2 * M};
              pg8::gemm_phase<pg8::EpiResidF32, SO, true, true>(lds, g, S, E); }
            xcd_barrier(bar);
        }
        constexpr int NA = 20 * 256, NR = 2 * 256;
        PH(12) { ARGP(); pg8::Gemm g{H, WG, M, NA, DM}; SO S; S.init(M, NA, G, (int)blockIdx.x);
          pg8::EpiStoreBf16 E{(bf16_t*)(ws + WS_G), DFF, NA, (const float*)(ws + WS_SS) + (1 ? 2 * M : 0)};
          pg8::gemm_phase<pg8::EpiStoreBf16, SO, true, true>(lds, g, S, E); }
        xcd_barrier(bar);
        PH(12) { ARGP(); const int half = G / 2; const float* ssp = (const float*)(ws + WS_SS) + (1 ? 2 * M : 0);
          if ((int)blockIdx.x < half) {
            pg8::Gemm g{H, WG + (size_t)NA * DM, M, NR, DM}; pg8::SubsetOrder S{(M / 256) * 2, 2, half, (int)blockIdx.x};
            pg8::EpiStoreBf16 E{(bf16_t*)(ws + WS_G) + NA, DFF, NR, ssp};
            pg8::gemm_phase<pg8::EpiStoreBf16, pg8::SubsetOrder, true, true>(lds, g, S, E);
          } else {
            pg8::Gemm g{H, WU, M, NR, DM}; pg8::SubsetOrder S{(M / 256) * 2, 2, G - half, (int)blockIdx.x - half};
            pg8::EpiConvGate<true> E{(const bf16_t*)(ws + WS_G), ap->in[26] + (size_t)1 * 3 * DFF, ap->in[27] + (size_t)1 * DFF, (bf16_t*)(ws + WS_ACT), DFF, SEQ, ssp};
            pg8::gemm_phase<pg8::EpiConvGate<true>, pg8::SubsetOrder, true, true>(lds, g, S, E);
          } }
        xcd_barrier(bar);
        PH(13) { ARGP(); pg8::Gemm g{H, WU + (size_t)NR * DM, M, NA, DM}; SO S; S.init(M, NA, G, (int)blockIdx.x);
          pg8::EpiConvGate<true> E{(const bf16_t*)(ws + WS_G) + NR, ap->in[26] + (size_t)1 * 3 * DFF + NR, ap->in[27] + (size_t)1 * DFF + NR, (bf16_t*)(ws + WS_ACT) + NR, DFF, SEQ, (const float*)(ws + WS_SS) + (1 ? 2 * M : 0)};
          pg8::gemm_phase<pg8::EpiConvGate<true>, SO, true, true>(lds, g, S, E); }
        xcd_barrier(bar);
        PH(14) { ARGP(); pg8::Gemm g{(const bf16_t*)(ws + WS_ACT), WD, M, DM, DFF}; SO S; S.init(M, DM, G, (int)blockIdx.x);
          pg8::EpiResidF32 E{ap->out, ap->out, DM, 1 ? (bf16_t*)nullptr : H, (float*)(ws + WS_SS) + M};
          pg8::gemm_phase<pg8::EpiResidF32, SO, true, true>(lds, g, S, E); }
        if (1 == 0) xcd_barrier(bar);
    }
}

extern "C" void kernel_launch(void* const* d_in, const int* in_sizes, int n_in, void* d_out, int out_size, void* d_ws, size_t ws_size, hipStream_t stream) {
    static int grid = 0;
    if (grid == 0) {
        if (n_in != 29 || out_size != M * DM || ws_size < WS_END) { fprintf(stderr, "kernel_launch: unexpected shapes n_in %d out %d ws %zu (need %zu)\n", n_in, out_size, ws_size, (size_t)WS_END); grid = -1; return; }
        int dev = 0, cus = 0, per_cu = 0;
        hipGetDevice(&dev); hipDeviceGetAttribute(&cus, hipDeviceAttributeMultiprocessorCount, dev);
        hipFuncSetAttribute((const void*)fwd_megakernel, hipFuncAttributeMaxDynamicSharedMemorySize, LDS_BYTES);
        hipOccupancyMaxActiveBlocksPerMultiprocessor(&per_cu, (const void*)fwd_megakernel, NTHREADS, LDS_BYTES);
        if (per_cu < 1) { fprintf(stderr, "kernel_launch: occupancy query says %d blocks/CU\n", per_cu); per_cu = 1; }
        (void)hipGetLastError();
        grid = cus * per_cu;
    }
    if (grid < 0) return;
    if (hipMemsetAsync((char*)d_ws + WS_CTL, 0, CTL_ZERO_BYTES, stream) != hipSuccess) { fprintf(stderr, "kernel_launch: memset failed\n"); return; }
    Args a{};
    for (int i = 0; i < 29; ++i) a.in[i] = (const float*)d_in[i];
    a.out = (float*)d_out; a.ws = (unsigned char*)d_ws;
    void* args[] = {&a};
    hipError_t e = hipLaunchCooperativeKernel((const void*)fwd_megakernel, dim3(grid), dim3(NTHREADS), args, LDS_BYTES, stream);
    if (e != hipSuccess) fprintf(stderr, "cooperative launch failed: %s (grid %d)\n", hipGetErrorString(e), grid);
}
```

```cpp
#include <hip/hip_runtime.h>
#include <hip/hip_cooperative_groups.h>
#include <cstdio>
#include <cstdint>
namespace cg = cooperative_groups;
namespace pg8 {
#define PG8_LAS __attribute__((address_space(3)))
typedef unsigned short bf16_t;
typedef short bf16x8 __attribute__((ext_vector_type(8)));
typedef float f32x4 __attribute__((ext_vector_type(4)));
typedef unsigned u32x4 __attribute__((ext_vector_type(4)));
constexpr int BM = 256, BK = 64, HALF = 128, HTB = HALF * BK * 2  , STAGE_BYTES = 8 * HTB, NXCD = 8, WGM = 8;

__host__ __device__ __forceinline__ int lds_byte(int r, int c) { const int st = (r >> 4) * 2 + (c >> 5), rr = r & 15, cc = c & 31, ob = rr * 64 + cc * 2; return st * 1024 + (ob ^ (((ob >> 9) & 1) << 5)); }
__host__ __device__ __forceinline__ void stage_rc(int b, int& R, int& C) { const int st = b / 1024, sb = b % 1024, swz = sb ^ (((sb >> 9) & 1) << 5); R = (st >> 1) * 16 + swz / 64; C = (st & 1) * 32 + (swz % 64) / 2; }
__host__ __device__ __forceinline__ int perm32(int rho) { const int n = rho >> 4, i = rho & 15; return 8 * (i >> 2) + 4 * n + (i & 3); }

struct Unit { int pm, pn; };
struct Gemm { const bf16_t* A; const bf16_t* Bt; int M, N, K; };

struct StaticOrder {
    int nM, nN, nwg, G, c;
    __host__ __device__ void init(int M, int N, int G_, int c_) { nM = M / BM; nN = N / BM; nwg = nM * nN; G = G_; c = c_; }
    __host__ __device__ bool next(int i, Unit& u) const {
        const long L = (long)i * G + c; if (L >= nwg) return false;
        int wgid = (int)L; { const int q = nwg / NXCD, r = nwg % NXCD, xcd = wgid % NXCD, off = wgid / NXCD; wgid = (xcd < r ? xcd * (q + 1) : r * (q + 1) + (xcd - r) * q) + off; }
        const int nig = WGM * nN, gid = wgid / nig, fm = gid * WGM, gsz = (nM - fm) < WGM ? (nM - fm) : WGM;
        u.pm = fm + ((wgid % nig) % gsz); u.pn = (wgid % nig) / gsz; return true;
    }
    __device__ __forceinline__ void a_ready(const Unit&) const {}
    __device__ __forceinline__ void done(const Unit&) const {}
};


typedef __bf16 bf16x2_t __attribute__((ext_vector_type(2)));
typedef float f32x2_t __attribute__((ext_vector_type(2)));
__device__ __forceinline__ unsigned cvt_pk_bf16(float lo, float hi) { f32x2_t f = {lo, hi}; bf16x2_t r = __builtin_convertvector(f, bf16x2_t); return __builtin_bit_cast(unsigned, r); }
__device__ __forceinline__ float bf_lo(unsigned w) { return __uint_as_float(w << 16); }
__device__ __forceinline__ float bf_hi(unsigned w) { return __uint_as_float(w & 0xffff0000u); }

struct SubsetOrder {
    int n, nN, R, r;
    __device__ __forceinline__ bool next(int i, Unit& u) const { const int k = r + i * R; if (k >= n) return false; u.pm = k / nN; u.pn = k % nN; return true; }
    __device__ __forceinline__ void a_ready(const Unit&) const {}
    __device__ __forceinline__ void done(const Unit&) const {}
};
__device__ __forceinline__ float row_rstd(const float* ss, int row) { return ss ? 1.0f / sqrtf(ss[row] * (1.0f / 2048.0f) + 1e-6f) : 1.0f; }
struct EpiStoreBf16 {
    static constexpr bool PERM = true, AFTER_DRAIN = false;
    bf16_t* O; int ldc; int ncols; const float* ss;
    __device__ __forceinline__ void operator()(f32x4 (&acc)[2][2][4][2], const Unit& u, int wr, int wc, int fr, int fq) const {
        const int row0 = u.pm * BM + wr * 64 + fr; const int col0 = u.pn * BM + wc * 32 + 8 * fq;
        float rs[2][4];
#pragma unroll
        for (int ai = 0; ai < 2; ++ai)
#pragma unroll
            for (int m = 0; m < 4; ++m) rs[ai][m] = row_rstd(ss, row0 + ai * HALF + m * 16);
#pragma unroll
        for (int ai = 0; ai < 2; ++ai)
#pragma unroll
            for (int m = 0; m < 4; ++m) { const int row = row0 + ai * HALF + m * 16; bf16_t* rowp = O + (size_t)row * ldc + col0;
#pragma unroll
                for (int bj = 0; bj < 2; ++bj) { const f32x4 v0 = acc[ai][bj][m][0] * rs[ai][m], v1 = acc[ai][bj][m][1] * rs[ai][m];
                    u32x4 w; w.x = cvt_pk_bf16(v0[0], v0[1]); w.y = cvt_pk_bf16(v0[2], v0[3]); w.z = cvt_pk_bf16(v1[0], v1[1]); w.w = cvt_pk_bf16(v1[2], v1[3]);
                    if (col0 + bj * HALF < ncols) *(u32x4*)(rowp + bj * HALF) = w; } }
    }
};
typedef unsigned u32x2e __attribute__((ext_vector_type(2)));
struct EpiResidF32 {
    static constexpr bool PERM = false, AFTER_DRAIN = false;
    const float* base; float* out; int ldc; bf16_t* xb; float* ss;
    __device__ __forceinline__ void operator()(f32x4 (&acc)[2][2][4][2], const Unit& u, int wr, int wc, int fr, int fq) const {
        const int row0 = u.pm * BM + wr * 64 + fr; const int col0 = u.pn * BM + wc * 32 + 4 * fq;
#pragma unroll
        for (int ai = 0; ai < 2; ++ai)
#pragma unroll
            for (int m = 0; m < 4; ++m) { const size_t off = (size_t)(row0 + ai * HALF + m * 16) * ldc + col0;
#pragma unroll
                for (int bj = 0; bj < 2; ++bj)
#pragma unroll
                    for (int n = 0; n < 2; ++n) acc[ai][bj][m][n] += *(const f32x4*)(base + off + bj * HALF + n * 16);
                if (m == 3) asm volatile("" : "+v"(acc[ai][0][0][0]), "+v"(acc[ai][0][0][1]), "+v"(acc[ai][1][0][0]), "+v"(acc[ai][1][0][1]), "+v"(acc[ai][0][1][0]), "+v"(acc[ai][0][1][1]), "+v"(acc[ai][1][1][0]), "+v"(acc[ai][1][1][1]),
                                             "+v"(acc[ai][0][2][0]), "+v"(acc[ai][0][2][1]), "+v"(acc[ai][1][2][0]), "+v"(acc[ai][1][2][1]), "+v"(acc[ai][0][3][0]), "+v"(acc[ai][0][3][1]), "+v"(acc[ai][1][3][0]), "+v"(acc[ai][1][3][1]) :: "memory"); }
        asm volatile("" ::: "memory");
#pragma unroll
        for (int ai = 0; ai < 2; ++ai)
#pragma unroll
            for (int m = 0; m < 4; ++m) { const int row = row0 + ai * HALF + m * 16; const size_t off = (size_t)row * ldc + col0; float sq = 0.f;
#pragma unroll
                for (int bj = 0; bj < 2; ++bj)
#pragma unroll
                    for (int n = 0; n < 2; ++n) { const f32x4 v = acc[ai][bj][m][n]; *(f32x4*)(out + off + bj * HALF + n * 16) = v;
                        if (xb) { u32x2e w; w.x = cvt_pk_bf16(v[0], v[1]); w.y = cvt_pk_bf16(v[2], v[3]); *(u32x2e*)(xb + off + bj * HALF + n * 16) = w; sq += (v[0] * v[0] + v[1] * v[1]) + (v[2] * v[2] + v[3] * v[3]); } }
                if (xb) { sq += __shfl_xor(sq, 16); sq += __shfl_xor(sq, 32); if (fq == 0) atomicAdd(ss + row, sq); } }
    }
};
struct EpiMulBf16 {
    static constexpr bool PERM = true, AFTER_DRAIN = false;
    bf16_t* O; int ldc; const float* ss;
    __device__ __forceinline__ void operator()(f32x4 (&acc)[2][2][4][2], const Unit& u, int wr, int wc, int fr, int fq) const {
        const int row0 = u.pm * BM + wr * 64 + fr; const int col0 = u.pn * HALF + wc * 32 + 8 * fq;
        float rs[2][4];
#pragma unroll
        for (int ai = 0; ai < 2; ++ai)
#pragma unroll
            for (int m = 0; m < 4; ++m) rs[ai][m] = row_rstd(ss, row0 + ai * HALF + m * 16);
#pragma unroll
        for (int ai = 0; ai < 2; ++ai)
#pragma unroll
            for (int m = 0; m < 4; ++m) { const int row = row0 + ai * HALF + m * 16; bf16_t* rowp = O + (size_t)row * ldc + col0; const float rs2 = rs[ai][m] * rs[ai][m];
                const f32x4 v0 = acc[ai][0][m][0] * acc[ai][1][m][0] * rs2, v1 = acc[ai][0][m][1] * acc[ai][1][m][1] * rs2;
                u32x4 w; w.x = cvt_pk_bf16(v0[0], v0[1]); w.y = cvt_pk_bf16(v0[2], v0[3]); w.z = cvt_pk_bf16(v1[0], v1[1]); w.w = cvt_pk_bf16(v1[2], v1[3]);
                *(u32x4*)rowp = w; }
    }
};
#define PG8_DPP(old_, src_, ctrl_) ((unsigned)__builtin_amdgcn_update_dpp((int)(old_), (int)(src_), (ctrl_), 0xf, 0xf, false))
template <bool SILU> struct EpiConvGate {
    static constexpr bool PERM = true, AFTER_DRAIN = false;
    const bf16_t* G; const float* cw; const float* bias; bf16_t* O; int ldc; int seq; const float* ss;
    __device__ __forceinline__ void operator()(f32x4 (&acc)[2][2][4][2], const Unit& u, int wr, int wc, int fr, int fq) const {
        const int row0 = u.pm * BM + wr * 64 + fr;
        float rs[2][4];
#pragma unroll
        for (int ai = 0; ai < 2; ++ai)
#pragma unroll
            for (int m = 0; m < 4; ++m) rs[ai][m] = row_rstd(ss, row0 + ai * HALF + m * 16);
        u32x4 own[1][4], halo[1];
        const u32x4 z4 = {0u, 0u, 0u, 0u};
#define PG8_ISSUE(g_, buf_) do { const int bj_ = (g_) >> 1, ai_ = (g_) & 1; const int col0_ = u.pn * BM + bj_ * HALF + wc * 32 + 8 * fq; \
            const int rowb_ = row0 + ai_ * HALF; const bf16_t* gp_ = G + (size_t)rowb_ * ldc + col0_; \
            _Pragma("unroll") for (int m_ = 0; m_ < 4; ++m_) own[buf_][m_] = *(const u32x4*)(gp_ + (size_t)(16 * m_) * ldc); \
            const int blk_ = rowb_ - fr; u32x4 hv_ = z4; \
            if (fr == 0) { if ((blk_ & (seq - 1)) != 0) hv_ = *(const u32x4*)(gp_ - ldc); } \
            else if (fr == 15) { if (((blk_ + 64) & (seq - 1)) != 0) hv_ = *(const u32x4*)(gp_ + (size_t)49 * ldc); } \
            halo[buf_] = hv_; } while (0)
#pragma unroll
        for (int g = 0; g < 4; ++g) {
            const int bj = g >> 1, ai = g & 1, buf = 0; const int col0 = u.pn * BM + bj * HALF + wc * 32 + 8 * fq;
            PG8_ISSUE(g, 0);
            float w0[8], w1[8], w2[8], bb[8];
#pragma unroll
            for (int q = 0; q < 2; ++q) { const f32x4 a = *(const f32x4*)(cw + col0 + 4 * q), b = *(const f32x4*)(cw + ldc + col0 + 4 * q), c = *(const f32x4*)(cw + 2 * ldc + col0 + 4 * q);
                const f32x4 d = bias ? *(const f32x4*)(bias + col0 + 4 * q) : (f32x4){0.f, 0.f, 0.f, 0.f};
#pragma unroll
                for (int j = 0; j < 4; ++j) { w0[4 * q + j] = a[j]; w1[4 * q + j] = b[j]; w2[4 * q + j] = c[j]; bb[4 * q + j] = d[j]; } }
#pragma unroll
            for (int m = 0; m < 4; ++m) {
                u32x4 gm, gn; const u32x4 g0 = own[buf][m];
#pragma unroll
                for (int q = 0; q < 4; ++q) {
                    const unsigned oldp = m > 0 ? PG8_DPP(0u, own[buf][m > 0 ? m - 1 : 0][q], 0x121) : halo[buf][q];
                    const unsigned oldn = m < 3 ? PG8_DPP(0u, own[buf][m < 3 ? m + 1 : 3][q], 0x12F) : halo[buf][q];
                    gm[q] = PG8_DPP(oldp, g0[q], 0x111);
                    gn[q] = PG8_DPP(oldn, g0[q], 0x101);
                }
                float r[8];
#pragma unroll
                for (int q = 0; q < 4; ++q) {
                    const float c0 = w0[2 * q] * bf_lo(gm[q]) + w1[2 * q] * bf_lo(g0[q]) + w2[2 * q] * bf_lo(gn[q]) + bb[2 * q];
                    const float c1 = w0[2 * q + 1] * bf_hi(gm[q]) + w1[2 * q + 1] * bf_hi(g0[q]) + w2[2 * q + 1] * bf_hi(gn[q]) + bb[2 * q + 1];
                    float f0 = c0, f1 = c1;
                    if (SILU) { f0 = c0 * __builtin_amdgcn_rcpf(1.0f + __builtin_amdgcn_exp2f(-1.44269504089f * c0)); f1 = c1 * __builtin_amdgcn_rcpf(1.0f + __builtin_amdgcn_exp2f(-1.44269504089f * c1)); }
                    r[2 * q] = f0 * rs[ai][m]; r[2 * q + 1] = f1 * rs[ai][m]; }
                const f32x4 v0 = acc[ai][bj][m][0], v1 = acc[ai][bj][m][1];
                f32x4 pk; pk[0] = __uint_as_float(cvt_pk_bf16(v0[0] * r[0], v0[1] * r[1])); pk[1] = __uint_as_float(cvt_pk_bf16(v0[2] * r[2], v0[3] * r[3]));
                pk[2] = __uint_as_float(cvt_pk_bf16(v1[0] * r[4], v1[1] * r[5])); pk[3] = __uint_as_float(cvt_pk_bf16(v1[2] * r[6], v1[3] * r[7]));
                acc[ai][bj][m][0] = pk;
            }
            asm volatile("" : "+v"(acc[ai][bj][0][0]), "+v"(acc[ai][bj][1][0]), "+v"(acc[ai][bj][2][0]), "+v"(acc[ai][bj][3][0]) :: "memory");
        }
#pragma unroll
        for (int bj = 0; bj < 2; ++bj) {
            const int col0 = u.pn * BM + bj * HALF + wc * 32 + 8 * fq;
#pragma unroll
            for (int ai = 0; ai < 2; ++ai)
#pragma unroll
                for (int m = 0; m < 4; ++m) { const int row = row0 + ai * HALF + m * 16; *(f32x4*)(O + (size_t)row * ldc + col0) = acc[ai][bj][m][0]; }
        }
    }
};

template <class Epi, class Sched, bool ALIGN_EPI = false, bool SP2 = false>
__device__ __forceinline__ void gemm_phase(PG8_LAS unsigned char* lds, const Gemm g, const Sched& S, const Epi& E) {
    int tid_ = threadIdx.x; asm volatile("" : "+v"(tid_));
    const int tid = tid_, wid = __builtin_amdgcn_readfirstlane(tid >> 6), lane = tid & 63, wr = wid >> 2, wc = wid & 3, fr = lane & 15, fq = lane >> 4;
    const int K = g.K, nt = K / BK;
    unsigned voffA[2], voffB[2];
#pragma unroll
    for (int i = 0; i < 2; ++i) { int R, C; stage_rc(tid * 16 + i * 8192, R, C); const int Rb = Epi::PERM ? ((R & ~31) + perm32(R & 31)) : R;
        voffA[i] = (unsigned)(R * K + C) * 2u; voffB[i] = (unsigned)(Rb * K + C) * 2u; }
    const size_t kstep = (size_t)(BK * 2);
    const size_t hstep = (size_t)HALF * K * 2;
    const size_t tstep = 2 * hstep;
    const unsigned ldsw = (unsigned)wid * 1024u;
    const int aoff = lds_byte(wr * 64 + fr, fq * 8), boff = lds_byte(wc * 32 + fr, fq * 8);
#define PG8_SA(b, h) (((b) * 2 + (h)) * HTB)
#define PG8_SB(b, h) ((4 + (b) * 2 + (h)) * HTB)
#define PG8_STAGE(bufoff, gbase, voff) do { _Pragma("unroll") for (int _i = 0; _i < 2; ++_i) \
        __builtin_amdgcn_global_load_lds((const unsigned*)((const char*)(gbase) + (voff)[_i]), (PG8_LAS unsigned*)(lds + (bufoff) + ldsw + _i * 8192), 16, 0, 0); } while (0)
#define PG8_LDA(dst, b, h) do { _Pragma("unroll") for (int m = 0; m < 4; ++m) _Pragma("unroll") for (int k = 0; k < 2; ++k) dst[m][k] = *(const PG8_LAS bf16x8*)(lds + PG8_SA(b, h) + aoff + m * 2048 + k * 1024); } while (0)
#define PG8_LDB(dst, b, h) do { _Pragma("unroll") for (int n = 0; n < 2; ++n) _Pragma("unroll") for (int k = 0; k < 2; ++k) dst[n][k] = *(const PG8_LAS bf16x8*)(lds + PG8_SB(b, h) + boff + n * 2048 + k * 1024); } while (0)
#define PG8_MMA(ai, bj, At, Bt) do { __builtin_amdgcn_s_setprio(1); _Pragma("unroll") for (int m = 0; m < 4; ++m) _Pragma("unroll") for (int n = 0; n < 2; ++n) _Pragma("unroll") for (int k = 0; k < 2; ++k) \
        acc[ai][bj][m][n] = __builtin_amdgcn_mfma_f32_16x16x32_bf16(Bt[n][k], At[m][k], acc[ai][bj][m][n], 0, 0, 0); __builtin_amdgcn_s_setprio(0); } while (0)
#define PG8_WAIT_V(n) asm volatile("s_waitcnt vmcnt(" #n ")" ::: "memory")
#define PG8_WAIT_L(n) asm volatile("s_waitcnt lgkmcnt(" #n ")" ::: "memory")
#define PG8_BAR __builtin_amdgcn_s_barrier()
#define PG8_SCHED __builtin_amdgcn_sched_barrier(0)
    Unit cur, nxt; int ui = 0;
    if (!S.next(0, cur)) return;
    f32x4 acc[2][2][4][2];
#pragma unroll
    for (int a = 0; a < 2; ++a)
#pragma unroll
        for (int b = 0; b < 2; ++b)
#pragma unroll
            for (int m = 0; m < 4; ++m)
#pragma unroll
                for (int n = 0; n < 2; ++n) acc[a][b][m][n] = (f32x4){0.f, 0.f, 0.f, 0.f};
    bf16x8 At[4][2], B0[2][2], B1[2][2];
    const char* cA = (const char*)g.A + (size_t)cur.pm * tstep; const char* cB = (const char*)g.Bt + (size_t)cur.pn * tstep;
    S.a_ready(cur);
    if constexpr (SP2) {
        PG8_STAGE(PG8_SB(0, 0), cB, voffB); PG8_STAGE(PG8_SB(0, 1), cB + hstep, voffB); PG8_STAGE(PG8_SA(0, 0), cA, voffA); PG8_STAGE(PG8_SA(0, 1), cA + hstep, voffA);
        if (wr == 1) PG8_BAR;
        PG8_WAIT_V(2); PG8_BAR;
        PG8_STAGE(PG8_SB(1, 0), cB + kstep, voffB); PG8_STAGE(PG8_SA(1, 0), cA + kstep, voffA); PG8_STAGE(PG8_SB(1, 1), cB + hstep + kstep, voffB);
        PG8_WAIT_V(6); PG8_BAR;
    } else {
        PG8_STAGE(PG8_SB(0, 0), cB, voffB); PG8_STAGE(PG8_SA(0, 0), cA, voffA); PG8_STAGE(PG8_SB(0, 1), cB + hstep, voffB); PG8_STAGE(PG8_SA(0, 1), cA + hstep, voffA);
        if (wr == 1) PG8_BAR;
        PG8_WAIT_V(4); PG8_BAR;
        PG8_STAGE(PG8_SB(1, 0), cB + kstep, voffB); PG8_STAGE(PG8_SA(1, 0), cA + kstep, voffA); PG8_STAGE(PG8_SB(1, 1), cB + hstep + kstep, voffB);
        PG8_WAIT_V(6); PG8_BAR;
    }
    for (;;) {
        const bool has_next = S.next(ui + 1, nxt);
        const char* nA = has_next ? (const char*)g.A + (size_t)nxt.pm * tstep : cA; const char* nB = has_next ? (const char*)g.Bt + (size_t)nxt.pn * tstep : cB;
        for (int t = 0; t < nt; t += 2) {
            const bool last = (t == nt - 2);
            const char* a1 = cA + (size_t)(t + 1) * kstep;
            const char* a2 = last ? nA : cA + (size_t)(t + 2) * kstep; const char* b2 = last ? nB : cB + (size_t)(t + 2) * kstep;
            const char* a3 = a2 + kstep; const char* b3 = b2 + kstep;
            if (last && has_next) S.a_ready(nxt);
            if constexpr (SP2) {
            PG8_LDB(B0, 0, 0); PG8_LDB(B1, 0, 1); PG8_SCHED; PG8_LDA(At, 0, 0); PG8_STAGE(PG8_SA(1, 1), a1 + hstep, voffA);
            PG8_WAIT_V(8); PG8_WAIT_L(0); PG8_BAR; PG8_MMA(0, 0, At, B0); PG8_MMA(0, 1, At, B1); PG8_BAR; PG8_SCHED;
            PG8_LDA(At, 0, 1); PG8_STAGE(PG8_SB(0, 0), b2, voffB); PG8_STAGE(PG8_SB(0, 1), b2 + hstep, voffB); PG8_STAGE(PG8_SA(0, 0), a2, voffA);
            PG8_WAIT_V(8); PG8_WAIT_L(0); PG8_BAR; PG8_MMA(1, 0, At, B0); PG8_MMA(1, 1, At, B1); PG8_BAR; PG8_SCHED;
            PG8_LDB(B0, 1, 0); PG8_LDB(B1, 1, 1); PG8_SCHED; PG8_LDA(At, 1, 0); PG8_STAGE(PG8_SA(0, 1), a2 + hstep, voffA);
            PG8_WAIT_V(8); PG8_WAIT_L(0); PG8_BAR; PG8_MMA(0, 0, At, B0); PG8_MMA(0, 1, At, B1); PG8_BAR; PG8_SCHED;
            PG8_LDA(At, 1, 1); PG8_STAGE(PG8_SB(1, 0), b3, voffB); PG8_STAGE(PG8_SB(1, 1), b3 + hstep, voffB); PG8_STAGE(PG8_SA(1, 0), a3, voffA);
            PG8_WAIT_V(8); PG8_WAIT_L(0); PG8_BAR; PG8_MMA(1, 0, At, B0); PG8_MMA(1, 1, At, B1); PG8_BAR; PG8_SCHED;
            } else {
            PG8_LDB(B0, 0, 0); PG8_SCHED; PG8_LDA(At, 0, 0); PG8_STAGE(PG8_SA(1, 1), a1 + hstep, voffA);
            PG8_WAIT_L(8); PG8_BAR; PG8_WAIT_L(0); PG8_MMA(0, 0, At, B0); PG8_BAR; PG8_SCHED;
            PG8_LDB(B1, 0, 1); PG8_STAGE(PG8_SB(0, 0), b2, voffB);
            PG8_BAR; PG8_WAIT_L(0); PG8_MMA(0, 1, At, B1); PG8_BAR;
            PG8_LDA(At, 0, 1); PG8_STAGE(PG8_SA(0, 0), a2, voffA);
            PG8_BAR; PG8_WAIT_L(0); PG8_MMA(1, 0, At, B0); PG8_BAR; PG8_SCHED;
            PG8_STAGE(PG8_SB(0, 1), b2 + hstep, voffB);
            PG8_WAIT_V(6); PG8_BAR; PG8_MMA(1, 1, At, B1); PG8_BAR;
            PG8_LDB(B0, 1, 0); PG8_SCHED; PG8_LDA(At, 1, 0); PG8_STAGE(PG8_SA(0, 1), a2 + hstep, voffA);
            PG8_WAIT_L(8); PG8_BAR; PG8_WAIT_L(0); PG8_MMA(0, 0, At, B0); PG8_BAR; PG8_SCHED;
            PG8_LDB(B1, 1, 1); PG8_STAGE(PG8_SB(1, 0), b3, voffB);
            PG8_BAR; PG8_WAIT_L(0); PG8_MMA(0, 1, At, B1); PG8_BAR;
            PG8_LDA(At, 1, 1); PG8_STAGE(PG8_SA(1, 0), a3, voffA);
            PG8_BAR; PG8_WAIT_L(0); PG8_MMA(1, 0, At, B0); PG8_BAR; PG8_SCHED;
            PG8_STAGE(PG8_SB(1, 1), b3 + hstep, voffB);
            PG8_WAIT_V(6); PG8_BAR; PG8_MMA(1, 1, At, B1); PG8_BAR;
            }
        }
        if constexpr (ALIGN_EPI) { if (wr == 0) PG8_BAR; }
        if constexpr (!Epi::AFTER_DRAIN) { E(acc, cur, wr, wc, fr, fq); S.done(cur); }
        if (!has_next) break;
#pragma unroll
        for (int a = 0; a < 2; ++a)
#pragma unroll
            for (int b = 0; b < 2; ++b)
#pragma unroll
                for (int m = 0; m < 4; ++m)
#pragma unroll
                    for (int n = 0; n < 2; ++n) acc[a][b][m][n] = (f32x4){0.f, 0.f, 0.f, 0.f};
        cur = nxt; cA = nA; cB = nB; ++ui;
        if constexpr (ALIGN_EPI) { if (wr == 1) PG8_BAR; }
    }
    PG8_WAIT_V(0);
    if constexpr (!ALIGN_EPI) { if (wr == 0) PG8_BAR; }
    PG8_BAR;
    if constexpr (Epi::AFTER_DRAIN) { E.fused(acc, cur, wr, wc, fr, fq, lds, wid, lane); S.done(cur); }
#undef PG8_SA
#undef PG8_SB
#undef PG8_STAGE
#undef PG8_LDA
#undef PG8_LDB
#undef PG8_MMA
#undef PG8_WAIT_V
#undef PG8_WAIT_L
#undef PG8_BAR
#undef PG8_SCHED
}
}

#define GAS __attribute__((address_space(1)))
#define LAS __attribute__((address_space(3)))
typedef unsigned short bf16_t;
typedef unsigned u32x4 __attribute__((ext_vector_type(4)));
typedef unsigned u32x2 __attribute__((ext_vector_type(2)));
typedef int i32x4 __attribute__((ext_vector_type(4)));
typedef float f32x4 __attribute__((ext_vector_type(4)));
typedef float f32x16 __attribute__((ext_vector_type(16)));
typedef short bf16x8 __attribute__((ext_vector_type(8)));
using pg8::cvt_pk_bf16; using pg8::bf_lo; using pg8::bf_hi;

constexpr int NWAVES = 8, NTHREADS = 512;
constexpr int BATCH = 8, SEQ = 2048, DM = 2048, M = BATCH * SEQ, DFF = 5632;
constexpr int NIN = 3904, NIN_PAD = 4096;
constexpr float EPS = 1e-6f, LOG2E = 1.44269504088896f;
constexpr float QSCALE_A = 0.125f * LOG2E;
constexpr float QSCALE_B = 0.07216878364870322f * LOG2E;
constexpr float LAM_INIT = 0.2f;

constexpr size_t MiB = 1u << 20;
constexpr size_t WS_WGATE = 1 * MiB, WS_WUP = 23 * MiB, WS_WDOWN = 45 * MiB;
constexpr size_t WS_H = 67 * MiB;
constexpr size_t WS_BIG = 131 * MiB;
constexpr size_t WS_WIN = WS_BIG + 0, WS_WUQ = WS_BIG + 16 * MiB, WS_WUKV = WS_BIG + 18 * MiB, WS_WOUT = WS_BIG + 19 * MiB;
constexpr size_t WS_PROJ = WS_BIG + 27 * MiB;
constexpr size_t WS_QLAT = WS_BIG + 27 * MiB, WS_KVRAW = WS_BIG + 75 * MiB;
constexpr size_t WS_AO = WS_BIG + 27 * MiB;
constexpr size_t WS_DQ = WS_BIG + 149 * MiB, WS_DK = WS_BIG + 181 * MiB, WS_DVT = WS_BIG + 213 * MiB;
constexpr size_t WS_CQN = WS_BIG + 245 * MiB, WS_CKVN = WS_BIG + 261 * MiB, WS_KR = WS_BIG + 269 * MiB;
constexpr size_t DO_MQ = 0, DO_MK = 48 * MiB, DO_MVT = 96 * MiB;
constexpr size_t WS_G = WS_BIG, WS_ACT = WS_BIG + 176 * MiB;
constexpr size_t WS_WCIN = WS_BIG, WS_WCOUT = WS_BIG + 24 * MiB, WS_P = WS_BIG + 32 * MiB, WS_Z = WS_BIG + 96 * MiB;
constexpr size_t WS_END = WS_BIG + 352 * MiB;

constexpr int RING_BYTES = 131072;
constexpr int LDS_BYTES = 147456;

struct Args {
    const float* in[29]; float* out; unsigned char* ws;
};
#define CAS __attribute__((address_space(4)))
typedef const CAS Args* ArgP;

__device__ __forceinline__ float wave_sum(float v) {
#pragma unroll
    for (int o = 1; o < 64; o <<= 1) v += __shfl_xor(v, o);
    return v;
}
#define LDS_WAIT() asm volatile("s_waitcnt lgkmcnt(0)" ::: "memory")

#define TW_LOAD(it_, dst_, g0_, g1_) do { const int kb_ = (it_) / nblk, nb_ = (it_) % nblk, k0_ = 64 * kb_, n0_ = 32 * nb_; \
        _Pragma("unroll") for (int i_ = 0; i_ < 32; ++i_) { const int kk_ = 2 * i_ + (lane >> 5); dst_[i_] = W[(size_t)(k0_ + kk_) * N + n0_ + (lane & 31)]; } \
        if (gk) { g0_ = *(const f32x4*)(gk + k0_ + 8 * c); g1_ = *(const f32x4*)(gk + k0_ + 8 * c + 4); } } while (0)
template <int MODE>
__device__ __forceinline__ void transpose_weight(const float* W, int K, int N, bf16_t* WT, LAS float* scr, int gw, int NGW, int lane, const float* gk = nullptr) {
    const int nblk = N / 32, nitems = (K / 64) * nblk;
    const int c = lane & 7;
    float cur[32], nxt[32];
    f32x4 gc0 = {1.f, 1.f, 1.f, 1.f}, gc1 = gc0, gn0 = gc0, gn1 = gc0;
    int it = gw;
    if (it < nitems) TW_LOAD(it, cur, gc0, gc1);
    while (it < nitems) {
        const int itn = it + NGW;
        if (itn < nitems) TW_LOAD(itn, nxt, gn0, gn1);
        const int kb = it / nblk, nb = it % nblk, k0 = 64 * kb, n0 = 32 * nb;
        int drow = n0;
        if (MODE == 1) { if (n0 < 2048) drow = 4096 + n0; else if (n0 < 4096) { const int cc = n0 - 2048; drow = (cc >> 7) * 256 + (cc & 127); } else { const int cc = n0 - 4096; drow = (cc >> 7) * 256 + 128 + (cc & 127); } }
#pragma unroll
        for (int i = 0; i < 32; ++i) { const int kk = 2 * i + (lane >> 5); scr[kk * 33 + (lane & 31)] = cur[i]; }
        LDS_WAIT(); asm volatile("" ::: "memory");
#pragma unroll
        for (int j = 0; j < 4; ++j) { const int n = (lane >> 3) + 8 * j; const LAS float* sp = scr + (8 * c) * 33 + n;
            u32x4 o; o.x = cvt_pk_bf16(sp[0 * 33] * gc0[0], sp[1 * 33] * gc0[1]); o.y = cvt_pk_bf16(sp[2 * 33] * gc0[2], sp[3 * 33] * gc0[3]);
            o.z = cvt_pk_bf16(sp[4 * 33] * gc1[0], sp[5 * 33] * gc1[1]); o.w = cvt_pk_bf16(sp[6 * 33] * gc1[2], sp[7 * 33] * gc1[3]);
            *(u32x4*)(WT + (size_t)(drow + n) * K + k0 + 8 * c) = o; }
        LDS_WAIT(); asm volatile("" ::: "memory");
#pragma unroll
        for (int i = 0; i < 32; ++i) cur[i] = nxt[i];
        gc0 = gn0; gc1 = gn1; it = itn;
    }
}
__device__ __forceinline__ void rms_row_to_bf16(const float* xrow, const float* g, bf16_t* orow, int lane) {
    const f32x4* xr = (const f32x4*)xrow + lane; const f32x4* gr = (const f32x4*)g + lane;
    f32x4 v[8]; float s = 0.f;
#pragma unroll
    for (int j = 0; j < 8; ++j) { v[j] = xr[64 * j]; s += (v[j].x * v[j].x + v[j].y * v[j].y) + (v[j].z * v[j].z + v[j].w * v[j].w); }
    const float rstd = 1.0f / sqrtf(wave_sum(s) * (1.0f / DM) + EPS);
    u32x2* o8 = (u32x2*)orow + lane;
#pragma unroll
    for (int j = 0; j < 8; ++j) { const f32x4 gg = gr[64 * j]; u32x2 w; w.x = cvt_pk_bf16(v[j].x * rstd * gg.x, v[j].y * rstd * gg.y); w.y = cvt_pk_bf16(v[j].z * rstd * gg.z, v[j].w * rstd * gg.w); o8[64 * j] = w; }
}
__device__ __forceinline__ void rms_phase(const float* X, const float* g, bf16_t* H, int gw, int NGW, int lane) {
    for (int m = gw; m < M; m += 2 * NGW) {
        const int m2 = m + NGW; const bool two = m2 < M;
        const f32x4* xa = (const f32x4*)(X + (size_t)m * DM) + lane; const f32x4* xb = (const f32x4*)(X + (size_t)(two ? m2 : m) * DM) + lane; const f32x4* gr = (const f32x4*)g + lane;
        f32x4 va[8], vb[8]; float sa = 0.f, sb = 0.f;
#pragma unroll
        for (int j = 0; j < 8; ++j) { va[j] = xa[64 * j]; vb[j] = xb[64 * j]; }
#pragma unroll
        for (int j = 0; j < 8; ++j) { sa += (va[j].x * va[j].x + va[j].y * va[j].y) + (va[j].z * va[j].z + va[j].w * va[j].w); sb += (vb[j].x * vb[j].x + vb[j].y * vb[j].y) + (vb[j].z * vb[j].z + vb[j].w * vb[j].w); }
        const float ra = 1.0f / sqrtf(wave_sum(sa) * (1.0f / DM) + EPS), rb = 1.0f / sqrtf(wave_sum(sb) * (1.0f / DM) + EPS);
        u32x2* oa = (u32x2*)(H + (size_t)m * DM) + lane; u32x2* ob = (u32x2*)(H + (size_t)m2 * DM) + lane;
#pragma unroll
        for (int j = 0; j < 8; ++j) { const f32x4 gg = gr[64 * j]; u32x2 w; w.x = cvt_pk_bf16(va[j].x * ra * gg.x, va[j].y * ra * gg.y); w.y = cvt_pk_bf16(va[j].z * ra * gg.z, va[j].w * ra * gg.w); oa[64 * j] = w;
            if (two) { u32x2 w2; w2.x = cvt_pk_bf16(vb[j].x * rb * gg.x, vb[j].y * rb * gg.y); w2.y = cvt_pk_bf16(vb[j].z * rb * gg.z, vb[j].w * rb * gg.w); ob[64 * j] = w2; } }
    }
}

__device__ __forceinline__ int perm16(int w) { return (w & 3) | (((w >> 3) & 1) << 2) | (((w >> 2) & 1) << 3); }

__device__ __forceinline__ void vt_tile8(const bf16_t* src, int ld, int hstride, bf16_t* vt, int t0, LAS unsigned char* lds, int tid) {
    LAS bf16_t* T = (LAS bf16_t*)lds;
    u32x4 v[2][8];
#pragma unroll
    for (int hb = 0; hb < 2; ++hb)
#pragma unroll
        for (int i = 0; i < 8; ++i) { const int c = tid + i * NTHREADS, r = c >> 6, hc = c & 63, hq = hc >> 4, cc = hc & 15; v[hb][i] = *(const u32x4*)(src + (size_t)r * ld + (hb * 4 + hq) * hstride + cc * 8); }
#pragma unroll
    for (int hb = 0; hb < 2; ++hb) {
#pragma unroll
        for (int i = 0; i < 8; ++i) { const int c = tid + i * NTHREADS, r = c >> 6, hc = c & 63; *(LAS u32x4*)(T + r * 520 + hc * 8) = v[hb][i]; }
        __syncthreads();
#pragma unroll
        for (int i = 0; i < 8; ++i) { const int c = tid + i * NTHREADS, hq = c >> 10, dv = (c >> 3) & 127, q8 = c & 7, blk = q8 >> 1, hh = q8 & 1;
            unsigned e[8];
#pragma unroll
            for (int j = 0; j < 8; ++j) { const int key = blk * 16 + 8 * (j >> 2) + 4 * hh + (j & 3); e[j] = T[key * 520 + hq * 128 + dv]; }
            u32x4 o; o.x = e[0] | (e[1] << 16); o.y = e[2] | (e[3] << 16); o.z = e[4] | (e[5] << 16); o.w = e[6] | (e[7] << 16);
            *(u32x4*)(vt + (size_t)((hb * 4 + hq) * 128 + dv) * SEQ + t0 + blk * 16 + hh * 8) = o; }
        __syncthreads();
    }
}

__device__ __forceinline__ void p2_phase(ArgP ap, LAS unsigned char* lds, int tid, int wid, int lane) {
    unsigned char* ws = ap->ws;
    const bf16_t* PROJ = (const bf16_t*)(ws + WS_PROJ);
    bf16_t* DQ = (bf16_t*)(ws + WS_DQ); bf16_t* DK = (bf16_t*)(ws + WS_DK); bf16_t* DVT = (bf16_t*)(ws + WS_DVT);
    bf16_t* CQN = (bf16_t*)(ws + WS_CQN); bf16_t* CKVN = (bf16_t*)(ws + WS_CKVN); bf16_t* KR = (bf16_t*)(ws + WS_KR);
    const float* dq_g = ap->in[5]; const float* dk_g = ap->in[6]; const float* qa_g = ap->in[12]; const float* kva_g = ap->in[14];
    for (int u = blockIdx.x; u < M / 64; u += gridDim.x) {
        const int tok0 = u * 64;
        for (int i = 0; i < 8; ++i) {
            const int row = tok0 + wid * 8 + i; const bf16_t* p = PROJ + (size_t)row * NIN;
#pragma unroll
            for (int part = 0; part < 2; ++part) {
                const float* g = part ? dk_g : dq_g; const float sc = part ? 1.0f : QSCALE_A; bf16_t* dst = (part ? DK : DQ) + (size_t)row * 1024;
#pragma unroll
                for (int c = 0; c < 2; ++c) {
                    const u32x4 v = *(const u32x4*)(p + part * 1024 + c * 512 + lane * 8);
                    float f[8]; float ss = 0.f;
#pragma unroll
                    for (int q = 0; q < 4; ++q) { f[2 * q] = bf_lo(v[q]); f[2 * q + 1] = bf_hi(v[q]); ss += f[2 * q] * f[2 * q] + f[2 * q + 1] * f[2 * q + 1]; }
                    ss += __shfl_xor(ss, 1); ss += __shfl_xor(ss, 2); ss += __shfl_xor(ss, 4);
                    const float rstd = sc / sqrtf(ss * (1.0f / 64.0f) + EPS);
                    const float* gg = g + (lane & 7) * 8;
                    u32x4 o;
#pragma unroll
                    for (int q = 0; q < 4; ++q) o[q] = cvt_pk_bf16(f[2 * q] * rstd * gg[2 * q], f[2 * q + 1] * rstd * gg[2 * q + 1]);
                    *(u32x4*)(dst + c * 512 + lane * 8) = o;
                }
            }
            {
                const u32x4 v = *(const u32x4*)(p + 3072 + lane * 8); float f[8]; float ss = 0.f;
#pragma unroll
                for (int q = 0; q < 4; ++q) { f[2 * q] = bf_lo(v[q]); f[2 * q + 1] = bf_hi(v[q]); ss += f[2 * q] * f[2 * q] + f[2 * q + 1] * f[2 * q + 1]; }
                const float rstd = 1.0f / sqrtf(wave_sum(ss) * (1.0f / 512.0f) + EPS); const float* gg = qa_g + lane * 8; u32x4 o;
#pragma unroll
                for (int q = 0; q < 4; ++q) o[q] = cvt_pk_bf16(f[2 * q] * rstd * gg[2 * q], f[2 * q + 1] * rstd * gg[2 * q + 1]);
                *(u32x4*)(CQN + (size_t)row * 512 + lane * 8) = o;
            }
            {
                const int l2 = lane & 31; const u32x4 v = *(const u32x4*)(p + 3584 + l2 * 8); float f[8]; float ss = 0.f;
#pragma unroll
                for (int q = 0; q < 4; ++q) { f[2 * q] = bf_lo(v[q]); f[2 * q + 1] = bf_hi(v[q]); ss += f[2 * q] * f[2 * q] + f[2 * q + 1] * f[2 * q + 1]; }
                if (lane >= 32) ss = 0.f;
                const float rstd = 1.0f / sqrtf(wave_sum(ss) * (1.0f / 256.0f) + EPS); const float* gg = kva_g + l2 * 8; u32x4 o;
#pragma unroll
                for (int q = 0; q < 4; ++q) o[q] = cvt_pk_bf16(f[2 * q] * rstd * gg[2 * q], f[2 * q + 1] * rstd * gg[2 * q + 1]);
                if (lane < 32) *(u32x4*)(CKVN + (size_t)row * 256 + l2 * 8) = o;
            }
            if (lane < 8) *(u32x4*)(KR + (size_t)row * 64 + lane * 8) = *(const u32x4*)(p + 3840 + lane * 8);
        }
        const int b = tok0 / SEQ, t0 = tok0 % SEQ;
        vt_tile8(PROJ + (size_t)tok0 * NIN + 2048, NIN, 128, DVT + (size_t)(b * 8) * 128 * SEQ, t0, lds, tid);
    }
}

__device__ __forceinline__ float bfld(const bf16_t* p) { return __uint_as_float((unsigned)(*p) << 16); }
__device__ __forceinline__ void bfst(bf16_t* p, float v) { *p = (bf16_t)(cvt_pk_bf16(v, 0.f) & 0xffffu); }
__device__ __forceinline__ void p4_phase(ArgP ap, LAS unsigned char* lds, int tid, int wid, int lane) {
    unsigned char* ws = ap->ws;
    const bf16_t* QLAT = (const bf16_t*)(ws + WS_QLAT); const bf16_t* KVRAW = (const bf16_t*)(ws + WS_KVRAW); const bf16_t* KR = (const bf16_t*)(ws + WS_KR);
    bf16_t* MQ = (bf16_t*)((unsigned char*)ap->out + DO_MQ); bf16_t* MK = (bf16_t*)((unsigned char*)ap->out + DO_MK); bf16_t* MVT = (bf16_t*)((unsigned char*)ap->out + DO_MVT);
    const int* pos = (const int*)ap->in[1]; const float* mq_g = ap->in[16]; const float* mk_g = ap->in[17];
    const int l2 = lane & 31; const bool lo = lane < 32;
    const float inv_freq = __builtin_amdgcn_exp2f(-(float)l2 * 0.41524101186092029f);
    const float gq0 = mq_g[lane], gq1 = mq_g[64 + lane], gq2 = mq_g[128 + l2], gq3 = mq_g[160 + l2];
    const float gk0 = mk_g[lane], gk1 = mk_g[64 + lane], gk2 = mk_g[128 + l2], gk3 = mk_g[160 + l2];
    for (int u = blockIdx.x; u < M / 64; u += gridDim.x) {
        const int tok0 = u * 64;
        for (int i = 0; i < 8; i += 2) {
            float qe0[2][8], qe1[2][8], qx1[2][8], qx2[2][8], ke0[2][8], ke1[2][8], kr1[2], kr2[2], cs[2], sn[2];
#pragma unroll
            for (int t = 0; t < 2; ++t) {
                const int row = tok0 + wid * 8 + i + t;
                const float ang = (float)pos[row] * inv_freq;
                const double rev = (double)ang * 0.15915494309189535; const float fr = (float)(rev - floor(rev));
                cs[t] = __builtin_amdgcn_cosf(fr); sn[t] = __builtin_amdgcn_sinf(fr);
                kr1[t] = bfld(KR + (size_t)row * 64 + l2); kr2[t] = bfld(KR + (size_t)row * 64 + 32 + l2);
#pragma unroll
                for (int h = 0; h < 8; ++h) {
                    const bf16_t* sq = QLAT + (size_t)row * 1536 + h * 192; const bf16_t* sk = KVRAW + (size_t)row * 2048 + h * 256;
                    qe0[t][h] = bfld(sq + lane); qe1[t][h] = bfld(sq + 64 + lane); qx1[t][h] = bfld(sq + 128 + l2); qx2[t][h] = bfld(sq + 160 + l2);
                    ke0[t][h] = bfld(sk + lane); ke1[t][h] = bfld(sk + 64 + lane); }
            }
#pragma unroll
            for (int t = 0; t < 2; ++t) {
                const int row = tok0 + wid * 8 + i + t;
#pragma unroll
                for (int h = 0; h < 8; ++h) {
                    {
                        const float e0 = qe0[t][h], e1 = qe1[t][h], x1 = qx1[t][h], x2 = qx2[t][h];
                        float ss = e0 * e0 + e1 * e1 + (lo ? x1 * x1 + x2 * x2 : 0.f);
                        const float rstd = QSCALE_B / sqrtf(wave_sum(ss) * (1.0f / 192.0f) + EPS);
                        const float n1 = x1 * rstd * gq2, n2 = x2 * rstd * gq3;
                        bf16_t* d = MQ + (size_t)row * 1536 + h * 192;
                        bfst(d + lane, e0 * rstd * gq0); bfst(d + 64 + lane, e1 * rstd * gq1);
                        if (lo) { bfst(d + 128 + l2, n1 * cs[t] - n2 * sn[t]); bfst(d + 160 + l2, n2 * cs[t] + n1 * sn[t]); }
                    }
                    {
                        const float e0 = ke0[t][h], e1 = ke1[t][h];
                        float ss = e0 * e0 + e1 * e1 + (lo ? kr1[t] * kr1[t] + kr2[t] * kr2[t] : 0.f);
                        const float rstd = 1.0f / sqrtf(wave_sum(ss) * (1.0f / 192.0f) + EPS);
                        const float n1 = kr1[t] * rstd * gk2, n2 = kr2[t] * rstd * gk3;
                        bf16_t* d = MK + (size_t)row * 1536 + h * 192;
                        bfst(d + lane, e0 * rstd * gk0); bfst(d + 64 + lane, e1 * rstd * gk1);
                        if (lo) { bfst(d + 128 + l2, n1 * cs[t] - n2 * sn[t]); bfst(d + 160 + l2, n2 * cs[t] + n1 * sn[t]); }
                    }
                }
            }
        }
        const int b = tok0 / SEQ, t0 = tok0 % SEQ;
        vt_tile8(KVRAW + (size_t)tok0 * 2048 + 128, 2048, 256, MVT + (size_t)(b * 8) * 128 * SEQ, t0, lds, tid);
    }
}


constexpr size_t WS_CTL = 0, CTL_ZERO_BYTES = 16384, WS_SS = 65536;
constexpr int MISC_OFF = RING_BYTES + 320;
#define XB_TMO      128
#define XB_XCNT(j)  (256  + 64 * (j))
#define XB_XSUB(j)  (1280 + 64 * (j))
#define XB_XGEN(j)  (2304 + 64 * (j))
#define XB_TOP      3328
#define XB_TOPGEN   3392
#define XCD_BAR_WORDS 3456
#define XB_SPIN_CAP (1u << 18)

__device__ __forceinline__ unsigned xb_ld(unsigned* p)              { return __hip_atomic_load(p, __ATOMIC_RELAXED, __HIP_MEMORY_SCOPE_AGENT); }
__device__ __forceinline__ unsigned xb_add(unsigned* p, unsigned v) { return __hip_atomic_fetch_add(p, v, __ATOMIC_RELAXED, __HIP_MEMORY_SCOPE_AGENT); }
__device__ __forceinline__ unsigned xb_xcc_id() { return (unsigned)__builtin_amdgcn_s_getreg((3 << 11) | 20) & 0xFu; }
#define XB_SPIN(cond, bar) do { unsigned _sp = 0; while (cond) { __builtin_amdgcn_s_sleep(1); \
    if ((++_sp & 255u) == 0u) { if (xb_ld(&(bar)[XB_TMO])) break; if (_sp > XB_SPIN_CAP) { atomicAdd(&(bar)[XB_TMO], 1u); break; } } } } while (0)

struct XcdBarrier {
    unsigned* bar; unsigned x;
    volatile LAS unsigned* st;
};

__device__ __forceinline__ XcdBarrier xcd_barrier_post(unsigned* bar, volatile LAS unsigned* st) {
    XcdBarrier b; b.bar = bar; b.x = xb_xcc_id(); b.st = st;
    if (threadIdx.x == 0) (void)xb_add(&bar[XB_XCNT(b.x)], 1u);
    return b;
}
__device__ __forceinline__ void xcd_barrier_complete(unsigned* bar, unsigned x, unsigned& nloc, unsigned& nx) {
    const unsigned G = gridDim.x * gridDim.y * gridDim.z;
    unsigned sum, cnt, mine, sp = 0u;
    for (;;) {
        sum = 0u; cnt = 0u; mine = 0u;
#pragma unroll
        for (unsigned j = 0; j < 16; ++j) { const unsigned c = xb_ld(&bar[XB_XCNT(j)]); sum += c; cnt += (c > 0u) ? 1u : 0u; mine = (j == x) ? c : mine; }
        if (sum == G) break;
        __builtin_amdgcn_s_sleep(1);
        if ((++sp & 255u) == 0u) { if (xb_ld(&bar[XB_TMO])) break; if (sp > XB_SPIN_CAP) { atomicAdd(&bar[XB_TMO], 1u); break; } }
    }
    nloc = mine > 0u ? mine : 1u; nx = cnt > 0u ? cnt : 1u;
}

__device__ __forceinline__ void xcd_barrier(const XcdBarrier& b) {
    asm volatile("s_waitcnt vmcnt(0)" ::: "memory");
    __syncthreads();
    if (threadIdx.x == 0) {
        unsigned* bar = b.bar; asm volatile("" : "+s"(bar));
        __builtin_amdgcn_s_waitcnt(0);
        unsigned nloc = b.st[0], nx = b.st[1];
        if (nloc == 0u) { xcd_barrier_complete(bar, b.x, nloc, nx); b.st[0] = nloc; b.st[1] = nx; }
        const unsigned old = xb_add(&bar[XB_XSUB(b.x)], 1u);
        const unsigned gen = old / nloc;
        if (old + 1u == (gen + 1u) * nloc) {
            __builtin_amdgcn_fence(__ATOMIC_RELEASE, "agent");
            asm volatile("s_waitcnt vmcnt(0)" ::: "memory");
            const unsigned og = xb_add(&bar[XB_TOP], 1u);
            const unsigned tg = og / nx;
            if (og + 1u == (tg + 1u) * nx) xb_add(&bar[XB_TOPGEN], 1u);
            else XB_SPIN(xb_ld(&bar[XB_TOPGEN]) == tg, bar);
            __builtin_amdgcn_fence(__ATOMIC_ACQUIRE, "agent");
            xb_add(&bar[XB_XGEN(b.x)], 1u);
            asm volatile("s_waitcnt vmcnt(0)" ::: "memory");
        } else {
            XB_SPIN(xb_ld(&bar[XB_XGEN(b.x)]) == gen, bar);
            __builtin_amdgcn_fence(__ATOMIC_ACQUIRE, "agent");
            asm volatile("s_waitcnt vmcnt(0)" ::: "memory");
        }
    }
    __syncthreads();
}

#define MFMA32(a, b, c) __builtin_amdgcn_mfma_f32_32x32x16_bf16((a), (b), (c), 0, 0, 0)
template <bool DIFF>
__device__ __forceinline__ void attn_unit(LAS unsigned char* lds, const bf16_t* Qg, const bf16_t* Kg, const bf16_t* VTg, bf16_t* AO,
                                          const int* pos, const float* rel_table, const float* subln_g, float lam,
                                          int b, int h, int qb, int tid_in, int wid, int lane_in, bool fresh) {
    int tid = tid_in; asm volatile("" : "+v"(tid)); const int lane = tid & 63; (void)lane_in;
    constexpr int DKH = DIFF ? 64 : 192, KROW = DIFF ? 128 : 192, KSTR = KROW + 8, VSTR = 72;
    constexpr int K_BYTES = 64 * KSTR * 2, V_BYTES = 128 * VSTR * 2, BUF = K_BYTES + V_BYTES;
    constexpr int POS_OFF = 2 * BUF, LUT_OFF = POS_OFF + 8192, TMM_OFF = LUT_OFF + 1280;
    constexpr int ROWS = DIFF ? 128 : 256, QLD = DIFF ? 1024 : 1536, KLD = QLD, CPR = KROW / 8, NKC = (64 * CPR) / NTHREADS, NKS = DKH / 16;
    static_assert(TMM_OFF + 256 <= RING_BYTES, "attention LDS");
    const int r = lane & 31, hh = lane >> 5;
    const int rg = DIFF ? (wid >> 1) : wid, hf = DIFF ? (wid & 1) : 0;
    const int qrow = b * SEQ + qb * ROWS + rg * 32 + r;
    const bf16_t* Kb = Kg + (size_t)b * SEQ * KLD + h * KROW;
    const bf16_t* Vb = VTg + (size_t)(b * 8 + h) * 128 * SEQ;

    int pq4 = 0;
    if (DIFF) {
        LAS int* P4 = (LAS int*)(lds + POS_OFF); LAS float* LUT = (LAS float*)(lds + LUT_OFF);
        if (fresh) for (int i = tid; i < SEQ; i += NTHREADS) P4[i] = 4 * pos[b * SEQ + i];
        if (fresh && tid < 257) { const int rel = tid - 128, n = rel < 0 ? -rel : rel;
            const int large = 8 + (n >= 12) + (n >= 16) + (n >= 23) + (n >= 32) + (n >= 46) + (n >= 64) + (n >= 91);
            const int bucket = (rel > 0 ? 16 : 0) + (n < 8 ? n : (large < 15 ? large : 15));
            LUT[tid] = rel_table[bucket * 8 + h] * LOG2E; }
        pq4 = 4 * pos[qrow];
    }
    bf16x8 qf[NKS];
    { const bf16_t* qp = Qg + (size_t)qrow * QLD + h * KROW + hf * 64 + 8 * hh;
#pragma unroll
      for (int ks = 0; ks < NKS; ++ks) qf[ks] = *(const bf16x8*)(qp + 16 * ks); }

    u32x4 kreg[NKC], vreg[2];
    auto load_tile = [&](int kt) {
#pragma unroll
        for (int i = 0; i < NKC; ++i) { const int c = tid + i * NTHREADS, row = c / CPR, cc = c % CPR; kreg[i] = *(const u32x4*)(Kb + (size_t)(kt * 64 + row) * KLD + cc * 8); }
#pragma unroll
        for (int i = 0; i < 2; ++i) { const int c = tid + i * NTHREADS, dv = c >> 3, cc = c & 7; vreg[i] = *(const u32x4*)(Vb + (size_t)dv * SEQ + kt * 64 + cc * 8); }
    };
    auto store_tile = [&](int buf) {
        LAS unsigned char* kb_ = lds + buf * BUF; LAS unsigned char* vb_ = kb_ + K_BYTES;
#pragma unroll
        for (int i = 0; i < NKC; ++i) { const int c = tid + i * NTHREADS, row = c / CPR, cc = c % CPR; *(LAS u32x4*)(kb_ + (row * KSTR + cc * 8) * 2) = kreg[i]; }
#pragma unroll
        for (int i = 0; i < 2; ++i) { const int c = tid + i * NTHREADS, dv = c >> 3, cc = c & 7; *(LAS u32x4*)(vb_ + (dv * VSTR + cc * 8) * 2) = vreg[i]; }
    };
    load_tile(0); store_tile(0);
    __syncthreads();
    int qmin4 = 0, qmax4 = 0; float bias_lo = 0.f, bias_hi = 0.f;
    if (DIFF) {
        if (fresh && tid < SEQ / 64) { const LAS int* P4 = (const LAS int*)(lds + POS_OFF) + tid * 64; int mn = P4[0], mx_ = P4[0];
            for (int i = 1; i < 64; ++i) { const int v = P4[i]; mn = v < mn ? v : mn; mx_ = v > mx_ ? v : mx_; }
            ((LAS int*)(lds + TMM_OFF))[2 * tid] = mn; ((LAS int*)(lds + TMM_OFF))[2 * tid + 1] = mx_; }
        qmin4 = pq4; qmax4 = pq4;
#pragma unroll
        for (int o = 1; o < 64; o <<= 1) { const int a_ = __shfl_xor(qmin4, o), b_ = __shfl_xor(qmax4, o); qmin4 = a_ < qmin4 ? a_ : qmin4; qmax4 = b_ > qmax4 ? b_ : qmax4; }
        bias_lo = *(const LAS float*)(lds + LUT_OFF);
        bias_hi = *(const LAS float*)(lds + LUT_OFF + 1024);
        __syncthreads();
    }

    f32x16 O[4];
#pragma unroll
    for (int d = 0; d < 4; ++d)
#pragma unroll
        for (int i = 0; i < 16; ++i) O[d][i] = 0.f;
    float m_used = -INFINITY, lsum = 0.f;

    for (int kt = 0; kt < SEQ / 64; ++kt) {
        const bool more = kt + 1 < SEQ / 64;
        if (more) load_tile(kt + 1);
        LAS unsigned char* kbuf = lds + (kt & 1) * BUF; LAS unsigned char* vbuf = kbuf + K_BYTES;
        f32x16 s[2];
        if (DIFF) {
            const int tmn = ((const LAS int*)(lds + TMM_OFF))[2 * kt], tmx = ((const LAS int*)(lds + TMM_OFF))[2 * kt + 1];
            const bool far_hi = __builtin_amdgcn_readfirstlane(tmn - qmax4) >= 512, far_lo = __builtin_amdgcn_readfirstlane(tmx - qmin4) <= -512;
            if (far_hi || far_lo) {
                const float cb = far_hi ? bias_hi : bias_lo;
#pragma unroll
                for (int kb = 0; kb < 2; ++kb)
#pragma unroll
                    for (int i = 0; i < 16; ++i) s[kb][i] = cb;
            } else {
#pragma unroll
                for (int kb = 0; kb < 2; ++kb) {
                    const LAS int* P4 = (const LAS int*)(lds + POS_OFF) + kt * 64 + 32 * kb + 4 * hh;
#pragma unroll
                    for (int g = 0; g < 4; ++g) { const i32x4 pk = *(const LAS i32x4*)(P4 + 8 * g);
#pragma unroll
                        for (int j = 0; j < 4; ++j) { int d = pk[j] - pq4; d = d < -512 ? -512 : (d > 512 ? 512 : d); s[kb][4 * g + j] = *(const LAS float*)(lds + LUT_OFF + 512 + d); } }
                }
            }
        } else {
#pragma unroll
            for (int kb = 0; kb < 2; ++kb)
#pragma unroll
                for (int i = 0; i < 16; ++i) s[kb][i] = 0.f;
        }
        {
            const LAS unsigned char* kp0 = kbuf + (r * KSTR + hf * 64 + 8 * hh) * 2; const LAS unsigned char* kp1 = kp0 + 32 * KSTR * 2;
#pragma unroll
            for (int ks = 0; ks < NKS; ++ks) { const bf16x8 kf0 = *(const LAS bf16x8*)(kp0 + 32 * ks), kf1 = *(const LAS bf16x8*)(kp1 + 32 * ks);
                s[0] = MFMA32(kf0, qf[ks], s[0]); s[1] = MFMA32(kf1, qf[ks], s[1]); }
        }
        float mx = s[0][0];
#pragma unroll
        for (int i = 1; i < 16; ++i) mx = fmaxf(mx, s[0][i]);
#pragma unroll
        for (int i = 0; i < 16; ++i) mx = fmaxf(mx, s[1][i]);
        mx = fmaxf(mx, __shfl_xor(mx, 32));
        const bool need = mx > m_used + 8.0f;
        if (__builtin_amdgcn_ballot_w64(need) != 0ull) {
            const float m_new = need ? mx : m_used;
            const float alpha = __builtin_amdgcn_exp2f(m_used - m_new);
            lsum *= alpha;
#pragma unroll
            for (int d = 0; d < 4; ++d) O[d] = O[d] * alpha;
            m_used = m_new;
        }
#pragma unroll
        for (int kb = 0; kb < 2; ++kb)
#pragma unroll
            for (int i = 0; i < 16; ++i) { const float p = __builtin_amdgcn_exp2f(s[kb][i] - m_used); s[kb][i] = p; lsum += p; }
#pragma unroll
        for (int kb = 0; kb < 2; ++kb)
#pragma unroll
            for (int st = 0; st < 2; ++st) {
                u32x4 pw;
#pragma unroll
                for (int q = 0; q < 4; ++q) pw[q] = cvt_pk_bf16(s[kb][8 * st + 2 * q], s[kb][8 * st + 2 * q + 1]);
                const bf16x8 pf = __builtin_bit_cast(bf16x8, pw);
                const LAS unsigned char* vp = vbuf + (r * VSTR + (2 * kb + st) * 16 + 8 * hh) * 2;
#pragma unroll
                for (int d = 0; d < 4; ++d) { const bf16x8 vf = *(const LAS bf16x8*)(vp + d * 32 * VSTR * 2); O[d] = MFMA32(vf, pf, O[d]); }
            }
        if (more) store_tile((kt + 1) & 1);
        __syncthreads();
    }
    const float ltot = lsum + __shfl_xor(lsum, 32);
    const float inv = 1.0f / ltot;
    if (DIFF) {
        LAS float* XO = (LAS float*)lds + (size_t)rg * 64 * 64 + lane;
        if (hf == 1) {
#pragma unroll
            for (int d = 0; d < 4; ++d)
#pragma unroll
                for (int i = 0; i < 16; ++i) XO[(d * 16 + i) * 64] = O[d][i] * inv;
        }
        __syncthreads();
        if (hf == 0) {
            float ss = 0.f;
#pragma unroll
            for (int d = 0; d < 4; ++d)
#pragma unroll
                for (int i = 0; i < 16; ++i) { const float o = O[d][i] * inv - lam * XO[(d * 16 + i) * 64]; O[d][i] = o; ss += o * o; }
            ss += __shfl_xor(ss, 32);
            const float rstd = (1.0f - LAM_INIT) / sqrtf(ss * (1.0f / 128.0f) + EPS);
            bf16_t* op = AO + (size_t)qrow * 2048 + h * 128 + 4 * hh;
#pragma unroll
            for (int d = 0; d < 4; ++d)
#pragma unroll
                for (int g = 0; g < 4; ++g) { const f32x4 gg = *(const f32x4*)(subln_g + 32 * d + 8 * g + 4 * hh);
                    u32x2 w; w.x = cvt_pk_bf16(O[d][4 * g] * rstd * gg.x, O[d][4 * g + 1] * rstd * gg.y); w.y = cvt_pk_bf16(O[d][4 * g + 2] * rstd * gg.z, O[d][4 * g + 3] * rstd * gg.w);
                    *(u32x2*)(op + 32 * d + 8 * g) = w; }
        }
        __syncthreads();
    } else {
        bf16_t* op = AO + (size_t)qrow * 2048 + 1024 + h * 128 + 4 * hh;
#pragma unroll
        for (int d = 0; d < 4; ++d)
#pragma unroll
            for (int g = 0; g < 4; ++g) { u32x2 w; w.x = cvt_pk_bf16(O[d][4 * g] * inv, O[d][4 * g + 1] * inv); w.y = cvt_pk_bf16(O[d][4 * g + 2] * inv, O[d][4 * g + 3] * inv);
                *(u32x2*)(op + 32 * d + 8 * g) = w; }
    }
}

__device__ __forceinline__ void attn_phase_mla(ArgP ap, LAS unsigned char* lds, int tid, int wid, int lane) {
    const bf16_t* MQ = (const bf16_t*)((unsigned char*)ap->out + DO_MQ); const bf16_t* MK = (const bf16_t*)((unsigned char*)ap->out + DO_MK); const bf16_t* MVT = (const bf16_t*)((unsigned char*)ap->out + DO_MVT);
    bf16_t* AO = (bf16_t*)(ap->ws + WS_AO);
    const int G = gridDim.x, bx = blockIdx.x, v = (G % 8 == 0) ? (bx % 8) * (G / 8) + bx / 8 : bx;
    const bool fast = (512 % G == 0); const int per = fast ? 512 / G : 0;
    for (int i = 0; ; ++i) { int u; if (fast) { if (i >= per) break; u = v * per + i; } else { u = bx + i * G; if (u >= 512) break; }
        const int qb = u & 7, h = (u >> 3) & 7, b = u >> 6;
        attn_unit<false>(lds, MQ, MK, MVT, AO, nullptr, nullptr, nullptr, 0.f, b, h, qb, tid, wid, lane, true); }
}
__device__ __forceinline__ void attn_phase_diff(ArgP ap, LAS unsigned char* lds, int tid, int wid, int lane) {
    unsigned char* ws = ap->ws;
    const bf16_t* DQ = (const bf16_t*)(ws + WS_DQ); const bf16_t* DK = (const bf16_t*)(ws + WS_DK); const bf16_t* DVT = (const bf16_t*)(ws + WS_DVT);
    bf16_t* AO = (bf16_t*)(ws + WS_AO);
    const int* pos = (const int*)ap->in[1];
    float d1 = 0.f, d2 = 0.f;
    { const float q1 = ap->in[7][lane], k1 = ap->in[8][lane], q2 = ap->in[9][lane], k2 = ap->in[10][lane]; d1 = wave_sum(q1 * k1); d2 = wave_sum(q2 * k2); }
    const float lam = expf(d1) - expf(d2) + LAM_INIT;
    const int G = gridDim.x, bx = blockIdx.x, v = (G % 8 == 0) ? (bx % 8) * (G / 8) + bx / 8 : bx;
    const bool fast = (1024 % G == 0 && 1024 / G <= 16 && 16 % (1024 / G) == 0); const int per = fast ? 1024 / G : 0;
    for (int i = 0; ; ++i) { int u; bool fresh; if (fast) { if (i >= per) break; u = v * per + i; fresh = (i == 0); } else { u = bx + i * G; if (u >= 1024) break; fresh = true; }
        const int qb = u & 15, h = (u >> 4) & 7, b = u >> 7;
        attn_unit<true>(lds, DQ, DK, DVT, AO, pos, ap->in[2], ap->in[11], lam, b, h, qb, tid, wid, lane, fresh); }
}

__global__ void __launch_bounds__(NTHREADS, 2) fwd_megakernel(Args a) {
    extern __shared__ __attribute__((aligned(16))) unsigned char lds_raw[];
    LAS unsigned char* lds = (LAS unsigned char*)lds_raw;
    cg::grid_group grid = cg::this_grid();
    if (gridDim.x == 0x7fffffffu) grid.sync();
    { int t_ = threadIdx.x; if (t_ < 32) ((volatile LAS unsigned*)(lds + MISC_OFF))[t_] = 0u; }
    __syncthreads();
    XcdBarrier bar;
    { ArgP ap0 = (ArgP)__builtin_amdgcn_kernarg_segment_ptr(); bar = xcd_barrier_post((unsigned*)(ap0->ws + WS_CTL), (volatile LAS unsigned*)(lds + MISC_OFF) + 8); }
#define ARGP() ArgP ap = (ArgP)__builtin_amdgcn_kernarg_segment_ptr(); asm volatile("" : "+s"(ap)); unsigned char* ws = ap->ws; (void)ws; bf16_t* H = (bf16_t*)(ws + WS_H); bf16_t* WG = (bf16_t*)(ws + WS_WGATE); bf16_t* WU = (bf16_t*)(ws + WS_WUP); bf16_t* WD = (bf16_t*)(ws + WS_WDOWN); (void)H; (void)WG; (void)WU; (void)WD;
#define FRESH_IDS() int tid = threadIdx.x; asm volatile("" : "+v"(tid)); const int lane = tid & 63, wid = __builtin_amdgcn_readfirstlane(tid >> 6); const int gw = blockIdx.x * NWAVES + wid; (void)gw; (void)lane;
    const int G = gridDim.x, NGW = G * NWAVES;
    typedef pg8::StaticOrder SO;

#ifndef PH_MASK
#define PH_MASK 0xffffffffu
#endif
#define PH(k) if ((PH_MASK >> (k)) & 1u)
    PH(0) { FRESH_IDS(); ARGP(); LAS float* scr = (LAS float*)(lds + wid * 16384);
    { f32x4* z = (f32x4*)(ws + WS_SS); const f32x4 z4 = {0.f, 0.f, 0.f, 0.f}; for (int i = gw * 64 + lane; i < 3 * M / 4; i += NGW * 64) z[i] = z4; }
    transpose_weight<0>(ap->in[4], DM, NIN, (bf16_t*)(ws + WS_WIN), scr, gw, NGW, lane);
    transpose_weight<0>(ap->in[13], 512, 1536, (bf16_t*)(ws + WS_WUQ), scr, gw, NGW, lane);
    transpose_weight<0>(ap->in[15], 256, 2048, (bf16_t*)(ws + WS_WUKV), scr, gw, NGW, lane);
    transpose_weight<0>(ap->in[18], DM, DM, (bf16_t*)(ws + WS_WOUT), scr, gw, NGW, lane);
    transpose_weight<0>(ap->in[24], DM, DFF, WG, scr, gw, NGW, lane, ap->in[23]);
    transpose_weight<0>(ap->in[25], DM, DFF, WU, scr, gw, NGW, lane, ap->in[23]);
    transpose_weight<0>(ap->in[28], DFF, DM, WD, scr, gw, NGW, lane);
    rms_phase(ap->in[0], ap->in[3], H, gw, NGW, lane); }
    xcd_barrier(bar);
    PH(1) { ARGP(); pg8::Gemm g{H, (const bf16_t*)(ws + WS_WIN), M, NIN_PAD, DM}; SO S; S.init(M, NIN_PAD, G, (int)blockIdx.x);
      pg8::EpiStoreBf16 E{(bf16_t*)(ws + WS_PROJ), NIN, NIN, nullptr};
      pg8::gemm_phase<pg8::EpiStoreBf16, SO, true, true>(lds, g, S, E); }
    xcd_barrier(bar);
    PH(2) { FRESH_IDS(); ARGP(); p2_phase(ap, lds, tid, wid, lane); }
    xcd_barrier(bar);
    PH(3) { ARGP(); pg8::Gemm g{(const bf16_t*)(ws + WS_CQN), (const bf16_t*)(ws + WS_WUQ), M, 1536, 512}; SO S; S.init(M, 1536, G, (int)blockIdx.x);
      pg8::EpiStoreBf16 E{(bf16_t*)(ws + WS_QLAT), 1536, 1536, nullptr};
      pg8::gemm_phase<pg8::EpiStoreBf16, SO, true, true>(lds, g, S, E); }
    PH(3) { ARGP(); pg8::Gemm g{(const bf16_t*)(ws + WS_CKVN), (const bf16_t*)(ws + WS_WUKV), M, 2048, 256}; SO S; S.init(M, 2048, G, (int)blockIdx.x);
      pg8::EpiStoreBf16 E{(bf16_t*)(ws + WS_KVRAW), 2048, 2048, nullptr};
      pg8::gemm_phase<pg8::EpiStoreBf16, SO, true, true>(lds, g, S, E); }
    xcd_barrier(bar);
    PH(4) { FRESH_IDS(); ARGP(); p4_phase(ap, lds, tid, wid, lane); }
    xcd_barrier(bar);
    PH(5) { FRESH_IDS(); ARGP(); attn_phase_mla(ap, lds, tid, wid, lane); }
    PH(5) { FRESH_IDS(); ARGP(); attn_phase_diff(ap, lds, tid, wid, lane); }
    xcd_barrier(bar);
    PH(6) { ARGP(); pg8::Gemm g{(const bf16_t*)(ws + WS_AO), (const bf16_t*)(ws + WS_WOUT), M, DM, DM}; SO S; S.init(M, DM, G, (int)blockIdx.x);
      pg8::EpiResidF32 E{ap->in[0], ap->out, DM, H, (float*)(ws + WS_SS)};
      pg8::gemm_phase<pg8::EpiResidF32, SO, true, true>(lds, g, S, E); }
    xcd_barrier(bar);
    {
        if (0 == 1) {
            PH(7) { FRESH_IDS(); ARGP(); LAS float* scr = (LAS float*)(lds + wid * 16384);
            transpose_weight<1>(ap->in[20], DM, 3 * DM, (bf16_t*)(ws + WS_WCIN), scr, gw, NGW, lane, ap->in[19]);
            transpose_weight<0>(ap->in[22], DM, DM, (bf16_t*)(ws + WS_WCOUT), scr, gw, NGW, lane);
            transpose_weight<0>(ap->in[24] + (size_t)DM * DFF, DM, DFF, WG, scr, gw, NGW, lane, ap->in[23] + DM);
            transpose_weight<0>(ap->in[25] + (size_t)DM * DFF, DM, DFF, WU, scr, gw, NGW, lane, ap->in[23] + DM);
            transpose_weight<0>(ap->in[28] + (size_t)DM * DFF, DFF, DM, WD, scr, gw, NGW, lane); }
            xcd_barrier(bar);
            PH(8) { ARGP(); pg8::Gemm g{H, (const bf16_t*)(ws + WS_WCIN), M, 2 * DM, DM}; SO S; S.init(M, 2 * DM, G, (int)blockIdx.x);
              pg8::EpiMulBf16 E{(bf16_t*)(ws + WS_P), DM, (const float*)(ws + WS_SS) + M};
              pg8::gemm_phase<pg8::EpiMulBf16, SO, true, true>(lds, g, S, E); }
            xcd_barrier(bar);
            PH(9) { ARGP(); pg8::Gemm g{H, (const bf16_t*)(ws + WS_WCIN) + (size_t)2 * DM * DM, M, DM, DM}; SO S; S.init(M, DM, G, (int)blockIdx.x);
              pg8::EpiConvGate<false> E{(const bf16_t*)(ws + WS_P), ap->in[21], nullptr, (bf16_t*)(ws + WS_Z), DM, SEQ, (const float*)(ws + WS_SS) + M};
              pg8::gemm_phase<pg8::EpiConvGate<false>, SO, true, true>(lds, g, S, E); }
            xcd_barrier(bar);
            PH(10) { ARGP(); pg8::Gemm g{(const bf16_t*)(ws + WS_Z), (const bf16_t*)(ws + WS_WCOUT), M, DM, DM}; SO S; S.init(M, DM, G, (int)blockIdx.x);
              pg8::EpiResidF32 E{ap->out, ap->out, DM, H, (float*)(ws + WS_SS) + 2 * M};
              pg8::gemm_phase<pg8::EpiResidF32, SO, true, true>(lds, g, S, E); }
            xcd_barrier(bar);
        }
        constexpr int NA = 20 * 256, NR = 2 * 256;
        PH(12) { ARGP(); pg8::Gemm g{H, WG, M, NA, DM}; SO S; S.init(M, NA, G, (int)blockIdx.x);
          pg8::EpiStoreBf16 E{(bf16_t*)(ws + WS_G), DFF, NA, (const float*)(ws + WS_SS) + (0 ? 2 * M : 0)};
          pg8::gemm_phase<pg8::EpiStoreBf16, SO, true, true>(lds, g, S, E); }
        xcd_barrier(bar);
        PH(12) { ARGP(); const int half = G / 2; const float* ssp = (const float*)(ws + WS_SS) + (0 ? 2 * M : 0);
          if ((int)blockIdx.x < half) {
            pg8::Gemm g{H, WG + (size_t)NA * DM, M, NR, DM}; pg8::SubsetOrder S{(M / 256) * 2, 2, half, (int)blockIdx.x};
            pg8::EpiStoreBf16 E{(bf16_t*)(ws + WS_G) + NA, DFF, NR, ssp};
            pg8::gemm_phase<pg8::EpiStoreBf16, pg8::SubsetOrder, true, true>(lds, g, S, E);
          } else {
            pg8::Gemm g{H, WU, M, NR, DM}; pg8::SubsetOrder S{(M / 256) * 2, 2, G - half, (int)blockIdx.x - half};
            pg8::EpiConvGate<true> E{(const bf16_t*)(ws + WS_G), ap->in[26] + (size_t)0 * 3 * DFF, ap->in[27] + (size_t)0 * DFF, (bf16_t*)(ws + WS_ACT), DFF, SEQ, ssp};
            pg8::gemm_phase<pg8::EpiConvGate<true>, pg8::SubsetOrder, true, true>(lds, g, S, E);
          } }
        xcd_barrier(bar);
        PH(13) { ARGP(); pg8::Gemm g{H, WU + (size_t)NR * DM, M, NA, DM}; SO S; S.init(M, NA, G, (int)blockIdx.x);
          pg8::EpiConvGate<true> E{(const bf16_t*)(ws + WS_G) + NR, ap->in[26] + (size_t)0 * 3 * DFF + NR, ap->in[27] + (size_t)0 * DFF + NR, (bf16_t*)(ws + WS_ACT) + NR, DFF, SEQ, (const float*)(ws + WS_SS) + (0 ? 2 * M : 0)};
          pg8::gemm_phase<pg8::EpiConvGate<true>, SO, true, true>(lds, g, S, E); }
        xcd_barrier(bar);
        PH(14) { ARGP(); pg8::Gemm g{(const bf16_t*)(ws + WS_ACT), WD, M, DM, DFF}; SO S; S.init(M, DM, G, (int)blockIdx.x);
          pg8::EpiResidF32 E{ap->out, ap->out, DM, 0 ? (bf16_t*)nullptr : H, (float*)(ws + WS_SS) + M};
          pg8::gemm_phase<pg8::EpiResidF32, SO, true, true>(lds, g, S, E); }
        if (0 == 0) xcd_barrier(bar);
    }
    {
        if (1 == 1) {
            PH(7) { FRESH_IDS(); ARGP(); LAS float* scr = (LAS float*)(lds + wid * 16384);
            transpose_weight<1>(ap->in[20], DM, 3 * DM, (bf16_t*)(ws + WS_WCIN), scr, gw, NGW, lane, ap->in[19]);
            transpose_weight<0>(ap->in[22], DM, DM, (bf16_t*)(ws + WS_WCOUT), scr, gw, NGW, lane);
            transpose_weight<0>(ap->in[24] + (size_t)DM * DFF, DM, DFF, WG, scr, gw, NGW, lane, ap->in[23] + DM);
            transpose_weight<0>(ap->in[25] + (size_t)DM * DFF, DM, DFF, WU, scr, gw, NGW, lane, ap->in[23] + DM);
            transpose_weight<0>(ap->in[28] + (size_t)DM * DFF, DFF, DM, WD, scr, gw, NGW, lane); }
            xcd_barrier(bar);
            PH(8) { ARGP(); pg8::Gemm g{H, (const bf16_t*)(ws + WS_WCIN), M, 2 * DM, DM}; SO S; S.init(M, 2 * DM, G, (int)blockIdx.x);
              pg8::EpiMulBf16 E{(bf16_t*)(ws + WS_P), DM, (const float*)(ws + WS_SS) + M};
              pg8::gemm_phase<pg8::EpiMulBf16, SO, true, true>(lds, g, S, E); }
            xcd_barrier(bar);
            PH(9) { ARGP(); pg8::Gemm g{H, (const bf16_t*)(ws + WS_WCIN) + (size_t)2 * DM * DM, M, DM, DM}; SO S; S.init(M, DM, G, (int)blockIdx.x);
              pg8::EpiConvGate<false> E{(const bf16_t*)(ws + WS_P), ap->in[21], nullptr, (bf16_t*)(ws + WS_Z), DM, SEQ, (const float*)(ws + WS_SS) + M};
              pg8::gemm_phase<pg8::EpiConvGate<false>, SO, true, true>(lds, g, S, E); }
            xcd_barrier(bar);
            PH(10) { ARGP(); pg8::Gemm g{(const bf16_t*)(ws + WS_Z), (const bf16_t*)(ws + WS_WCOUT), M, DM, DM}; SO S; S.init(M, DM, G, (int)blockIdx.x);
              pg8::EpiResidF32 E{ap->out, ap->out, DM, H, (float*)(ws + WS_SS) + 2 * M};
              pg8::gemm_phase<pg8::EpiResidF32, SO, true, true>(lds, g, S, E); }
            xcd_barrier(bar);
        }
        constexpr int NA = 20 * 256, NR = 2 * 256;
        PH(12) { ARGP(); pg8::Gemm g{H, WG, M, NA, DM}; SO S; S.init(M, NA, G, (int)blockIdx.x);
          pg8::EpiStoreBf16 E{(bf16_t*)(ws + WS_G), DFF, NA, (const float*)(ws + WS_SS) + (1 ? 2 * M : 0)};
          pg8::gemm_phase<pg8::EpiStoreBf16, SO, true, true>(lds, g, S, E); }
        xcd_barrier(bar);
        PH(12) { ARGP(); const int half = G / 2; const float* ssp = (const float*)(ws + WS_SS) + (1 ? 2 * M : 0);
          if ((int)blockIdx.x < half) {
            pg8::Gemm g{H, WG + (size_t)NA * DM, M, NR, DM}; pg8::SubsetOrder S{(M / 256) * 2, 2, half, (int)blockIdx.x};
            pg8::EpiStoreBf16 E{(bf16_t*)(ws + WS_G) + NA, DFF, NR, ssp};
            pg8::gemm_phase<pg8::EpiStoreBf16, pg8::SubsetOrder, true, true>(lds, g, S, E);
          } else {
            pg8::Gemm g{H, WU, M, NR, DM}; pg8::SubsetOrder S{(M / 256) * 2, 2, G - half, (int)blockIdx.x - half};
            pg8::EpiConvGate<true> E{(const bf16_t*)(ws + WS_G), ap->in[26] + (size_t)1 * 3 * DFF, ap->in[27] + (size_t)1 * DFF, (bf16_t*)(ws + WS_ACT), DFF, SEQ, ssp};
            pg8::gemm_phase<pg8::EpiConvGate<true>, pg8::SubsetOrder, true, true>(lds, g, S, E);
          } }
        xcd_barrier(bar);
        PH(13) { ARGP(); pg8::Gemm g{H, WU + (size_t)NR * DM, M, NA, DM}; SO S; S.init(M, NA, G, (int)blockIdx.x);
          pg8::EpiConvGate<true> E{(const bf16_t*)(ws + WS_G) + NR, ap->in[26] + (size_t)1 * 3 * DFF + NR, ap->in[27] + (size_t)1 * DFF + NR, (bf16_t*)(ws + WS_ACT) + NR, DFF, SEQ, (const float*)(ws + WS_SS) + (1 ? 2 * M : 0)};
          pg8::gemm_phase<pg8::EpiConvGate<true>, SO, true, true>(lds, g, S, E); }
        xcd_barrier(bar);
        PH(14) { ARGP(); pg8::Gemm g{(const bf16_t*)(ws + WS_ACT), WD, M, DM, DFF}; SO S; S.init(M, DM, G, (int)blockIdx.x);
          pg8::EpiResidF32 E{ap->out, ap->out, DM, 1 ? (bf16_t*)nullptr : H, (float*)(ws + WS_SS) + M};
          pg8::gemm_phase<pg8::EpiResidF32, SO, true, true>(lds, g, S, E); }
        if (1 == 0) xcd_barrier(bar);
    }
}

extern "C" void kernel_launch(void* const* d_in, const int* in_sizes, int n_in, void* d_out, int out_size, void* d_ws, size_t ws_size, hipStream_t stream) {
    static int grid = 0;
    if (grid == 0) {
        if (n_in != 29 || out_size != M * DM || ws_size < WS_END) { fprintf(stderr, "kernel_launch: unexpected shapes n_in %d out %d ws %zu (need %zu)\n", n_in, out_size, ws_size, (size_t)WS_END); grid = -1; return; }
        int dev = 0, cus = 0, per_cu = 0;
        hipGetDevice(&dev); hipDeviceGetAttribute(&cus, hipDeviceAttributeMultiprocessorCount, dev);
        hipFuncSetAttribute((const void*)fwd_megakernel, hipFuncAttributeMaxDynamicSharedMemorySize, LDS_BYTES);
        hipOccupancyMaxActiveBlocksPerMultiprocessor(&per_cu, (const void*)fwd_megakernel, NTHREADS, LDS_BYTES);
        if (per_cu < 1) { fprintf(stderr, "kernel_launch: occupancy query says %d blocks/CU\n", per_cu); per_cu = 1; }
        (void)hipGetLastError();
        grid = cus * per_cu;
    }
    if (grid < 0) return;
    if (hipMemsetAsync((char*)d_ws + WS_CTL, 0, CTL_ZERO_BYTES, stream) != hipSuccess) { fprintf(stderr, "kernel_launch: memset failed\n"); return; }
    Args a{};
    for (int i = 0; i < 29; ++i) a.in[i] = (const float*)d_in[i];
    a.out = (float*)d_out; a.ws = (unsigned char*)d_ws;
    void* args[] = {&a};
    hipError_t e = hipLaunchCooperativeKernel((const void*)fwd_megakernel, dim3(grid), dim3(NTHREADS), args, LDS_BYTES, stream);
    if (e != hipSuccess) fprintf(stderr, "cooperative launch failed: %s (grid %d)\n", hipGetErrorString(e), grid);
}
```

```cpp
#include <hip/hip_runtime.h>
#include <hip/hip_cooperative_groups.h>
#include <cstdio>
#include <cstdint>
namespace cg = cooperative_groups;
namespace pg8 {
#define PG8_LAS __attribute__((address_space(3)))
typedef unsigned short bf16_t;
typedef short bf16x8 __attribute__((ext_vector_type(8)));
typedef float f32x4 __attribute__((ext_vector_type(4)));
typedef unsigned u32x4 __attribute__((ext_vector_type(4)));
constexpr int BM = 256, BK = 64, HALF = 128, HTB = HALF * BK * 2  , STAGE_BYTES = 8 * HTB, NXCD = 8, WGM = 8;

__host__ __device__ __forceinline__ int lds_byte(int r, int c) { const int st = (r >> 4) * 2 + (c >> 5), rr = r & 15, cc = c & 31, ob = rr * 64 + cc * 2; return st * 1024 + (ob ^ (((ob >> 9) & 1) << 5)); }
__host__ __device__ __forceinline__ void stage_rc(int b, int& R, int& C) { const int st = b / 1024, sb = b % 1024, swz = sb ^ (((sb >> 9) & 1) << 5); R = (st >> 1) * 16 + swz / 64; C = (st & 1) * 32 + (swz % 64) / 2; }
__host__ __device__ __forceinline__ int perm32(int rho) { const int n = rho >> 4, i = rho & 15; return 8 * (i >> 2) + 4 * n + (i & 3); }

struct Unit { int pm, pn; };
struct Gemm { const bf16_t* A; const bf16_t* Bt; int M, N, K; };

struct StaticOrder {
    int nM, nN, nwg, G, c;
    __host__ __device__ void init(int M, int N, int G_, int c_) { nM = M / BM; nN = N / BM; nwg = nM * nN; G = G_; c = c_; }
    __host__ __device__ bool next(int i, Unit& u) const {
        const long L = (long)i * G + c; if (L >= nwg) return false;
        int wgid = (int)L; { const int q = nwg / NXCD, r = nwg % NXCD, xcd = wgid % NXCD, off = wgid / NXCD; wgid = (xcd < r ? xcd * (q + 1) : r * (q + 1) + (xcd - r) * q) + off; }
        const int nig = WGM * nN, gid = wgid / nig, fm = gid * WGM, gsz = (nM - fm) < WGM ? (nM - fm) : WGM;
        u.pm = fm + ((wgid % nig) % gsz); u.pn = (wgid % nig) / gsz; return true;
    }
    __device__ __forceinline__ void a_ready(const Unit&) const {}
    __device__ __forceinline__ void done(const Unit&) const {}
};


typedef __bf16 bf16x2_t __attribute__((ext_vector_type(2)));
typedef float f32x2_t __attribute__((ext_vector_type(2)));
__device__ __forceinline__ unsigned cvt_pk_bf16(float lo, float hi) { f32x2_t f = {lo, hi}; bf16x2_t r = __builtin_convertvector(f, bf16x2_t); return __builtin_bit_cast(unsigned, r); }
__device__ __forceinline__ float bf_lo(unsigned w) { return __uint_as_float(w << 16); }
__device__ __forceinline__ float bf_hi(unsigned w) { return __uint_as_float(w & 0xffff0000u); }

struct SubsetOrder {
    int n, nN, R, r;
    __device__ __forceinline__ bool next(int i, Unit& u) const { const int k = r + i * R; if (k >= n) return false; u.pm = k / nN; u.pn = k % nN; return true; }
    __device__ __forceinline__ void a_ready(const Unit&) const {}
    __device__ __forceinline__ void done(const Unit&) const {}
};
__device__ __forceinline__ float row_rstd(const float* ss, int row) { return ss ? 1.0f / sqrtf(ss[row] * (1.0f / 2048.0f) + 1e-6f) : 1.0f; }
struct EpiStoreBf16 {
    static constexpr bool PERM = true, AFTER_DRAIN = false;
    bf16_t* O; int ldc; int ncols; const float* ss;
    __device__ __forceinline__ void operator()(f32x4 (&acc)[2][2][4][2], const Unit& u, int wr, int wc, int fr, int fq) const {
        const int row0 = u.pm * BM + wr * 64 + fr; const int col0 = u.pn * BM + wc * 32 + 8 * fq;
        float rs[2][4];
#pragma unroll
        for (int ai = 0; ai < 2; ++ai)
#pragma unroll
            for (int m = 0; m < 4; ++m) rs[ai][m] = row_rstd(ss, row0 + ai * HALF + m * 16);
#pragma unroll
        for (int ai = 0; ai < 2; ++ai)
#pragma unroll
            for (int m = 0; m < 4; ++m) { const int row = row0 + ai * HALF + m * 16; bf16_t* rowp = O + (size_t)row * ldc + col0;
#pragma unroll
                for (int bj = 0; bj < 2; ++bj) { const f32x4 v0 = acc[ai][bj][m][0] * rs[ai][m], v1 = acc[ai][bj][m][1] * rs[ai][m];
                    u32x4 w; w.x = cvt_pk_bf16(v0[0], v0[1]); w.y = cvt_pk_bf16(v0[2], v0[3]); w.z = cvt_pk_bf16(v1[0], v1[1]); w.w = cvt_pk_bf16(v1[2], v1[3]);
                    if (col0 + bj * HALF < ncols) *(u32x4*)(rowp + bj * HALF) = w; } }
    }
};
typedef unsigned u32x2e __attribute__((ext_vector_type(2)));
struct EpiResidF32 {
    static constexpr bool PERM = false, AFTER_DRAIN = false;
    const float* base; float* out; int ldc; bf16_t* xb; float* ss;
    __device__ __forceinline__ void operator()(f32x4 (&acc)[2][2][4][2], const Unit& u, int wr, int wc, int fr, int fq) const {
        const int row0 = u.pm * BM + wr * 64 + fr; const int col0 = u.pn * BM + wc * 32 + 4 * fq;
#pragma unroll
        for (int ai = 0; ai < 2; ++ai)
#pragma unroll
            for (int m = 0; m < 4; ++m) { const size_t off = (size_t)(row0 + ai * HALF + m * 16) * ldc + col0;
#pragma unroll
                for (int bj = 0; bj < 2; ++bj)
#pragma unroll
                    for (int n = 0; n < 2; ++n) acc[ai][bj][m][n] += *(const f32x4*)(base + off + bj * HALF + n * 16);
                if (m == 3) asm volatile("" : "+v"(acc[ai][0][0][0]), "+v"(acc[ai][0][0][1]), "+v"(acc[ai][1][0][0]), "+v"(acc[ai][1][0][1]), "+v"(acc[ai][0][1][0]), "+v"(acc[ai][0][1][1]), "+v"(acc[ai][1][1][0]), "+v"(acc[ai][1][1][1]),
                                             "+v"(acc[ai][0][2][0]), "+v"(acc[ai][0][2][1]), "+v"(acc[ai][1][2][0]), "+v"(acc[ai][1][2][1]), "+v"(acc[ai][0][3][0]), "+v"(acc[ai][0][3][1]), "+v"(acc[ai][1][3][0]), "+v"(acc[ai][1][3][1]) :: "memory"); }
        asm volatile("" ::: "memory");
#pragma unroll
        for (int ai = 0; ai < 2; ++ai)
#pragma unroll
            for (int m = 0; m < 4; ++m) { const int row = row0 + ai * HALF + m * 16; const size_t off = (size_t)row * ldc + col0; float sq = 0.f;
#pragma unroll
                for (int bj = 0; bj < 2; ++bj)
#pragma unroll
                    for (int n = 0; n < 2; ++n) { const f32x4 v = acc[ai][bj][m][n]; *(f32x4*)(out + off + bj * HALF + n * 16) = v;
                        if (xb) { u32x2e w; w.x = cvt_pk_bf16(v[0], v[1]); w.y = cvt_pk_bf16(v[2], v[3]); *(u32x2e*)(xb + off + bj * HALF + n * 16) = w; sq += (v[0] * v[0] + v[1] * v[1]) + (v[2] * v[2] + v[3] * v[3]); } }
                if (xb) { sq += __shfl_xor(sq, 16); sq += __shfl_xor(sq, 32); if (fq == 0) atomicAdd(ss + row, sq); } }
    }
};
struct EpiMulBf16 {
    static constexpr bool PERM = true, AFTER_DRAIN = false;
    bf16_t* O; int ldc; const float* ss;
    __device__ __forceinline__ void operator()(f32x4 (&acc)[2][2][4][2], const Unit& u, int wr, int wc, int fr, int fq) const {
        const int row0 = u.pm * BM + wr * 64 + fr; const int col0 = u.pn * HALF + wc * 32 + 8 * fq;
        float rs[2][4];
#pragma unroll
        for (int ai = 0; ai < 2; ++ai)
#pragma unroll
            for (int m = 0; m < 4; ++m) rs[ai][m] = row_rstd(ss, row0 + ai * HALF + m * 16);
#pragma unroll
        for (int ai = 0; ai < 2; ++ai)
#pragma unroll
            for (int m = 0; m < 4; ++m) { const int row = row0 + ai * HALF + m * 16; bf16_t* rowp = O + (size_t)row * ldc + col0; const float rs2 = rs[ai][m] * rs[ai][m];
                const f32x4 v0 = acc[ai][0][m][0] * acc[ai][1][m][0] * rs2, v1 = acc[ai][0][m][1] * acc[ai][1][m][1] * rs2;
                u32x4 w; w.x = cvt_pk_bf16(v0[0], v0[1]); w.y = cvt_pk_bf16(v0[2], v0[3]); w.z = cvt_pk_bf16(v1[0], v1[1]); w.w = cvt_pk_bf16(v1[2], v1[3]);
                *(u32x4*)rowp = w; }
    }
};
#define PG8_DPP(old_, src_, ctrl_) ((unsigned)__builtin_amdgcn_update_dpp((int)(old_), (int)(src_), (ctrl_), 0xf, 0xf, false))
template <bool SILU> struct EpiConvGate {
    static constexpr bool PERM = true, AFTER_DRAIN = false;
    const bf16_t* G; const float* cw; const float* bias; bf16_t* O; int ldc; int seq; const float* ss;
    __device__ __forceinline__ void operator()(f32x4 (&acc)[2][2][4][2], const Unit& u, int wr, int wc, int fr, int fq) const {
        const int row0 = u.pm * BM + wr * 64 + fr;
        float rs[2][4];
#pragma unroll
        for (int ai = 0; ai < 2; ++ai)
#pragma unroll
            for (int m = 0; m < 4; ++m) rs[ai][m] = row_rstd(ss, row0 + ai * HALF + m * 16);
        u32x4 own[1][4], halo[1];
        const u32x4 z4 = {0u, 0u, 0u, 0u};
#define PG8_ISSUE(g_, buf_) do { const int bj_ = (g_) >> 1, ai_ = (g_) & 1; const int col0_ = u.pn * BM + bj_ * HALF + wc * 32 + 8 * fq; \
            const int rowb_ = row0 + ai_ * HALF; const bf16_t* gp_ = G + (size_t)rowb_ * ldc + col0_; \
            _Pragma("unroll") for (int m_ = 0; m_ < 4; ++m_) own[buf_][m_] = *(const u32x4*)(gp_ + (size_t)(16 * m_) * ldc); \
            const int blk_ = rowb_ - fr; u32x4 hv_ = z4; \
            if (fr == 0) { if ((blk_ & (seq - 1)) != 0) hv_ = *(const u32x4*)(gp_ - ldc); } \
            else if (fr == 15) { if (((blk_ + 64) & (seq - 1)) != 0) hv_ = *(const u32x4*)(gp_ + (size_t)49 * ldc); } \
            halo[buf_] = hv_; } while (0)
#pragma unroll
        for (int g = 0; g < 4; ++g) {
            const int bj = g >> 1, ai = g & 1, buf = 0; const int col0 = u.pn * BM + bj * HALF + wc * 32 + 8 * fq;
            PG8_ISSUE(g, 0);
            float w0[8], w1[8], w2[8], bb[8];
#pragma unroll
            for (int q = 0; q < 2; ++q) { const f32x4 a = *(const f32x4*)(cw + col0 + 4 * q), b = *(const f32x4*)(cw + ldc + col0 + 4 * q), c = *(const f32x4*)(cw + 2 * ldc + col0 + 4 * q);
                const f32x4 d = bias ? *(const f32x4*)(bias + col0 + 4 * q) : (f32x4){0.f, 0.f, 0.f, 0.f};
#pragma unroll
                for (int j = 0; j < 4; ++j) { w0[4 * q + j] = a[j]; w1[4 * q + j] = b[j]; w2[4 * q + j] = c[j]; bb[4 * q + j] = d[j]; } }
#pragma unroll
            for (int m = 0; m < 4; ++m) {
                u32x4 gm, gn; const u32x4 g0 = own[buf][m];
#pragma unroll
                for (int q = 0; q < 4; ++q) {
                    const unsigned oldp = m > 0 ? PG8_DPP(0u, own[buf][m > 0 ? m - 1 : 0][q], 0x121) : halo[buf][q];
                    const unsigned oldn = m < 3 ? PG8_DPP(0u, own[buf][m < 3 ? m + 1 : 3][q], 0x12F) : halo[buf][q];
                    gm[q] = PG8_DPP(oldp, g0[q], 0x111);
                    gn[q] = PG8_DPP(oldn, g0[q], 0x101);
                }
                float r[8];
#pragma unroll
                for (int q = 0; q < 4; ++q) {
                    const float c0 = w0[2 * q] * bf_lo(gm[q]) + w1[2 * q] * bf_lo(g0[q]) + w2[2 * q] * bf_lo(gn[q]) + bb[2 * q];
                    const float c1 = w0[2 * q + 1] * bf_hi(gm[q]) + w1[2 * q + 1] * bf_hi(g0[q]) + w2[2 * q + 1] * bf_hi(gn[q]) + bb[2 * q + 1];
                    float f0 = c0, f1 = c1;
                    if (SILU) { f0 = c0 * __builtin_amdgcn_rcpf(1.0f + __builtin_amdgcn_exp2f(-1.44269504089f * c0)); f1 = c1 * __builtin_amdgcn_rcpf(1.0f + __builtin_amdgcn_exp2f(-1.44269504089f * c1)); }
                    r[2 * q] = f0 * rs[ai][m]; r[2 * q + 1] = f1 * rs[ai][m]; }
                const f32x4 v0 = acc[ai][bj][m][0], v1 = acc[ai][bj][m][1];
                f32x4 pk; pk[0] = __uint_as_float(cvt_pk_bf16(v0[0] * r[0], v0[1] * r[1])); pk[1] = __uint_as_float(cvt_pk_bf16(v0[2] * r[2], v0[3] * r[3]));
                pk[2] = __uint_as_float(cvt_pk_bf16(v1[0] * r[4], v1[1] * r[5])); pk[3] = __uint_as_float(cvt_pk_bf16(v1[2] * r[6], v1[3] * r[7]));
                acc[ai][bj][m][0] = pk;
            }
            asm volatile("" : "+v"(acc[ai][bj][0][0]), "+v"(acc[ai][bj][1][0]), "+v"(acc[ai][bj][2][0]), "+v"(acc[ai][bj][3][0]) :: "memory");
        }
#pragma unroll
        for (int bj = 0; bj < 2; ++bj) {
            const int col0 = u.pn * BM + bj * HALF + wc * 32 + 8 * fq;
#pragma unroll
            for (int ai = 0; ai < 2; ++ai)
#pragma unroll
                for (int m = 0; m < 4; ++m) { const int row = row0 + ai * HALF + m * 16; *(f32x4*)(O + (size_t)row * ldc + col0) = acc[ai][bj][m][0]; }
        }
    }
};

template <class Epi, class Sched, bool ALIGN_EPI = false, bool SP2 = false>
__device__ __forceinline__ void gemm_phase(PG8_LAS unsigned char* lds, const Gemm g, const Sched& S, const Epi& E) {
    int tid_ = threadIdx.x; asm volatile("" : "+v"(tid_));
    const int tid = tid_, wid = __builtin_amdgcn_readfirstlane(tid >> 6), lane = tid & 63, wr = wid >> 2, wc = wid & 3, fr = lane & 15, fq = lane >> 4;
    const int K = g.K, nt = K / BK;
    unsigned voffA[2], voffB[2];
#pragma unroll
    for (int i = 0; i < 2; ++i) { int R, C; stage_rc(tid * 16 + i * 8192, R, C); const int Rb = Epi::PERM ? ((R & ~31) + perm32(R & 31)) : R;
        voffA[i] = (unsigned)(R * K + C) * 2u; voffB[i] = (unsigned)(Rb * K + C) * 2u; }
    const size_t kstep = (size_t)(BK * 2);
    const size_t hstep = (size_t)HALF * K * 2;
    const size_t tstep = 2 * hstep;
    const unsigned ldsw = (unsigned)wid * 1024u;
    const int aoff = lds_byte(wr * 64 + fr, fq * 8), boff = lds_byte(wc * 32 + fr, fq * 8);
#define PG8_SA(b, h) (((b) * 2 + (h)) * HTB)
#define PG8_SB(b, h) ((4 + (b) * 2 + (h)) * HTB)
#define PG8_STAGE(bufoff, gbase, voff) do { _Pragma("unroll") for (int _i = 0; _i < 2; ++_i) \
        __builtin_amdgcn_global_load_lds((const unsigned*)((const char*)(gbase) + (voff)[_i]), (PG8_LAS unsigned*)(lds + (bufoff) + ldsw + _i * 8192), 16, 0, 0); } while (0)
#define PG8_LDA(dst, b, h) do { _Pragma("unroll") for (int m = 0; m < 4; ++m) _Pragma("unroll") for (int k = 0; k < 2; ++k) dst[m][k] = *(const PG8_LAS bf16x8*)(lds + PG8_SA(b, h) + aoff + m * 2048 + k * 1024); } while (0)
#define PG8_LDB(dst, b, h) do { _Pragma("unroll") for (int n = 0; n < 2; ++n) _Pragma("unroll") for (int k = 0; k < 2; ++k) dst[n][k] = *(const PG8_LAS bf16x8*)(lds + PG8_SB(b, h) + boff + n * 2048 + k * 1024); } while (0)
#define PG8_MMA(ai, bj, At, Bt) do { __builtin_amdgcn_s_setprio(1); _Pragma("unroll") for (int m = 0; m < 4; ++m) _Pragma("unroll") for (int n = 0; n < 2; ++n) _Pragma("unroll") for (int k = 0; k < 2; ++k) \
        acc[ai][bj][m][n] = __builtin_amdgcn_mfma_f32_16x16x32_bf16(Bt[n][k], At[m][k], acc[ai][bj][m][n], 0, 0, 0); __builtin_amdgcn_s_setprio(0); } while (0)
#define PG8_WAIT_V(n) asm volatile("s_waitcnt vmcnt(" #n ")" ::: "memory")
#define PG8_WAIT_L(n) asm volatile("s_waitcnt lgkmcnt(" #n ")" ::: "memory")
#define PG8_BAR __builtin_amdgcn_s_barrier()
#define PG8_SCHED __builtin_amdgcn_sched_barrier(0)
    Unit cur, nxt; int ui = 0;
    if (!S.next(0, cur)) return;
    f32x4 acc[2][2][4][2];
#pragma unroll
    for (int a = 0; a < 2; ++a)
#pragma unroll
        for (int b = 0; b < 2; ++b)
#pragma unroll
            for (int m = 0; m < 4; ++m)
#pragma unroll
                for (int n = 0; n < 2; ++n) acc[a][b][m][n] = (f32x4){0.f, 0.f, 0.f, 0.f};
    bf16x8 At[4][2], B0[2][2], B1[2][2];
    const char* cA = (const char*)g.A + (size_t)cur.pm * tstep; const char* cB = (const char*)g.Bt + (size_t)cur.pn * tstep;
    S.a_ready(cur);
    if constexpr (SP2) {
        PG8_STAGE(PG8_SB(0, 0), cB, voffB); PG8_STAGE(PG8_SB(0, 1), cB + hstep, voffB); PG8_STAGE(PG8_SA(0, 0), cA, voffA); PG8_STAGE(PG8_SA(0, 1), cA + hstep, voffA);
        if (wr == 1) PG8_BAR;
        PG8_WAIT_V(2); PG8_BAR;
        PG8_STAGE(PG8_SB(1, 0), cB + kstep, voffB); PG8_STAGE(PG8_SA(1, 0), cA + kstep, voffA); PG8_STAGE(PG8_SB(1, 1), cB + hstep + kstep, voffB);
        PG8_WAIT_V(6); PG8_BAR;
    } else {
        PG8_STAGE(PG8_SB(0, 0), cB, voffB); PG8_STAGE(PG8_SA(0, 0), cA, voffA); PG8_STAGE(PG8_SB(0, 1), cB + hstep, voffB); PG8_STAGE(PG8_SA(0, 1), cA + hstep, voffA);
        if (wr == 1) PG8_BAR;
        PG8_WAIT_V(4); PG8_BAR;
        PG8_STAGE(PG8_SB(1, 0), cB + kstep, voffB); PG8_STAGE(PG8_SA(1, 0), cA + kstep, voffA); PG8_STAGE(PG8_SB(1, 1), cB + hstep + kstep, voffB);
        PG8_WAIT_V(6); PG8_BAR;
    }
    for (;;) {
        const bool has_next = S.next(ui + 1, nxt);
        const char* nA = has_next ? (const char*)g.A + (size_t)nxt.pm * tstep : cA; const char* nB = has_next ? (const char*)g.Bt + (size_t)nxt.pn * tstep : cB;
        for (int t = 0; t < nt; t += 2) {
            const bool last = (t == nt - 2);
            const char* a1 = cA + (size_t)(t + 1) * kstep;
            const char* a2 = last ? nA : cA + (size_t)(t + 2) * kstep; const char* b2 = last ? nB : cB + (size_t)(t + 2) * kstep;
            const char* a3 = a2 + kstep; const char* b3 = b2 + kstep;
            if (last && has_next) S.a_ready(nxt);
            if constexpr (SP2) {
            PG8_LDB(B0, 0, 0); PG8_LDB(B1, 0, 1); PG8_SCHED; PG8_LDA(At, 0, 0); PG8_STAGE(PG8_SA(1, 1), a1 + hstep, voffA);
            PG8_WAIT_V(8); PG8_WAIT_L(0); PG8_BAR; PG8_MMA(0, 0, At, B0); PG8_MMA(0, 1, At, B1); PG8_BAR; PG8_SCHED;
            PG8_LDA(At, 0, 1); PG8_STAGE(PG8_SB(0, 0), b2, voffB); PG8_STAGE(PG8_SB(0, 1), b2 + hstep, voffB); PG8_STAGE(PG8_SA(0, 0), a2, voffA);
            PG8_WAIT_V(8); PG8_WAIT_L(0); PG8_BAR; PG8_MMA(1, 0, At, B0); PG8_MMA(1, 1, At, B1); PG8_BAR; PG8_SCHED;
            PG8_LDB(B0, 1, 0); PG8_LDB(B1, 1, 1); PG8_SCHED; PG8_LDA(At, 1, 0); PG8_STAGE(PG8_SA(0, 1), a2 + hstep, voffA);
            PG8_WAIT_V(8); PG8_WAIT_L(0); PG8_BAR; PG8_MMA(0, 0, At, B0); PG8_MMA(0, 1, At, B1); PG8_BAR; PG8_SCHED;
            PG8_LDA(At, 1, 1); PG8_STAGE(PG8_SB(1, 0), b3, voffB); PG8_STAGE(PG8_SB(1, 1), b3 + hstep, voffB); PG8_STAGE(PG8_SA(1, 0), a3, voffA);
            PG8_WAIT_V(8); PG8_WAIT_L(0); PG8_BAR; PG8_MMA(1, 0, At, B0); PG8_MMA(1, 1, At, B1); PG8_BAR; PG8_SCHED;
            } else {
            PG8_LDB(B0, 0, 0); PG8_SCHED; PG8_LDA(At, 0, 0); PG8_STAGE(PG8_SA(1, 1), a1 + hstep, voffA);
            PG8_WAIT_L(8); PG8_BAR; PG8_WAIT_L(0); PG8_MMA(0, 0, At, B0); PG8_BAR; PG8_SCHED;
            PG8_LDB(B1, 0, 1); PG8_STAGE(PG8_SB(0, 0), b2, voffB);
            PG8_BAR; PG8_WAIT_L(0); PG8_MMA(0, 1, At, B1); PG8_BAR;
            PG8_LDA(At, 0, 1); PG8_STAGE(PG8_SA(0, 0), a2, voffA);
            PG8_BAR; PG8_WAIT_L(0); PG8_MMA(1, 0, At, B0); PG8_BAR; PG8_SCHED;
            PG8_STAGE(PG8_SB(0, 1), b2 + hstep, voffB);
            PG8_WAIT_V(6); PG8_BAR; PG8_MMA(1, 1, At, B1); PG8_BAR;
            PG8_LDB(B0, 1, 0); PG8_SCHED; PG8_LDA(At, 1, 0); PG8_STAGE(PG8_SA(0, 1), a2 + hstep, voffA);
            PG8_WAIT_L(8); PG8_BAR; PG8_WAIT_L(0); PG8_MMA(0, 0, At, B0); PG8_BAR; PG8_SCHED;
            PG8_LDB(B1, 1, 1); PG8_STAGE(PG8_SB(1, 0), b3, voffB);
            PG8_BAR; PG8_WAIT_L(0); PG8_MMA(0, 1, At, B1); PG8_BAR;
            PG8_LDA(At, 1, 1); PG8_STAGE(PG8_SA(1, 0), a3, voffA);
            PG8_BAR; PG8_WAIT_L(0); PG8_MMA(1, 0, At, B0); PG8_BAR; PG8_SCHED;
            PG8_STAGE(PG8_SB(1, 1), b3 + hstep, voffB);
            PG8_WAIT_V(6); PG8_BAR; PG8_MMA(1, 1, At, B1); PG8_BAR;
            }
        }
        if constexpr (ALIGN_EPI) { if (wr == 0) PG8_BAR; }
        if constexpr (!Epi::AFTER_DRAIN) { E(acc, cur, wr, wc, fr, fq); S.done(cur); }
        if (!has_next) break;
#pragma unroll
        for (int a = 0; a < 2; ++a)
#pragma unroll
            for (int b = 0; b < 2; ++b)
#pragma unroll
                for (int m = 0; m < 4; ++m)
#pragma unroll
                    for (int n = 0; n < 2; ++n) acc[a][b][m][n] = (f32x4){0.f, 0.f, 0.f, 0.f};
        cur = nxt; cA = nA; cB = nB; ++ui;
        if constexpr (ALIGN_EPI) { if (wr == 1) PG8_BAR; }
    }
    PG8_WAIT_V(0);
    if constexpr (!ALIGN_EPI) { if (wr == 0) PG8_BAR; }
    PG8_BAR;
    if constexpr (Epi::AFTER_DRAIN) { E.fused(acc, cur, wr, wc, fr, fq, lds, wid, lane); S.done(cur); }
#undef PG8_SA
#undef PG8_SB
#undef PG8_STAGE
#undef PG8_LDA
#undef PG8_LDB
#undef PG8_MMA
#undef PG8_WAIT_V
#undef PG8_WAIT_L
#undef PG8_BAR
#undef PG8_SCHED
}
}

#define GAS __attribute__((address_space(1)))
#define LAS __attribute__((address_space(3)))
typedef unsigned short bf16_t;
typedef unsigned u32x4 __attribute__((ext_vector_type(4)));
typedef unsigned u32x2 __attribute__((ext_vector_type(2)));
typedef int i32x4 __attribute__((ext_vector_type(4)));
typedef float f32x4 __attribute__((ext_vector_type(4)));
typedef float f32x16 __attribute__((ext_vector_type(16)));
typedef short bf16x8 __attribute__((ext_vector_type(8)));
using pg8::cvt_pk_bf16; using pg8::bf_lo; using pg8::bf_hi;

constexpr int NWAVES = 8, NTHREADS = 512;
constexpr int BATCH = 8, SEQ = 2048, DM = 2048, M = BATCH * SEQ, DFF = 5632;
constexpr int NIN = 3904, NIN_PAD = 4096;
constexpr float EPS = 1e-6f, LOG2E = 1.44269504088896f;
constexpr float QSCALE_A = 0.125f * LOG2E;
constexpr float QSCALE_B = 0.07216878364870322f * LOG2E;
constexpr float LAM_INIT = 0.2f;

constexpr size_t MiB = 1u << 20;
constexpr size_t WS_WGATE = 1 * MiB, WS_WUP = 23 * MiB, WS_WDOWN = 45 * MiB;
constexpr size_t WS_H = 67 * MiB;
constexpr size_t WS_BIG = 131 * MiB;
constexpr size_t WS_WIN = WS_BIG + 0, WS_WUQ = WS_BIG + 16 * MiB, WS_WUKV = WS_BIG + 18 * MiB, WS_WOUT = WS_BIG + 19 * MiB;
constexpr size_t WS_PROJ = WS_BIG + 27 * MiB;
constexpr size_t WS_QLAT = WS_BIG + 27 * MiB, WS_KVRAW = WS_BIG + 75 * MiB;
constexpr size_t WS_AO = WS_BIG + 27 * MiB;
constexpr size_t WS_DQ = WS_BIG + 149 * MiB, WS_DK = WS_BIG + 181 * MiB, WS_DVT = WS_BIG + 213 * MiB;
constexpr size_t WS_CQN = WS_BIG + 245 * MiB, WS_CKVN = WS_BIG + 261 * MiB, WS_KR = WS_BIG + 269 * MiB;
constexpr size_t DO_MQ = 0, DO_MK = 48 * MiB, DO_MVT = 96 * MiB;
constexpr size_t WS_G = WS_BIG, WS_ACT = WS_BIG + 176 * MiB;
constexpr size_t WS_WCIN = WS_BIG, WS_WCOUT = WS_BIG + 24 * MiB, WS_P = WS_BIG + 32 * MiB, WS_Z = WS_BIG + 96 * MiB;
constexpr size_t WS_END = WS_BIG + 352 * MiB;

constexpr int RING_BYTES = 131072;
constexpr int LDS_BYTES = 147456;

struct Args {
    const float* in[29]; float* out; unsigned char* ws;
};
#define CAS __attribute__((address_space(4)))
typedef const CAS Args* ArgP;

__device__ __forceinline__ float wave_sum(float v) {
#pragma unroll
    for (int o = 1; o < 64; o <<= 1) v += __shfl_xor(v, o);
    return v;
}
#define LDS_WAIT() asm volatile("s_waitcnt lgkmcnt(0)" ::: "memory")

#define TW_LOAD(it_, dst_, g0_, g1_) do { const int kb_ = (it_) / nblk, nb_ = (it_) % nblk, k0_ = 64 * kb_, n0_ = 32 * nb_; \
        _Pragma("unroll") for (int i_ = 0; i_ < 32; ++i_) { const int kk_ = 2 * i_ + (lane >> 5); dst_[i_] = W[(size_t)(k0_ + kk_) * N + n0_ + (lane & 31)]; } \
        if (gk) { g0_ = *(const f32x4*)(gk + k0_ + 8 * c); g1_ = *(const f32x4*)(gk + k0_ + 8 * c + 4); } } while (0)
template <int MODE>
__device__ __forceinline__ void transpose_weight(const float* W, int K, int N, bf16_t* WT, LAS float* scr, int gw, int NGW, int lane, const float* gk = nullptr) {
    const int nblk = N / 32, nitems = (K / 64) * nblk;
    const int c = lane & 7;
    float cur[32], nxt[32];
    f32x4 gc0 = {1.f, 1.f, 1.f, 1.f}, gc1 = gc0, gn0 = gc0, gn1 = gc0;
    int it = gw;
    if (it < nitems) TW_LOAD(it, cur, gc0, gc1);
    while (it < nitems) {
        const int itn = it + NGW;
        if (itn < nitems) TW_LOAD(itn, nxt, gn0, gn1);
        const int kb = it / nblk, nb = it % nblk, k0 = 64 * kb, n0 = 32 * nb;
        int drow = n0;
        if (MODE == 1) { if (n0 < 2048) drow = 4096 + n0; else if (n0 < 4096) { const int cc = n0 - 2048; drow = (cc >> 7) * 256 + (cc & 127); } else { const int cc = n0 - 4096; drow = (cc >> 7) * 256 + 128 + (cc & 127); } }
#pragma unroll
        for (int i = 0; i < 32; ++i) { const int kk = 2 * i + (lane >> 5); scr[kk * 33 + (lane & 31)] = cur[i]; }
        LDS_WAIT(); asm volatile("" ::: "memory");
#pragma unroll
        for (int j = 0; j < 4; ++j) { const int n = (lane >> 3) + 8 * j; const LAS float* sp = scr + (8 * c) * 33 + n;
            u32x4 o; o.x = cvt_pk_bf16(sp[0 * 33] * gc0[0], sp[1 * 33] * gc0[1]); o.y = cvt_pk_bf16(sp[2 * 33] * gc0[2], sp[3 * 33] * gc0[3]);
            o.z = cvt_pk_bf16(sp[4 * 33] * gc1[0], sp[5 * 33] * gc1[1]); o.w = cvt_pk_bf16(sp[6 * 33] * gc1[2], sp[7 * 33] * gc1[3]);
            *(u32x4*)(WT + (size_t)(drow + n) * K + k0 + 8 * c) = o; }
        LDS_WAIT(); asm volatile("" ::: "memory");
#pragma unroll
        for (int i = 0; i < 32; ++i) cur[i] = nxt[i];
        gc0 = gn0; gc1 = gn1; it = itn;
    }
}
__device__ __forceinline__ void rms_row_to_bf16(const float* xrow, const float* g, bf16_t* orow, int lane) {
    const f32x4* xr = (const f32x4*)xrow + lane; const f32x4* gr = (const f32x4*)g + lane;
    f32x4 v[8]; float s = 0.f;
#pragma unroll
    for (int j = 0; j < 8; ++j) { v[j] = xr[64 * j]; s += (v[j].x * v[j].x + v[j].y * v[j].y) + (v[j].z * v[j].z + v[j].w * v[j].w); }
    const float rstd = 1.0f / sqrtf(wave_sum(s) * (1.0f / DM) + EPS);
    u32x2* o8 = (u32x2*)orow + lane;
#pragma unroll
    for (int j = 0; j < 8; ++j) { const f32x4 gg = gr[64 * j]; u32x2 w; w.x = cvt_pk_bf16(v[j].x * rstd * gg.x, v[j].y * rstd * gg.y); w.y = cvt_pk_bf16(v[j].z * rstd * gg.z, v[j].w * rstd * gg.w); o8[64 * j] = w; }
}
__device__ __forceinline__ void rms_phase(const float* X, const float* g, bf16_t* H, int gw, int NGW, int lane) {
    for (int m = gw; m < M; m += 2 * NGW) {
        const int m2 = m + NGW; const bool two = m2 < M;
        const f32x4* xa = (const f32x4*)(X + (size_t)m * DM) + lane; const f32x4* xb = (const f32x4*)(X + (size_t)(two ? m2 : m) * DM) + lane; const f32x4* gr = (const f32x4*)g + lane;
        f32x4 va[8], vb[8]; float sa = 0.f, sb = 0.f;
#pragma unroll
        for (int j = 0; j < 8; ++j) { va[j] = xa[64 * j]; vb[j] = xb[64 * j]; }
#pragma unroll
        for (int j = 0; j < 8; ++j) { sa += (va[j].x * va[j].x + va[j].y * va[j].y) + (va[j].z * va[j].z + va[j].w * va[j].w); sb += (vb[j].x * vb[j].x + vb[j].y * vb[j].y) + (vb[j].z * vb[j].z + vb[j].w * vb[j].w); }
        const float ra = 1.0f / sqrtf(wave_sum(sa) * (1.0f / DM) + EPS), rb = 1.0f / sqrtf(wave_sum(sb) * (1.0f / DM) + EPS);
        u32x2* oa = (u32x2*)(H + (size_t)m * DM) + lane; u32x2* ob = (u32x2*)(H + (size_t)m2 * DM) + lane;
#pragma unroll
        for (int j = 0; j < 8; ++j) { const f32x4 gg = gr[64 * j]; u32x2 w; w.x = cvt_pk_bf16(va[j].x * ra * gg.x, va[j].y * ra * gg.y); w.y = cvt_pk_bf16(va[j].z * ra * gg.z, va[j].w * ra * gg.w); oa[64 * j] = w;
            if (two) { u32x2 w2; w2.x = cvt_pk_bf16(vb[j].x * rb * gg.x, vb[j].y * rb * gg.y); w2.y = cvt_pk_bf16(vb[j].z * rb * gg.z, vb[j].w * rb * gg.w); ob[64 * j] = w2; } }
    }
}

__device__ __forceinline__ int perm16(int w) { return (w & 3) | (((w >> 3) & 1) << 2) | (((w >> 2) & 1) << 3); }

__device__ __forceinline__ void vt_tile8(const bf16_t* src, int ld, int hstride, bf16_t* vt, int t0, LAS unsigned char* lds, int tid) {
    LAS bf16_t* T = (LAS bf16_t*)lds;
    u32x4 v[2][8];
#pragma unroll
    for (int hb = 0; hb < 2; ++hb)
#pragma unroll
        for (int i = 0; i < 8; ++i) { const int c = tid + i * NTHREADS, r = c >> 6, hc = c & 63, hq = hc >> 4, cc = hc & 15; v[hb][i] = *(const u32x4*)(src + (size_t)r * ld + (hb * 4 + hq) * hstride + cc * 8); }
#pragma unroll
    for (int hb = 0; hb < 2; ++hb) {
#pragma unroll
        for (int i = 0; i < 8; ++i) { const int c = tid + i * NTHREADS, r = c >> 6, hc = c & 63; *(LAS u32x4*)(T + r * 520 + hc * 8) = v[hb][i]; }
        __syncthreads();
#pragma unroll
        for (int i = 0; i < 8; ++i) { const int c = tid + i * NTHREADS, hq = c >> 10, dv = (c >> 3) & 127, q8 = c & 7, blk = q8 >> 1, hh = q8 & 1;
            unsigned e[8];
#pragma unroll
            for (int j = 0; j < 8; ++j) { const int key = blk * 16 + 8 * (j >> 2) + 4 * hh + (j & 3); e[j] = T[key * 520 + hq * 128 + dv]; }
            u32x4 o; o.x = e[0] | (e[1] << 16); o.y = e[2] | (e[3] << 16); o.z = e[4] | (e[5] << 16); o.w = e[6] | (e[7] << 16);
            *(u32x4*)(vt + (size_t)((hb * 4 + hq) * 128 + dv) * SEQ + t0 + blk * 16 + hh * 8) = o; }
        __syncthreads();
    }
}

__device__ __forceinline__ void p2_phase(ArgP ap, LAS unsigned char* lds, int tid, int wid, int lane) {
    unsigned char* ws = ap->ws;
    const bf16_t* PROJ = (const bf16_t*)(ws + WS_PROJ);
    bf16_t* DQ = (bf16_t*)(ws + WS_DQ); bf16_t* DK = (bf16_t*)(ws + WS_DK); bf16_t* DVT = (bf16_t*)(ws + WS_DVT);
    bf16_t* CQN = (bf16_t*)(ws + WS_CQN); bf16_t* CKVN = (bf16_t*)(ws + WS_CKVN); bf16_t* KR = (bf16_t*)(ws + WS_KR);
    const float* dq_g = ap->in[5]; const float* dk_g = ap->in[6]; const float* qa_g = ap->in[12]; const float* kva_g = ap->in[14];
    for (int u = blockIdx.x; u < M / 64; u += gridDim.x) {
        const int tok0 = u * 64;
        for (int i = 0; i < 8; ++i) {
            const int row = tok0 + wid * 8 + i; const bf16_t* p = PROJ + (size_t)row * NIN;
#pragma unroll
            for (int part = 0; part < 2; ++part) {
                const float* g = part ? dk_g : dq_g; const float sc = part ? 1.0f : QSCALE_A; bf16_t* dst = (part ? DK : DQ) + (size_t)row * 1024;
#pragma unroll
                for (int c = 0; c < 2; ++c) {
                    const u32x4 v = *(const u32x4*)(p + part * 1024 + c * 512 + lane * 8);
                    float f[8]; float ss = 0.f;
#pragma unroll
                    for (int q = 0; q < 4; ++q) { f[2 * q] = bf_lo(v[q]); f[2 * q + 1] = bf_hi(v[q]); ss += f[2 * q] * f[2 * q] + f[2 * q + 1] * f[2 * q + 1]; }
                    ss += __shfl_xor(ss, 1); ss += __shfl_xor(ss, 2); ss += __shfl_xor(ss, 4);
                    const float rstd = sc / sqrtf(ss * (1.0f / 64.0f) + EPS);
                    const float* gg = g + (lane & 7) * 8;
                    u32x4 o;
#pragma unroll
                    for (int q = 0; q < 4; ++q) o[q] = cvt_pk_bf16(f[2 * q] * rstd * gg[2 * q], f[2 * q + 1] * rstd * gg[2 * q + 1]);
                    *(u32x4*)(dst + c * 512 + lane * 8) = o;
                }
            }
            {
                const u32x4 v = *(const u32x4*)(p + 3072 + lane * 8); float f[8]; float ss = 0.f;
#pragma unroll
                for (int q = 0; q < 4; ++q) { f[2 * q] = bf_lo(v[q]); f[2 * q + 1] = bf_hi(v[q]); ss += f[2 * q] * f[2 * q] + f[2 * q + 1] * f[2 * q + 1]; }
                const float rstd = 1.0f / sqrtf(wave_sum(ss) * (1.0f / 512.0f) + EPS); const float* gg = qa_g + lane * 8; u32x4 o;
#pragma unroll
                for (int q = 0; q < 4; ++q) o[q] = cvt_pk_bf16(f[2 * q] * rstd * gg[2 * q], f[2 * q + 1] * rstd * gg[2 * q + 1]);
                *(u32x4*)(CQN + (size_t)row * 512 + lane * 8) = o;
            }
            {
                const int l2 = lane & 31; const u32x4 v = *(const u32x4*)(p + 3584 + l2 * 8); float f[8]; float ss = 0.f;
#pragma unroll
                for (int q = 0; q < 4; ++q) { f[2 * q] = bf_lo(v[q]); f[2 * q + 1] = bf_hi(v[q]); ss += f[2 * q] * f[2 * q] + f[2 * q + 1] * f[2 * q + 1]; }
                if (lane >= 32) ss = 0.f;
                const float rstd = 1.0f / sqrtf(wave_sum(ss) * (1.0f / 256.0f) + EPS); const float* gg = kva_g + l2 * 8; u32x4 o;
#pragma unroll
                for (int q = 0; q < 4; ++q) o[q] = cvt_pk_bf16(f[2 * q] * rstd * gg[2 * q], f[2 * q + 1] * rstd * gg[2 * q + 1]);
                if (lane < 32) *(u32x4*)(CKVN + (size_t)row * 256 + l2 * 8) = o;
            }
            if (lane < 8) *(u32x4*)(KR + (size_t)row * 64 + lane * 8) = *(const u32x4*)(p + 3840 + lane * 8);
        }
        const int b = tok0 / SEQ, t0 = tok0 % SEQ;
        vt_tile8(PROJ + (size_t)tok0 * NIN + 2048, NIN, 128, DVT + (size_t)(b * 8) * 128 * SEQ, t0, lds, tid);
    }
}

__device__ __forceinline__ float bfld(const bf16_t* p) { return __uint_as_float((unsigned)(*p) << 16); }
__device__ __forceinline__ void bfst(bf16_t* p, float v) { *p = (bf16_t)(cvt_pk_bf16(v, 0.f) & 0xffffu); }
__device__ __forceinline__ void p4_phase(ArgP ap, LAS unsigned char* lds, int tid, int wid, int lane) {
    unsigned char* ws = ap->ws;
    const bf16_t* QLAT = (const bf16_t*)(ws + WS_QLAT); const bf16_t* KVRAW = (const bf16_t*)(ws + WS_KVRAW); const bf16_t* KR = (const bf16_t*)(ws + WS_KR);
    bf16_t* MQ = (bf16_t*)((unsigned char*)ap->out + DO_MQ); bf16_t* MK = (bf16_t*)((unsigned char*)ap->out + DO_MK); bf16_t* MVT = (bf16_t*)((unsigned char*)ap->out + DO_MVT);
    const int* pos = (const int*)ap->in[1]; const float* mq_g = ap->in[16]; const float* mk_g = ap->in[17];
    const int l2 = lane & 31; const bool lo = lane < 32;
    const float inv_freq = __builtin_amdgcn_exp2f(-(float)l2 * 0.41524101186092029f);
    const float gq0 = mq_g[lane], gq1 = mq_g[64 + lane], gq2 = mq_g[128 + l2], gq3 = mq_g[160 + l2];
    const float gk0 = mk_g[lane], gk1 = mk_g[64 + lane], gk2 = mk_g[128 + l2], gk3 = mk_g[160 + l2];
    for (int u = blockIdx.x; u < M / 64; u += gridDim.x) {
        const int tok0 = u * 64;
        for (int i = 0; i < 8; i += 2) {
            float qe0[2][8], qe1[2][8], qx1[2][8], qx2[2][8], ke0[2][8], ke1[2][8], kr1[2], kr2[2], cs[2], sn[2];
#pragma unroll
            for (int t = 0; t < 2; ++t) {
                const int row = tok0 + wid * 8 + i + t;
                const float ang = (float)pos[row] * inv_freq;
                const double rev = (double)ang * 0.15915494309189535; const float fr = (float)(rev - floor(rev));
                cs[t] = __builtin_amdgcn_cosf(fr); sn[t] = __builtin_amdgcn_sinf(fr);
                kr1[t] = bfld(KR + (size_t)row * 64 + l2); kr2[t] = bfld(KR + (size_t)row * 64 + 32 + l2);
#pragma unroll
                for (int h = 0; h < 8; ++h) {
                    const bf16_t* sq = QLAT + (size_t)row * 1536 + h * 192; const bf16_t* sk = KVRAW + (size_t)row * 2048 + h * 256;
                    qe0[t][h] = bfld(sq + lane); qe1[t][h] = bfld(sq + 64 + lane); qx1[t][h] = bfld(sq + 128 + l2); qx2[t][h] = bfld(sq + 160 + l2);
                    ke0[t][h] = bfld(sk + lane); ke1[t][h] = bfld(sk + 64 + lane); }
            }
#pragma unroll
            for (int t = 0; t < 2; ++t) {
                const int row = tok0 + wid * 8 + i + t;
#pragma unroll
                for (int h = 0; h < 8; ++h) {
                    {
                        const float e0 = qe0[t][h], e1 = qe1[t][h], x1 = qx1[t][h], x2 = qx2[t][h];
                        float ss = e0 * e0 + e1 * e1 + (lo ? x1 * x1 + x2 * x2 : 0.f);
                        const float rstd = QSCALE_B / sqrtf(wave_sum(ss) * (1.0f / 192.0f) + EPS);
                        const float n1 = x1 * rstd * gq2, n2 = x2 * rstd * gq3;
                        bf16_t* d = MQ + (size_t)row * 1536 + h * 192;
                        bfst(d + lane, e0 * rstd * gq0); bfst(d + 64 + lane, e1 * rstd * gq1);
                        if (lo) { bfst(d + 128 + l2, n1 * cs[t] - n2 * sn[t]); bfst(d + 160 + l2, n2 * cs[t] + n1 * sn[t]); }
                    }
                    {
                        const float e0 = ke0[t][h], e1 = ke1[t][h];
                        float ss = e0 * e0 + e1 * e1 + (lo ? kr1[t] * kr1[t] + kr2[t] * kr2[t] : 0.f);
                        const float rstd = 1.0f / sqrtf(wave_sum(ss) * (1.0f / 192.0f) + EPS);
                        const float n1 = kr1[t] * rstd * gk2, n2 = kr2[t] * rstd * gk3;
                        bf16_t* d = MK + (size_t)row * 1536 + h * 192;
                        bfst(d + lane, e0 * rstd * gk0); bfst(d + 64 + lane, e1 * rstd * gk1);
                        if (lo) { bfst(d + 128 + l2, n1 * cs[t] - n2 * sn[t]); bfst(d + 160 + l2, n2 * cs[t] + n1 * sn[t]); }
                    }
                }
            }
        }
        const int b = tok0 / SEQ, t0 = tok0 % SEQ;
        vt_tile8(KVRAW + (size_t)tok0 * 2048 + 128, 2048, 256, MVT + (size_t)(b * 8) * 128 * SEQ, t0, lds, tid);
    }
}


constexpr size_t WS_CTL = 0, CTL_ZERO_BYTES = 262144, WS_SS = 65536;
constexpr int MISC_OFF = RING_BYTES + 320;
#define XB_TMO      128
#define XB_XCNT(j)  (256  + 64 * (j))
#define XB_XSUB(j)  (1280 + 64 * (j))
#define XB_XGEN(j)  (2304 + 64 * (j))
#define XB_TOP      3328
#define XB_TOPGEN   3392
#define XCD_BAR_WORDS 3456
#define XB_SPIN_CAP (1u << 18)

__device__ __forceinline__ unsigned xb_ld(unsigned* p)              { return __hip_atomic_load(p, __ATOMIC_RELAXED, __HIP_MEMORY_SCOPE_AGENT); }
__device__ __forceinline__ unsigned xb_add(unsigned* p, unsigned v) { return __hip_atomic_fetch_add(p, v, __ATOMIC_RELAXED, __HIP_MEMORY_SCOPE_AGENT); }
__device__ __forceinline__ unsigned xb_xcc_id() { return (unsigned)__builtin_amdgcn_s_getreg((3 << 11) | 20) & 0xFu; }
#define XB_SPIN(cond, bar) do { unsigned _sp = 0; while (cond) { __builtin_amdgcn_s_sleep(1); \
    if ((++_sp & 255u) == 0u) { if (xb_ld(&(bar)[XB_TMO])) break; if (_sp > XB_SPIN_CAP) { atomicAdd(&(bar)[XB_TMO], 1u); break; } } } } while (0)

struct XcdBarrier {
    unsigned* bar; unsigned x;
    volatile LAS unsigned* st;
};

__device__ __forceinline__ XcdBarrier xcd_barrier_post(unsigned* bar, volatile LAS unsigned* st) {
    XcdBarrier b; b.bar = bar; b.x = xb_xcc_id(); b.st = st;
    if (threadIdx.x == 0) (void)xb_add(&bar[XB_XCNT(b.x)], 1u);
    return b;
}
__device__ __forceinline__ void xcd_barrier_complete(unsigned* bar, unsigned x, unsigned& nloc, unsigned& nx) {
    const unsigned G = gridDim.x * gridDim.y * gridDim.z;
    unsigned sum, cnt, mine, sp = 0u;
    for (;;) {
        sum = 0u; cnt = 0u; mine = 0u;
#pragma unroll
        for (unsigned j = 0; j < 16; ++j) { const unsigned c = xb_ld(&bar[XB_XCNT(j)]); sum += c; cnt += (c > 0u) ? 1u : 0u; mine = (j == x) ? c : mine; }
        if (sum == G) break;
        __builtin_amdgcn_s_sleep(1);
        if ((++sp & 255u) == 0u) { if (xb_ld(&bar[XB_TMO])) break; if (sp > XB_SPIN_CAP) { atomicAdd(&bar[XB_TMO], 1u); break; } }
    }
    nloc = mine > 0u ? mine : 1u; nx = cnt > 0u ? cnt : 1u;
}

__device__ __forceinline__ void xcd_barrier(const XcdBarrier& b) {
    asm volatile("s_waitcnt vmcnt(0)" ::: "memory");
    __syncthreads();
    if (threadIdx.x == 0) {
        unsigned* bar = b.bar; asm volatile("" : "+s"(bar));
        __builtin_amdgcn_s_waitcnt(0);
        unsigned nloc = b.st[0], nx = b.st[1];
        if (nloc == 0u) { xcd_barrier_complete(bar, b.x, nloc, nx); b.st[0] = nloc; b.st[1] = nx; }
        const unsigned old = xb_add(&bar[XB_XSUB(b.x)], 1u);
        const unsigned gen = old / nloc;
        if (old + 1u == (gen + 1u) * nloc) {
            __builtin_amdgcn_fence(__ATOMIC_RELEASE, "agent");
            asm volatile("s_waitcnt vmcnt(0)" ::: "memory");
            const unsigned og = xb_add(&bar[XB_TOP], 1u);
            const unsigned tg = og / nx;
            if (og + 1u == (tg + 1u) * nx) xb_add(&bar[XB_TOPGEN], 1u);
            else XB_SPIN(xb_ld(&bar[XB_TOPGEN]) == tg, bar);
            __builtin_amdgcn_fence(__ATOMIC_ACQUIRE, "agent");
            xb_add(&bar[XB_XGEN(b.x)], 1u);
            asm volatile("s_waitcnt vmcnt(0)" ::: "memory");
        } else {
            XB_SPIN(xb_ld(&bar[XB_XGEN(b.x)]) == gen, bar);
            __builtin_amdgcn_fence(__ATOMIC_ACQUIRE, "agent");
            asm volatile("s_waitcnt vmcnt(0)" ::: "memory");
        }
    }
    __syncthreads();
}

#define MFMA32(a, b, c) __builtin_amdgcn_mfma_f32_32x32x16_bf16((a), (b), (c), 0, 0, 0)
template <bool DIFF>
__device__ __forceinline__ void attn_unit(LAS unsigned char* lds, const bf16_t* Qg, const bf16_t* Kg, const bf16_t* VTg, bf16_t* AO,
                                          const int* pos, const float* rel_table, const float* subln_g, float lam,
                                          int b, int h, int qb, int tid_in, int wid, int lane_in, bool fresh) {
    int tid = tid_in; asm volatile("" : "+v"(tid)); const int lane = tid & 63; (void)lane_in;
    constexpr int DKH = DIFF ? 64 : 192, KROW = DIFF ? 128 : 192, KSTR = KROW + 8, VSTR = 72;
    constexpr int K_BYTES = 64 * KSTR * 2, V_BYTES = 128 * VSTR * 2, BUF = K_BYTES + V_BYTES;
    constexpr int POS_OFF = 2 * BUF, LUT_OFF = POS_OFF + 8192, TMM_OFF = LUT_OFF + 1280;
    constexpr int ROWS = DIFF ? 128 : 256, QLD = DIFF ? 1024 : 1536, KLD = QLD, CPR = KROW / 8, NKC = (64 * CPR) / NTHREADS, NKS = DKH / 16;
    static_assert(TMM_OFF + 256 <= RING_BYTES, "attention LDS");
    const int r = lane & 31, hh = lane >> 5;
    const int rg = DIFF ? (wid >> 1) : wid, hf = DIFF ? (wid & 1) : 0;
    const int qrow = b * SEQ + qb * ROWS + rg * 32 + r;
    const bf16_t* Kb = Kg + (size_t)b * SEQ * KLD + h * KROW;
    const bf16_t* Vb = VTg + (size_t)(b * 8 + h) * 128 * SEQ;

    int pq4 = 0;
    if (DIFF) {
        LAS int* P4 = (LAS int*)(lds + POS_OFF); LAS float* LUT = (LAS float*)(lds + LUT_OFF);
        if (fresh) for (int i = tid; i < SEQ; i += NTHREADS) P4[i] = 4 * pos[b * SEQ + i];
        if (fresh && tid < 257) { const int rel = tid - 128, n = rel < 0 ? -rel : rel;
            const int large = 8 + (n >= 12) + (n >= 16) + (n >= 23) + (n >= 32) + (n >= 46) + (n >= 64) + (n >= 91);
            const int bucket = (rel > 0 ? 16 : 0) + (n < 8 ? n : (large < 15 ? large : 15));
            LUT[tid] = rel_table[bucket * 8 + h] * LOG2E; }
        pq4 = 4 * pos[qrow];
    }
    bf16x8 qf[NKS];
    { const bf16_t* qp = Qg + (size_t)qrow * QLD + h * KROW + hf * 64 + 8 * hh;
#pragma unroll
      for (int ks = 0; ks < NKS; ++ks) qf[ks] = *(const bf16x8*)(qp + 16 * ks); }

    u32x4 kreg[NKC], vreg[2];
    auto load_tile = [&](int kt) {
#pragma unroll
        for (int i = 0; i < NKC; ++i) { const int c = tid + i * NTHREADS, row = c / CPR, cc = c % CPR; kreg[i] = *(const u32x4*)(Kb + (size_t)(kt * 64 + row) * KLD + cc * 8); }
#pragma unroll
        for (int i = 0; i < 2; ++i) { const int c = tid + i * NTHREADS, dv = c >> 3, cc = c & 7; vreg[i] = *(const u32x4*)(Vb + (size_t)dv * SEQ + kt * 64 + cc * 8); }
    };
    auto store_tile = [&](int buf) {
        LAS unsigned char* kb_ = lds + buf * BUF; LAS unsigned char* vb_ = kb_ + K_BYTES;
#pragma unroll
        for (int i = 0; i < NKC; ++i) { const int c = tid + i * NTHREADS, row = c / CPR, cc = c % CPR; *(LAS u32x4*)(kb_ + (row * KSTR + cc * 8) * 2) = kreg[i]; }
#pragma unroll
        for (int i = 0; i < 2; ++i) { const int c = tid + i * NTHREADS, dv = c >> 3, cc = c & 7; *(LAS u32x4*)(vb_ + (dv * VSTR + cc * 8) * 2) = vreg[i]; }
    };
    load_tile(0); store_tile(0);
    __syncthreads();
    int qmin4 = 0, qmax4 = 0; float bias_lo = 0.f, bias_hi = 0.f;
    if (DIFF) {
        if (fresh && tid < SEQ / 64) { const LAS int* P4 = (const LAS int*)(lds + POS_OFF) + tid * 64; int mn = P4[0], mx_ = P4[0];
            for (int i = 1; i < 64; ++i) { const int v = P4[i]; mn = v < mn ? v : mn; mx_ = v > mx_ ? v : mx_; }
            ((LAS int*)(lds + TMM_OFF))[2 * tid] = mn; ((LAS int*)(lds + TMM_OFF))[2 * tid + 1] = mx_; }
        qmin4 = pq4; qmax4 = pq4;
#pragma unroll
        for (int o = 1; o < 64; o <<= 1) { const int a_ = __shfl_xor(qmin4, o), b_ = __shfl_xor(qmax4, o); qmin4 = a_ < qmin4 ? a_ : qmin4; qmax4 = b_ > qmax4 ? b_ : qmax4; }
        bias_lo = *(const LAS float*)(lds + LUT_OFF);
        bias_hi = *(const LAS float*)(lds + LUT_OFF + 1024);
        __syncthreads();
    }

    f32x16 O[4];
#pragma unroll
    for (int d = 0; d < 4; ++d)
#pragma unroll
        for (int i = 0; i < 16; ++i) O[d][i] = 0.f;
    float m_used = -INFINITY, lsum = 0.f;
    float nm = 0.f;

    for (int kt = 0; kt < SEQ / 64; ++kt) {
        const bool more = kt + 1 < SEQ / 64;
        if (more) load_tile(kt + 1);
        LAS unsigned char* kbuf = lds + (kt & 1) * BUF; LAS unsigned char* vbuf = kbuf + K_BYTES;
        f32x16 s[2];
        if (DIFF) {
            const int tmn = ((const LAS int*)(lds + TMM_OFF))[2 * kt], tmx = ((const LAS int*)(lds + TMM_OFF))[2 * kt + 1];
            const bool far_hi = __builtin_amdgcn_readfirstlane(tmn - qmax4) >= 512, far_lo = __builtin_amdgcn_readfirstlane(tmx - qmin4) <= -512;
            if (far_hi || far_lo) {
                const float cb = (far_hi ? bias_hi : bias_lo) + nm;
#pragma unroll
                for (int kb = 0; kb < 2; ++kb)
#pragma unroll
                    for (int i = 0; i < 16; ++i) s[kb][i] = cb;
            } else {
#pragma unroll
                for (int kb = 0; kb < 2; ++kb) {
                    const LAS int* P4 = (const LAS int*)(lds + POS_OFF) + kt * 64 + 32 * kb + 4 * hh;
#pragma unroll
                    for (int g = 0; g < 4; ++g) { const i32x4 pk = *(const LAS i32x4*)(P4 + 8 * g);
#pragma unroll
                        for (int j = 0; j < 4; ++j) { int d = pk[j] - pq4; d = d < -512 ? -512 : (d > 512 ? 512 : d); s[kb][4 * g + j] = *(const LAS float*)(lds + LUT_OFF + 512 + d) + nm; } }
                }
            }
        } else {
#pragma unroll
            for (int kb = 0; kb < 2; ++kb)
#pragma unroll
                for (int i = 0; i < 16; ++i) s[kb][i] = 0.f;
        }
        {
            const LAS unsigned char* kp0 = kbuf + (r * KSTR + hf * 64 + 8 * hh) * 2; const LAS unsigned char* kp1 = kp0 + 32 * KSTR * 2;
#pragma unroll
            for (int ks = 0; ks < NKS; ++ks) { const bf16x8 kf0 = *(const LAS bf16x8*)(kp0 + 32 * ks), kf1 = *(const LAS bf16x8*)(kp1 + 32 * ks);
                s[0] = MFMA32(kf0, qf[ks], s[0]); s[1] = MFMA32(kf1, qf[ks], s[1]); }
        }
        float mx = s[0][0];
#pragma unroll
        for (int i = 1; i < 16; ++i) mx = fmaxf(mx, s[0][i]);
#pragma unroll
        for (int i = 0; i < 16; ++i) mx = fmaxf(mx, s[1][i]);
        mx = fmaxf(mx, __shfl_xor(mx, 32));
        if (DIFF) {
            const bool need = (kt == 0) || (mx > 8.0f);
            if (__builtin_amdgcn_ballot_w64(need) != 0ull) {
                const float delta = need ? mx : 0.f;
                const float alpha = (kt == 0) ? 1.0f : __builtin_amdgcn_exp2f(-delta);
                lsum *= alpha;
#pragma unroll
                for (int d = 0; d < 4; ++d) O[d] = O[d] * alpha;
#pragma unroll
                for (int kb = 0; kb < 2; ++kb)
#pragma unroll
                    for (int i = 0; i < 16; ++i) s[kb][i] -= delta;
                nm -= delta;
            }
#pragma unroll
            for (int kb = 0; kb < 2; ++kb)
#pragma unroll
                for (int i = 0; i < 16; ++i) { const float p = __builtin_amdgcn_exp2f(s[kb][i]); s[kb][i] = p; lsum += p; }
        } else {
            const bool need = mx > m_used + 8.0f;
            if (__builtin_amdgcn_ballot_w64(need) != 0ull) {
                const float m_new = need ? mx : m_used;
                const float alpha = __builtin_amdgcn_exp2f(m_used - m_new);
                lsum *= alpha;
#pragma unroll
                for (int d = 0; d < 4; ++d) O[d] = O[d] * alpha;
                m_used = m_new;
            }
#pragma unroll
            for (int kb = 0; kb < 2; ++kb)
#pragma unroll
                for (int i = 0; i < 16; ++i) { const float p = __builtin_amdgcn_exp2f(s[kb][i] - m_used); s[kb][i] = p; lsum += p; }
        }
#pragma unroll
        for (int kb = 0; kb < 2; ++kb)
#pragma unroll
            for (int st = 0; st < 2; ++st) {
                u32x4 pw;
#pragma unroll
                for (int q = 0; q < 4; ++q) pw[q] = cvt_pk_bf16(s[kb][8 * st + 2 * q], s[kb][8 * st + 2 * q + 1]);
                const bf16x8 pf = __builtin_bit_cast(bf16x8, pw);
                const LAS unsigned char* vp = vbuf + (r * VSTR + (2 * kb + st) * 16 + 8 * hh) * 2;
#pragma unroll
                for (int d = 0; d < 4; ++d) { const bf16x8 vf = *(const LAS bf16x8*)(vp + d * 32 * VSTR * 2); O[d] = MFMA32(vf, pf, O[d]); }
            }
        if (more) store_tile((kt + 1) & 1);
        __syncthreads();
    }
    const float ltot = lsum + __shfl_xor(lsum, 32);
    const float inv = 1.0f / ltot;
    if (DIFF) {
        LAS float* XO = (LAS float*)lds + (size_t)rg * 64 * 64 + lane;
        if (hf == 1) {
#pragma unroll
            for (int d = 0; d < 4; ++d)
#pragma unroll
                for (int i = 0; i < 16; ++i) XO[(d * 16 + i) * 64] = O[d][i] * inv;
        }
        __syncthreads();
        if (hf == 0) {
            float ss = 0.f;
#pragma unroll
            for (int d = 0; d < 4; ++d)
#pragma unroll
                for (int i = 0; i < 16; ++i) { const float o = O[d][i] * inv - lam * XO[(d * 16 + i) * 64]; O[d][i] = o; ss += o * o; }
            ss += __shfl_xor(ss, 32);
            const float rstd = (1.0f - LAM_INIT) / sqrtf(ss * (1.0f / 128.0f) + EPS);
            bf16_t* op = AO + (size_t)qrow * 2048 + h * 128 + 4 * hh;
#pragma unroll
            for (int d = 0; d < 4; ++d)
#pragma unroll
                for (int g = 0; g < 4; ++g) { const f32x4 gg = *(const f32x4*)(subln_g + 32 * d + 8 * g + 4 * hh);
                    u32x2 w; w.x = cvt_pk_bf16(O[d][4 * g] * rstd * gg.x, O[d][4 * g + 1] * rstd * gg.y); w.y = cvt_pk_bf16(O[d][4 * g + 2] * rstd * gg.z, O[d][4 * g + 3] * rstd * gg.w);
                    *(u32x2*)(op + 32 * d + 8 * g) = w; }
        }
        __syncthreads();
    } else {
        bf16_t* op = AO + (size_t)qrow * 2048 + 1024 + h * 128 + 4 * hh;
#pragma unroll
        for (int d = 0; d < 4; ++d)
#pragma unroll
            for (int g = 0; g < 4; ++g) { u32x2 w; w.x = cvt_pk_bf16(O[d][4 * g] * inv, O[d][4 * g + 1] * inv); w.y = cvt_pk_bf16(O[d][4 * g + 2] * inv, O[d][4 * g + 3] * inv);
                *(u32x2*)(op + 32 * d + 8 * g) = w; }
    }
}

__device__ __forceinline__ void attn_phase_mla(ArgP ap, LAS unsigned char* lds, int tid, int wid, int lane) {
    const bf16_t* MQ = (const bf16_t*)((unsigned char*)ap->out + DO_MQ); const bf16_t* MK = (const bf16_t*)((unsigned char*)ap->out + DO_MK); const bf16_t* MVT = (const bf16_t*)((unsigned char*)ap->out + DO_MVT);
    bf16_t* AO = (bf16_t*)(ap->ws + WS_AO);
    const int G = gridDim.x, bx = blockIdx.x, v = (G % 8 == 0) ? (bx % 8) * (G / 8) + bx / 8 : bx;
    const bool fast = (512 % G == 0); const int per = fast ? 512 / G : 0;
    for (int i = 0; ; ++i) { int u; if (fast) { if (i >= per) break; u = v * per + i; } else { u = bx + i * G; if (u >= 512) break; }
        const int qb = u & 7, h = (u >> 3) & 7, b = u >> 6;
        attn_unit<false>(lds, MQ, MK, MVT, AO, nullptr, nullptr, nullptr, 0.f, b, h, qb, tid, wid, lane, true); }
}
__device__ __forceinline__ void attn_phase_diff(ArgP ap, LAS unsigned char* lds, int tid, int wid, int lane) {
    unsigned char* ws = ap->ws;
    const bf16_t* DQ = (const bf16_t*)(ws + WS_DQ); const bf16_t* DK = (const bf16_t*)(ws + WS_DK); const bf16_t* DVT = (const bf16_t*)(ws + WS_DVT);
    bf16_t* AO = (bf16_t*)(ws + WS_AO);
    const int* pos = (const int*)ap->in[1];
    float d1 = 0.f, d2 = 0.f;
    { const float q1 = ap->in[7][lane], k1 = ap->in[8][lane], q2 = ap->in[9][lane], k2 = ap->in[10][lane]; d1 = wave_sum(q1 * k1); d2 = wave_sum(q2 * k2); }
    const float lam = expf(d1) - expf(d2) + LAM_INIT;
    const int G = gridDim.x, bx = blockIdx.x, v = (G % 8 == 0) ? (bx % 8) * (G / 8) + bx / 8 : bx;
    const bool fast = (1024 % G == 0 && 1024 / G <= 16 && 16 % (1024 / G) == 0); const int per = fast ? 1024 / G : 0;
    for (int i = 0; ; ++i) { int u; bool fresh; if (fast) { if (i >= per) break; u = v * per + i; fresh = (i == 0); } else { u = bx + i * G; if (u >= 1024) break; fresh = true; }
        const int qb = u & 15, h = (u >> 4) & 7, b = u >> 7;
        attn_unit<true>(lds, DQ, DK, DVT, AO, pos, ap->in[2], ap->in[11], lam, b, h, qb, tid, wid, lane, fresh); }
}

__global__ void __launch_bounds__(NTHREADS, 2) fwd_megakernel(Args a) {
    extern __shared__ __attribute__((aligned(16))) unsigned char lds_raw[];
    LAS unsigned char* lds = (LAS unsigned char*)lds_raw;
    cg::grid_group grid = cg::this_grid();
    if (gridDim.x == 0x7fffffffu) grid.sync();
    { int t_ = threadIdx.x; if (t_ < 32) ((volatile LAS unsigned*)(lds + MISC_OFF))[t_] = 0u; }
    __syncthreads();
    XcdBarrier bar;
    { ArgP ap0 = (ArgP)__builtin_amdgcn_kernarg_segment_ptr(); bar = xcd_barrier_post((unsigned*)(ap0->ws + WS_CTL), (volatile LAS unsigned*)(lds + MISC_OFF) + 8); }
#define ARGP() ArgP ap = (ArgP)__builtin_amdgcn_kernarg_segment_ptr(); asm volatile("" : "+s"(ap)); unsigned char* ws = ap->ws; (void)ws; bf16_t* H = (bf16_t*)(ws + WS_H); bf16_t* WG = (bf16_t*)(ws + WS_WGATE); bf16_t* WU = (bf16_t*)(ws + WS_WUP); bf16_t* WD = (bf16_t*)(ws + WS_WDOWN); (void)H; (void)WG; (void)WU; (void)WD;
#define FRESH_IDS() int tid = threadIdx.x; asm volatile("" : "+v"(tid)); const int lane = tid & 63, wid = __builtin_amdgcn_readfirstlane(tid >> 6); const int gw = blockIdx.x * NWAVES + wid; (void)gw; (void)lane;
    const int G = gridDim.x, NGW = G * NWAVES;
    typedef pg8::StaticOrder SO;

#ifndef PH_MASK
#define PH_MASK 0xffffffffu
#endif
#define PH(k) if ((PH_MASK >> (k)) & 1u)
    PH(0) { FRESH_IDS(); ARGP(); LAS float* scr = (LAS float*)(lds + wid * 16384);
    transpose_weight<0>(ap->in[4], DM, NIN, (bf16_t*)(ws + WS_WIN), scr, gw, NGW, lane);
    transpose_weight<0>(ap->in[13], 512, 1536, (bf16_t*)(ws + WS_WUQ), scr, gw, NGW, lane);
    transpose_weight<0>(ap->in[15], 256, 2048, (bf16_t*)(ws + WS_WUKV), scr, gw, NGW, lane);
    transpose_weight<0>(ap->in[18], DM, DM, (bf16_t*)(ws + WS_WOUT), scr, gw, NGW, lane);
    transpose_weight<0>(ap->in[24], DM, DFF, WG, scr, gw, NGW, lane, ap->in[23]);
    transpose_weight<0>(ap->in[25], DM, DFF, WU, scr, gw, NGW, lane, ap->in[23]);
    transpose_weight<0>(ap->in[28], DFF, DM, WD, scr, gw, NGW, lane);
    rms_phase(ap->in[0], ap->in[3], H, gw, NGW, lane); }
    xcd_barrier(bar);
    PH(1) { ARGP(); pg8::Gemm g{H, (const bf16_t*)(ws + WS_WIN), M, NIN_PAD, DM}; SO S; S.init(M, NIN_PAD, G, (int)blockIdx.x);
      pg8::EpiStoreBf16 E{(bf16_t*)(ws + WS_PROJ), NIN, NIN, nullptr};
      pg8::gemm_phase<pg8::EpiStoreBf16, SO, true, true>(lds, g, S, E); }
    xcd_barrier(bar);
    PH(2) { FRESH_IDS(); ARGP(); p2_phase(ap, lds, tid, wid, lane); }
    xcd_barrier(bar);
    PH(3) { ARGP(); pg8::Gemm g{(const bf16_t*)(ws + WS_CQN), (const bf16_t*)(ws + WS_WUQ), M, 1536, 512}; SO S; S.init(M, 1536, G, (int)blockIdx.x);
      pg8::EpiStoreBf16 E{(bf16_t*)(ws + WS_QLAT), 1536, 1536, nullptr};
      pg8::gemm_phase<pg8::EpiStoreBf16, SO, true, true>(lds, g, S, E); }
    PH(3) { ARGP(); pg8::Gemm g{(const bf16_t*)(ws + WS_CKVN), (const bf16_t*)(ws + WS_WUKV), M, 2048, 256}; SO S; S.init(M, 2048, G, (int)blockIdx.x);
      pg8::EpiStoreBf16 E{(bf16_t*)(ws + WS_KVRAW), 2048, 2048, nullptr};
      pg8::gemm_phase<pg8::EpiStoreBf16, SO, true, true>(lds, g, S, E); }
    xcd_barrier(bar);
    PH(4) { FRESH_IDS(); ARGP(); p4_phase(ap, lds, tid, wid, lane); }
    xcd_barrier(bar);
    PH(5) { FRESH_IDS(); ARGP(); attn_phase_mla(ap, lds, tid, wid, lane); }
    PH(5) { FRESH_IDS(); ARGP(); attn_phase_diff(ap, lds, tid, wid, lane); }
    xcd_barrier(bar);
    PH(6) { ARGP(); pg8::Gemm g{(const bf16_t*)(ws + WS_AO), (const bf16_t*)(ws + WS_WOUT), M, DM, DM}; SO S; S.init(M, DM, G, (int)blockIdx.x);
      pg8::EpiResidF32 E{ap->in[0], ap->out, DM, H, (float*)(ws + WS_SS)};
      pg8::gemm_phase<pg8::EpiResidF32, SO, true, true>(lds, g, S, E); }
    xcd_barrier(bar);
    {
        if (0 == 1) {
            PH(7) { FRESH_IDS(); ARGP(); LAS float* scr = (LAS float*)(lds + wid * 16384);
            transpose_weight<1>(ap->in[20], DM, 3 * DM, (bf16_t*)(ws + WS_WCIN), scr, gw, NGW, lane, ap->in[19]);
            transpose_weight<0>(ap->in[22], DM, DM, (bf16_t*)(ws + WS_WCOUT), scr, gw, NGW, lane);
            transpose_weight<0>(ap->in[24] + (size_t)DM * DFF, DM, DFF, WG, scr, gw, NGW, lane, ap->in[23] + DM);
            transpose_weight<0>(ap->in[25] + (size_t)DM * DFF, DM, DFF, WU, scr, gw, NGW, lane, ap->in[23] + DM);
            transpose_weight<0>(ap->in[28] + (size_t)DM * DFF, DFF, DM, WD, scr, gw, NGW, lane); }
            xcd_barrier(bar);
            PH(8) { ARGP(); pg8::Gemm g{H, (const bf16_t*)(ws + WS_WCIN), M, 2 * DM, DM}; SO S; S.init(M, 2 * DM, G, (int)blockIdx.x);
              pg8::EpiMulBf16 E{(bf16_t*)(ws + WS_P), DM, (const float*)(ws + WS_SS) + M};
              pg8::gemm_phase<pg8::EpiMulBf16, SO, true, true>(lds, g, S, E); }
            xcd_barrier(bar);
            PH(9) { ARGP(); pg8::Gemm g{H, (const bf16_t*)(ws + WS_WCIN) + (size_t)2 * DM * DM, M, DM, DM}; SO S; S.init(M, DM, G, (int)blockIdx.x);
              pg8::EpiConvGate<false> E{(const bf16_t*)(ws + WS_P), ap->in[21], nullptr, (bf16_t*)(ws + WS_Z), DM, SEQ, (const float*)(ws + WS_SS) + M};
              pg8::gemm_phase<pg8::EpiConvGate<false>, SO, true, true>(lds, g, S, E); }
            xcd_barrier(bar);
            PH(10) { ARGP(); pg8::Gemm g{(const bf16_t*)(ws + WS_Z), (const bf16_t*)(ws + WS_WCOUT), M, DM, DM}; SO S; S.init(M, DM, G, (int)blockIdx.x);
              pg8::EpiResidF32 E{ap->out, ap->out, DM, H, (float*)(ws + WS_SS) + 2 * M};
              pg8::gemm_phase<pg8::EpiResidF32, SO, true, true>(lds, g, S, E); }
            xcd_barrier(bar);
        }
        constexpr int NA = 20 * 256, NR = 2 * 256;
        PH(12) { ARGP(); pg8::Gemm g{H, WG, M, NA, DM}; SO S; S.init(M, NA, G, (int)blockIdx.x);
          pg8::EpiStoreBf16 E{(bf16_t*)(ws + WS_G), DFF, NA, (const float*)(ws + WS_SS) + (0 ? 2 * M : 0)};
          pg8::gemm_phase<pg8::EpiStoreBf16, SO, true, true>(lds, g, S, E); }
        xcd_barrier(bar);
        PH(12) { ARGP(); const int half = G / 2; const float* ssp = (const float*)(ws + WS_SS) + (0 ? 2 * M : 0);
          if ((int)blockIdx.x < half) {
            pg8::Gemm g{H, WG + (size_t)NA * DM, M, NR, DM}; pg8::SubsetOrder S{(M / 256) * 2, 2, half, (int)blockIdx.x};
            pg8::EpiStoreBf16 E{(bf16_t*)(ws + WS_G) + NA, DFF, NR, ssp};
            pg8::gemm_phase<pg8::EpiStoreBf16, pg8::SubsetOrder, true, true>(lds, g, S, E);
          } else {
            pg8::Gemm g{H, WU, M, NR, DM}; pg8::SubsetOrder S{(M / 256) * 2, 2, G - half, (int)blockIdx.x - half};
            pg8::EpiConvGate<true> E{(const bf16_t*)(ws + WS_G), ap->in[26] + (size_t)0 * 3 * DFF, ap->in[27] + (size_t)0 * DFF, (bf16_t*)(ws + WS_ACT), DFF, SEQ, ssp};
            pg8::gemm_phase<pg8::EpiConvGate<true>, pg8::SubsetOrder, true, true>(lds, g, S, E);
          } }
        xcd_barrier(bar);
        PH(13) { ARGP(); pg8::Gemm g{H, WU + (size_t)NR * DM, M, NA, DM}; SO S; S.init(M, NA, G, (int)blockIdx.x);
          pg8::EpiConvGate<true> E{(const bf16_t*)(ws + WS_G) + NR, ap->in[26] + (size_t)0 * 3 * DFF + NR, ap->in[27] + (size_t)0 * DFF + NR, (bf16_t*)(ws + WS_ACT) + NR, DFF, SEQ, (const float*)(ws + WS_SS) + (0 ? 2 * M : 0)};
          pg8::gemm_phase<pg8::EpiConvGate<true>, SO, true, true>(lds, g, S, E); }
        xcd_barrier(bar);
        PH(14) { ARGP(); pg8::Gemm g{(const bf16_t*)(ws + WS_ACT), WD, M, DM, DFF}; SO S; S.init(M, DM, G, (int)blockIdx.x);
          pg8::EpiResidF32 E{ap->out, ap->out, DM, 0 ? (bf16_t*)nullptr : H, (float*)(ws + WS_SS) + M};
          pg8::gemm_phase<pg8::EpiResidF32, SO, true, true>(lds, g, S, E); }
        if (0 == 0) xcd_barrier(bar);
    }
    {
        if (1 == 1) {
            PH(7) { FRESH_IDS(); ARGP(); LAS float* scr = (LAS float*)(lds + wid * 16384);
            transpose_weight<1>(ap->in[20], DM, 3 * DM, (bf16_t*)(ws + WS_WCIN), scr, gw, NGW, lane, ap->in[19]);
            transpose_weight<0>(ap->in[22], DM, DM, (bf16_t*)(ws + WS_WCOUT), scr, gw, NGW, lane);
            transpose_weight<0>(ap->in[24] + (size_t)DM * DFF, DM, DFF, WG, scr, gw, NGW, lane, ap->in[23] + DM);
            transpose_weight<0>(ap->in[25] + (size_t)DM * DFF, DM, DFF, WU, scr, gw, NGW, lane, ap->in[23] + DM);
            transpose_weight<0>(ap->in[28] + (size_t)DM * DFF, DFF, DM, WD, scr, gw, NGW, lane); }
            xcd_barrier(bar);
            PH(8) { ARGP(); pg8::Gemm g{H, (const bf16_t*)(ws + WS_WCIN), M, 2 * DM, DM}; SO S; S.init(M, 2 * DM, G, (int)blockIdx.x);
              pg8::EpiMulBf16 E{(bf16_t*)(ws + WS_P), DM, (const float*)(ws + WS_SS) + M};
              pg8::gemm_phase<pg8::EpiMulBf16, SO, true, true>(lds, g, S, E); }
            xcd_barrier(bar);
            PH(9) { ARGP(); pg8::Gemm g{H, (const bf16_t*)(ws + WS_WCIN) + (size_t)2 * DM * DM, M, DM, DM}; SO S; S.init(M, DM, G, (int)blockIdx.x);
              pg8::EpiConvGate<false> E{(const bf16_t*)(ws + WS_P), ap->in[21], nullptr, (bf16_t*)(ws + WS_Z), DM, SEQ, (const float*)(ws + WS_SS) + M};
              pg8::gemm_phase<pg8::EpiConvGate<false>, SO, true, true>(lds, g, S, E); }
            xcd_barrier(bar);
            PH(10) { ARGP(); pg8::Gemm g{(const bf16_t*)(ws + WS_Z), (const bf16_t*)(ws + WS_WCOUT), M, DM, DM}; SO S; S.init(M, DM, G, (int)blockIdx.x);
              pg8::EpiResidF32 E{ap->out, ap->out, DM, H, (float*)(ws + WS_SS) + 2 * M};
              pg8::gemm_phase<pg8::EpiResidF32, SO, true, true>(lds, g, S, E); }
            xcd_barrier(bar);
        }
        constexpr int NA = 20 * 256, NR = 2 * 256;
        PH(12) { ARGP(); pg8::Gemm g{H, WG, M, NA, DM}; SO S; S.init(M, NA, G, (int)blockIdx.x);
          pg8::EpiStoreBf16 E{(bf16_t*)(ws + WS_G), DFF, NA, (const float*)(ws + WS_SS) + (1 ? 2 * M : 0)};
          pg8::gemm_phase<pg8::EpiStoreBf16, SO, true, true>(lds, g, S, E); }
        xcd_barrier(bar);
        PH(12) { ARGP(); const int half = G / 2; const float* ssp = (const float*)(ws + WS_SS) + (1 ? 2 * M : 0);
          if ((int)blockIdx.x < half) {
            pg8::Gemm g{H, WG + (size_t)NA * DM, M, NR, DM}; pg8::SubsetOrder S{(M / 256) * 2, 2, half, (int)blockIdx.x};
            pg8::EpiStoreBf16 E{(bf16_t*)(ws + WS_G) + NA, DFF, NR, ssp};
            pg8::gemm_phase<pg8::EpiStoreBf16, pg8::SubsetOrder, true, true>(lds, g, S, E);
          } else {
            pg8::Gemm g{H, WU, M, NR, DM}; pg8::SubsetOrder S{(M / 256) * 2, 2, G - half, (int)blockIdx.x - half};
            pg8::EpiConvGate<true> E{(const bf16_t*)(ws + WS_G), ap->in[26] + (size_t)1 * 3 * DFF, ap->in[27] + (size_t)1 * DFF, (bf16_t*)(ws + WS_ACT), DFF, SEQ, ssp};
            pg8::gemm_phase<pg8::EpiConvGate<true>, pg8::SubsetOrder, true, true>(lds, g, S, E);
          } }
        xcd_barrier(bar);
        PH(13) { ARGP(); pg8::Gemm g{H, WU + (size_t)NR * DM, M, NA, DM}; SO S; S.init(M, NA, G, (int)blockIdx.x);
          pg8::EpiConvGate<true> E{(const bf16_t*)(ws + WS_G) + NR, ap->in[26] + (size_t)1 * 3 * DFF + NR, ap->in[27] + (size_t)1 * DFF + NR, (bf16_t*)(ws + WS_ACT) + NR, DFF, SEQ, (const float*)(ws + WS_SS) + (1 ? 2 * M : 0)};
          pg8::gemm_phase<pg8::EpiConvGate<true>, SO, true, true>(lds, g, S, E); }
        xcd_barrier(bar);
        PH(14) { ARGP(); pg8::Gemm g{(const bf16_t*)(ws + WS_ACT), WD, M, DM, DFF}; SO S; S.init(M, DM, G, (int)blockIdx.x);
          pg8::EpiResidF32 E{ap->out, ap->out, DM, 1 ? (bf16_t*)nullptr : H, (float*)(ws + WS_SS) + M};
          pg8::gemm_phase<pg8::EpiResidF32, SO, true, true>(lds, g, S, E); }
        if (1 == 0) xcd_barrier(bar);
    }
}

extern "C" void kernel_launch(void* const* d_in, const int* in_sizes, int n_in, void* d_out, int out_size, void* d_ws, size_t ws_size, hipStream_t stream) {
    static int grid = 0;
    if (grid == 0) {
        if (n_in != 29 || out_size != M * DM || ws_size < WS_END) { fprintf(stderr, "kernel_launch: unexpected shapes n_in %d out %d ws %zu (need %zu)\n", n_in, out_size, ws_size, (size_t)WS_END); grid = -1; return; }
        int dev = 0, cus = 0, per_cu = 0;
        hipGetDevice(&dev); hipDeviceGetAttribute(&cus, hipDeviceAttributeMultiprocessorCount, dev);
        hipFuncSetAttribute((const void*)fwd_megakernel, hipFuncAttributeMaxDynamicSharedMemorySize, LDS_BYTES);
        hipOccupancyMaxActiveBlocksPerMultiprocessor(&per_cu, (const void*)fwd_megakernel, NTHREADS, LDS_BYTES);
        if (per_cu < 1) { fprintf(stderr, "kernel_launch: occupancy query says %d blocks/CU\n", per_cu); per_cu = 1; }
        (void)hipGetLastError();
        grid = cus * per_cu;
    }
    if (grid < 0) return;
    if (hipMemsetAsync((char*)d_ws + WS_CTL, 0, CTL_ZERO_BYTES, stream) != hipSuccess) { fprintf(stderr, "kernel_launch: memset failed\n"); return; }
    Args a{};
    for (int i = 0; i < 29; ++i) a.in[i] = (const float*)d_in[i];
    a.out = (float*)d_out; a.ws = (unsigned char*)d_ws;
    void* args[] = {&a};
    hipError_t e = hipLaunchCooperativeKernel((const void*)fwd_megakernel, dim3(grid), dim3(NTHREADS), args, LDS_BYTES, stream);
    if (e != hipSuccess) fprintf(stderr, "cooperative launch failed: %s (grid %d)\n", hipGetErrorString(e), grid);
}
```

```cpp
#include <hip/hip_runtime.h>
#include <hip/hip_cooperative_groups.h>
#include <cstdio>
#include <cstdint>
namespace cg = cooperative_groups;
namespace pg8 {
#define PG8_LAS __attribute__((address_space(3)))
typedef unsigned short bf16_t;
typedef short bf16x8 __attribute__((ext_vector_type(8)));
typedef float f32x4 __attribute__((ext_vector_type(4)));
typedef unsigned u32x4 __attribute__((ext_vector_type(4)));
constexpr int BM = 256, BK = 64, HALF = 128, HTB = HALF * BK * 2  , STAGE_BYTES = 8 * HTB, NXCD = 8, WGM = 8;

__host__ __device__ __forceinline__ int lds_byte(int r, int c) { const int st = (r >> 4) * 2 + (c >> 5), rr = r & 15, cc = c & 31, ob = rr * 64 + cc * 2; return st * 1024 + (ob ^ (((ob >> 9) & 1) << 5)); }
__host__ __device__ __forceinline__ void stage_rc(int b, int& R, int& C) { const int st = b / 1024, sb = b % 1024, swz = sb ^ (((sb >> 9) & 1) << 5); R = (st >> 1) * 16 + swz / 64; C = (st & 1) * 32 + (swz % 64) / 2; }
__host__ __device__ __forceinline__ int perm32(int rho) { const int n = rho >> 4, i = rho & 15; return 8 * (i >> 2) + 4 * n + (i & 3); }

struct Unit { int pm, pn; };
struct Gemm { const bf16_t* A; const bf16_t* Bt; int M, N, K; };

struct StaticOrder {
    int nM, nN, nwg, G, c;
    __host__ __device__ void init(int M, int N, int G_, int c_) { nM = M / BM; nN = N / BM; nwg = nM * nN; G = G_; c = c_; }
    __host__ __device__ bool next(int i, Unit& u) const {
        const long L = (long)i * G + c; if (L >= nwg) return false;
        int wgid = (int)L; { const int q = nwg / NXCD, r = nwg % NXCD, xcd = wgid % NXCD, off = wgid / NXCD; wgid = (xcd < r ? xcd * (q + 1) : r * (q + 1) + (xcd - r) * q) + off; }
        const int nig = WGM * nN, gid = wgid / nig, fm = gid * WGM, gsz = (nM - fm) < WGM ? (nM - fm) : WGM;
        u.pm = fm + ((wgid % nig) % gsz); u.pn = (wgid % nig) / gsz; return true;
    }
    __device__ __forceinline__ void a_ready(const Unit&) const {}
    __device__ __forceinline__ void done(const Unit&) const {}
};


typedef __bf16 bf16x2_t __attribute__((ext_vector_type(2)));
typedef float f32x2_t __attribute__((ext_vector_type(2)));
__device__ __forceinline__ unsigned cvt_pk_bf16(float lo, float hi) { f32x2_t f = {lo, hi}; bf16x2_t r = __builtin_convertvector(f, bf16x2_t); return __builtin_bit_cast(unsigned, r); }
__device__ __forceinline__ float bf_lo(unsigned w) { return __uint_as_float(w << 16); }
__device__ __forceinline__ float bf_hi(unsigned w) { return __uint_as_float(w & 0xffff0000u); }

struct SubsetOrder {
    int n, nN, R, r;
    __device__ __forceinline__ bool next(int i, Unit& u) const { const int k = r + i * R; if (k >= n) return false; u.pm = k / nN; u.pn = k % nN; return true; }
    __device__ __forceinline__ void a_ready(const Unit&) const {}
    __device__ __forceinline__ void done(const Unit&) const {}
};
__device__ __forceinline__ float row_rstd(const float* ss, int row) { return ss ? 1.0f / sqrtf(ss[row] * (1.0f / 2048.0f) + 1e-6f) : 1.0f; }
struct EpiStoreBf16 {
    static constexpr bool PERM = true, AFTER_DRAIN = false;
    bf16_t* O; int ldc; int ncols; const float* ss;
    __device__ __forceinline__ void operator()(f32x4 (&acc)[2][2][4][2], const Unit& u, int wr, int wc, int fr, int fq) const {
        const int row0 = u.pm * BM + wr * 64 + fr; const int col0 = u.pn * BM + wc * 32 + 8 * fq;
        float rs[2][4];
#pragma unroll
        for (int ai = 0; ai < 2; ++ai)
#pragma unroll
            for (int m = 0; m < 4; ++m) rs[ai][m] = row_rstd(ss, row0 + ai * HALF + m * 16);
#pragma unroll
        for (int ai = 0; ai < 2; ++ai)
#pragma unroll
            for (int m = 0; m < 4; ++m) { const int row = row0 + ai * HALF + m * 16; bf16_t* rowp = O + (size_t)row * ldc + col0;
#pragma unroll
                for (int bj = 0; bj < 2; ++bj) { const f32x4 v0 = acc[ai][bj][m][0] * rs[ai][m], v1 = acc[ai][bj][m][1] * rs[ai][m];
                    u32x4 w; w.x = cvt_pk_bf16(v0[0], v0[1]); w.y = cvt_pk_bf16(v0[2], v0[3]); w.z = cvt_pk_bf16(v1[0], v1[1]); w.w = cvt_pk_bf16(v1[2], v1[3]);
                    if (col0 + bj * HALF < ncols) *(u32x4*)(rowp + bj * HALF) = w; } }
    }
};
typedef unsigned u32x2e __attribute__((ext_vector_type(2)));
struct EpiResidF32 {
    static constexpr bool PERM = false, AFTER_DRAIN = false;
    const float* base; float* out; int ldc; bf16_t* xb; float* ss;
    __device__ __forceinline__ void operator()(f32x4 (&acc)[2][2][4][2], const Unit& u, int wr, int wc, int fr, int fq) const {
        const int row0 = u.pm * BM + wr * 64 + fr; const int col0 = u.pn * BM + wc * 32 + 4 * fq;
#pragma unroll
        for (int ai = 0; ai < 2; ++ai)
#pragma unroll
            for (int m = 0; m < 4; ++m) { const size_t off = (size_t)(row0 + ai * HALF + m * 16) * ldc + col0;
#pragma unroll
                for (int bj = 0; bj < 2; ++bj)
#pragma unroll
                    for (int n = 0; n < 2; ++n) acc[ai][bj][m][n] += *(const f32x4*)(base + off + bj * HALF + n * 16);
                if (m == 3) asm volatile("" : "+v"(acc[ai][0][0][0]), "+v"(acc[ai][0][0][1]), "+v"(acc[ai][1][0][0]), "+v"(acc[ai][1][0][1]), "+v"(acc[ai][0][1][0]), "+v"(acc[ai][0][1][1]), "+v"(acc[ai][1][1][0]), "+v"(acc[ai][1][1][1]),
                                             "+v"(acc[ai][0][2][0]), "+v"(acc[ai][0][2][1]), "+v"(acc[ai][1][2][0]), "+v"(acc[ai][1][2][1]), "+v"(acc[ai][0][3][0]), "+v"(acc[ai][0][3][1]), "+v"(acc[ai][1][3][0]), "+v"(acc[ai][1][3][1]) :: "memory"); }
        asm volatile("" ::: "memory");
#pragma unroll
        for (int ai = 0; ai < 2; ++ai)
#pragma unroll
            for (int m = 0; m < 4; ++m) { const int row = row0 + ai * HALF + m * 16; const size_t off = (size_t)row * ldc + col0; float sq = 0.f;
#pragma unroll
                for (int bj = 0; bj < 2; ++bj)
#pragma unroll
                    for (int n = 0; n < 2; ++n) { const f32x4 v = acc[ai][bj][m][n]; *(f32x4*)(out + off + bj * HALF + n * 16) = v;
                        if (xb) { u32x2e w; w.x = cvt_pk_bf16(v[0], v[1]); w.y = cvt_pk_bf16(v[2], v[3]); *(u32x2e*)(xb + off + bj * HALF + n * 16) = w; sq += (v[0] * v[0] + v[1] * v[1]) + (v[2] * v[2] + v[3] * v[3]); } }
                if (xb) { sq += __shfl_xor(sq, 16); sq += __shfl_xor(sq, 32); if (fq == 0) atomicAdd(ss + row, sq); } }
    }
};
struct EpiMulBf16 {
    static constexpr bool PERM = true, AFTER_DRAIN = false;
    bf16_t* O; int ldc; const float* ss;
    __device__ __forceinline__ void operator()(f32x4 (&acc)[2][2][4][2], const Unit& u, int wr, int wc, int fr, int fq) const {
        const int row0 = u.pm * BM + wr * 64 + fr; const int col0 = u.pn * HALF + wc * 32 + 8 * fq;
        float rs[2][4];
#pragma unroll
        for (int ai = 0; ai < 2; ++ai)
#pragma unroll
            for (int m = 0; m < 4; ++m) rs[ai][m] = row_rstd(ss, row0 + ai * HALF + m * 16);
#pragma unroll
        for (int ai = 0; ai < 2; ++ai)
#pragma unroll
            for (int m = 0; m < 4; ++m) { const int row = row0 + ai * HALF + m * 16; bf16_t* rowp = O + (size_t)row * ldc + col0; const float rs2 = rs[ai][m] * rs[ai][m];
                const f32x4 v0 = acc[ai][0][m][0] * acc[ai][1][m][0] * rs2, v1 = acc[ai][0][m][1] * acc[ai][1][m][1] * rs2;
                u32x4 w; w.x = cvt_pk_bf16(v0[0], v0[1]); w.y = cvt_pk_bf16(v0[2], v0[3]); w.z = cvt_pk_bf16(v1[0], v1[1]); w.w = cvt_pk_bf16(v1[2], v1[3]);
                *(u32x4*)rowp = w; }
    }
};
#define PG8_DPP(old_, src_, ctrl_) ((unsigned)__builtin_amdgcn_update_dpp((int)(old_), (int)(src_), (ctrl_), 0xf, 0xf, false))
template <bool SILU> struct EpiConvGate {
    static constexpr bool PERM = true, AFTER_DRAIN = false;
    const bf16_t* G; const float* cw; const float* bias; bf16_t* O; int ldc; int seq; const float* ss;
    __device__ __forceinline__ void operator()(f32x4 (&acc)[2][2][4][2], const Unit& u, int wr, int wc, int fr, int fq) const {
        const int row0 = u.pm * BM + wr * 64 + fr;
        float rs[2][4];
#pragma unroll
        for (int ai = 0; ai < 2; ++ai)
#pragma unroll
            for (int m = 0; m < 4; ++m) rs[ai][m] = row_rstd(ss, row0 + ai * HALF + m * 16);
        u32x4 own[1][4], halo[1];
        const u32x4 z4 = {0u, 0u, 0u, 0u};
#define PG8_ISSUE(g_, buf_) do { const int bj_ = (g_) >> 1, ai_ = (g_) & 1; const int col0_ = u.pn * BM + bj_ * HALF + wc * 32 + 8 * fq; \
            const int rowb_ = row0 + ai_ * HALF; const bf16_t* gp_ = G + (size_t)rowb_ * ldc + col0_; \
            _Pragma("unroll") for (int m_ = 0; m_ < 4; ++m_) own[buf_][m_] = *(const u32x4*)(gp_ + (size_t)(16 * m_) * ldc); \
            const int blk_ = rowb_ - fr; u32x4 hv_ = z4; \
            if (fr == 0) { if ((blk_ & (seq - 1)) != 0) hv_ = *(const u32x4*)(gp_ - ldc); } \
            else if (fr == 15) { if (((blk_ + 64) & (seq - 1)) != 0) hv_ = *(const u32x4*)(gp_ + (size_t)49 * ldc); } \
            halo[buf_] = hv_; } while (0)
#pragma unroll
        for (int g = 0; g < 4; ++g) {
            const int bj = g >> 1, ai = g & 1, buf = 0; const int col0 = u.pn * BM + bj * HALF + wc * 32 + 8 * fq;
            PG8_ISSUE(g, 0);
            float w0[8], w1[8], w2[8], bb[8];
#pragma unroll
            for (int q = 0; q < 2; ++q) { const f32x4 a = *(const f32x4*)(cw + col0 + 4 * q), b = *(const f32x4*)(cw + ldc + col0 + 4 * q), c = *(const f32x4*)(cw + 2 * ldc + col0 + 4 * q);
                const f32x4 d = bias ? *(const f32x4*)(bias + col0 + 4 * q) : (f32x4){0.f, 0.f, 0.f, 0.f};
#pragma unroll
                for (int j = 0; j < 4; ++j) { w0[4 * q + j] = a[j]; w1[4 * q + j] = b[j]; w2[4 * q + j] = c[j]; bb[4 * q + j] = d[j]; } }
#pragma unroll
            for (int m = 0; m < 4; ++m) {
                u32x4 gm, gn; const u32x4 g0 = own[buf][m];
#pragma unroll
                for (int q = 0; q < 4; ++q) {
                    const unsigned oldp = m > 0 ? PG8_DPP(0u, own[buf][m > 0 ? m - 1 : 0][q], 0x121) : halo[buf][q];
                    const unsigned oldn = m < 3 ? PG8_DPP(0u, own[buf][m < 3 ? m + 1 : 3][q], 0x12F) : halo[buf][q];
                    gm[q] = PG8_DPP(oldp, g0[q], 0x111);
                    gn[q] = PG8_DPP(oldn, g0[q], 0x101);
                }
                float r[8];
#pragma unroll
                for (int q = 0; q < 4; ++q) {
                    const float c0 = w0[2 * q] * bf_lo(gm[q]) + w1[2 * q] * bf_lo(g0[q]) + w2[2 * q] * bf_lo(gn[q]) + bb[2 * q];
                    const float c1 = w0[2 * q + 1] * bf_hi(gm[q]) + w1[2 * q + 1] * bf_hi(g0[q]) + w2[2 * q + 1] * bf_hi(gn[q]) + bb[2 * q + 1];
                    float f0 = c0, f1 = c1;
                    if (SILU) { f0 = c0 * __builtin_amdgcn_rcpf(1.0f + __builtin_amdgcn_exp2f(-1.44269504089f * c0)); f1 = c1 * __builtin_amdgcn_rcpf(1.0f + __builtin_amdgcn_exp2f(-1.44269504089f * c1)); }
                    r[2 * q] = f0 * rs[ai][m]; r[2 * q + 1] = f1 * rs[ai][m]; }
                const f32x4 v0 = acc[ai][bj][m][0], v1 = acc[ai][bj][m][1];
                f32x4 pk; pk[0] = __uint_as_float(cvt_pk_bf16(v0[0] * r[0], v0[1] * r[1])); pk[1] = __uint_as_float(cvt_pk_bf16(v0[2] * r[2], v0[3] * r[3]));
                pk[2] = __uint_as_float(cvt_pk_bf16(v1[0] * r[4], v1[1] * r[5])); pk[3] = __uint_as_float(cvt_pk_bf16(v1[2] * r[6], v1[3] * r[7]));
                acc[ai][bj][m][0] = pk;
            }
            asm volatile("" : "+v"(acc[ai][bj][0][0]), "+v"(acc[ai][bj][1][0]), "+v"(acc[ai][bj][2][0]), "+v"(acc[ai][bj][3][0]) :: "memory");
        }
#pragma unroll
        for (int bj = 0; bj < 2; ++bj) {
            const int col0 = u.pn * BM + bj * HALF + wc * 32 + 8 * fq;
#pragma unroll
            for (int ai = 0; ai < 2; ++ai)
#pragma unroll
                for (int m = 0; m < 4; ++m) { const int row = row0 + ai * HALF + m * 16; *(f32x4*)(O + (size_t)row * ldc + col0) = acc[ai][bj][m][0]; }
        }
    }
};

template <class Epi, class Sched, bool ALIGN_EPI = false, bool SP2 = false>
__device__ __forceinline__ void gemm_phase(PG8_LAS unsigned char* lds, const Gemm g, const Sched& S, const Epi& E) {
    int tid_ = threadIdx.x; asm volatile("" : "+v"(tid_));
    const int tid = tid_, wid = __builtin_amdgcn_readfirstlane(tid >> 6), lane = tid & 63, wr = wid >> 2, wc = wid & 3, fr = lane & 15, fq = lane >> 4;
    const int K = g.K, nt = K / BK;
    unsigned voffA[2], voffB[2];
#pragma unroll
    for (int i = 0; i < 2; ++i) { int R, C; stage_rc(tid * 16 + i * 8192, R, C); const int Rb = Epi::PERM ? ((R & ~31) + perm32(R & 31)) : R;
        voffA[i] = (unsigned)(R * K + C) * 2u; voffB[i] = (unsigned)(Rb * K + C) * 2u; }
    const size_t kstep = (size_t)(BK * 2);
    const size_t hstep = (size_t)HALF * K * 2;
    const size_t tstep = 2 * hstep;
    const unsigned ldsw = (unsigned)wid * 1024u;
    const int aoff = lds_byte(wr * 64 + fr, fq * 8), boff = lds_byte(wc * 32 + fr, fq * 8);
#define PG8_SA(b, h) (((b) * 2 + (h)) * HTB)
#define PG8_SB(b, h) ((4 + (b) * 2 + (h)) * HTB)
#define PG8_STAGE(bufoff, gbase, voff) do { _Pragma("unroll") for (int _i = 0; _i < 2; ++_i) \
        __builtin_amdgcn_global_load_lds((const unsigned*)((const char*)(gbase) + (voff)[_i]), (PG8_LAS unsigned*)(lds + (bufoff) + ldsw + _i * 8192), 16, 0, 0); } while (0)
#define PG8_LDA(dst, b, h) do { _Pragma("unroll") for (int m = 0; m < 4; ++m) _Pragma("unroll") for (int k = 0; k < 2; ++k) dst[m][k] = *(const PG8_LAS bf16x8*)(lds + PG8_SA(b, h) + aoff + m * 2048 + k * 1024); } while (0)
#define PG8_LDB(dst, b, h) do { _Pragma("unroll") for (int n = 0; n < 2; ++n) _Pragma("unroll") for (int k = 0; k < 2; ++k) dst[n][k] = *(const PG8_LAS bf16x8*)(lds + PG8_SB(b, h) + boff + n * 2048 + k * 1024); } while (0)
#define PG8_MMA(ai, bj, At, Bt) do { __builtin_amdgcn_s_setprio(1); _Pragma("unroll") for (int m = 0; m < 4; ++m) _Pragma("unroll") for (int n = 0; n < 2; ++n) _Pragma("unroll") for (int k = 0; k < 2; ++k) \
        acc[ai][bj][m][n] = __builtin_amdgcn_mfma_f32_16x16x32_bf16(Bt[n][k], At[m][k], acc[ai][bj][m][n], 0, 0, 0); __builtin_amdgcn_s_setprio(0); } while (0)
#define PG8_WAIT_V(n) asm volatile("s_waitcnt vmcnt(" #n ")" ::: "memory")
#define PG8_WAIT_L(n) asm volatile("s_waitcnt lgkmcnt(" #n ")" ::: "memory")
#define PG8_BAR __builtin_amdgcn_s_barrier()
#define PG8_SCHED __builtin_amdgcn_sched_barrier(0)
    Unit cur, nxt; int ui = 0;
    if (!S.next(0, cur)) return;
    f32x4 acc[2][2][4][2];
#pragma unroll
    for (int a = 0; a < 2; ++a)
#pragma unroll
        for (int b = 0; b < 2; ++b)
#pragma unroll
            for (int m = 0; m < 4; ++m)
#pragma unroll
                for (int n = 0; n < 2; ++n) acc[a][b][m][n] = (f32x4){0.f, 0.f, 0.f, 0.f};
    bf16x8 At[4][2], B0[2][2], B1[2][2];
    const char* cA = (const char*)g.A + (size_t)cur.pm * tstep; const char* cB = (const char*)g.Bt + (size_t)cur.pn * tstep;
    S.a_ready(cur);
    if constexpr (SP2) {
        PG8_STAGE(PG8_SB(0, 0), cB, voffB); PG8_STAGE(PG8_SB(0, 1), cB + hstep, voffB); PG8_STAGE(PG8_SA(0, 0), cA, voffA); PG8_STAGE(PG8_SA(0, 1), cA + hstep, voffA);
        if (wr == 1) PG8_BAR;
        PG8_WAIT_V(2); PG8_BAR;
        PG8_STAGE(PG8_SB(1, 0), cB + kstep, voffB); PG8_STAGE(PG8_SA(1, 0), cA + kstep, voffA); PG8_STAGE(PG8_SB(1, 1), cB + hstep + kstep, voffB);
        PG8_WAIT_V(6); PG8_BAR;
    } else {
        PG8_STAGE(PG8_SB(0, 0), cB, voffB); PG8_STAGE(PG8_SA(0, 0), cA, voffA); PG8_STAGE(PG8_SB(0, 1), cB + hstep, voffB); PG8_STAGE(PG8_SA(0, 1), cA + hstep, voffA);
        if (wr == 1) PG8_BAR;
        PG8_WAIT_V(4); PG8_BAR;
        PG8_STAGE(PG8_SB(1, 0), cB + kstep, voffB); PG8_STAGE(PG8_SA(1, 0), cA + kstep, voffA); PG8_STAGE(PG8_SB(1, 1), cB + hstep + kstep, voffB);
        PG8_WAIT_V(6); PG8_BAR;
    }
    for (;;) {
        const bool has_next = S.next(ui + 1, nxt);
        const char* nA = has_next ? (const char*)g.A + (size_t)nxt.pm * tstep : cA; const char* nB = has_next ? (const char*)g.Bt + (size_t)nxt.pn * tstep : cB;
        for (int t = 0; t < nt; t += 2) {
            const bool last = (t == nt - 2);
            const char* a1 = cA + (size_t)(t + 1) * kstep;
            const char* a2 = last ? nA : cA + (size_t)(t + 2) * kstep; const char* b2 = last ? nB : cB + (size_t)(t + 2) * kstep;
            const char* a3 = a2 + kstep; const char* b3 = b2 + kstep;
            if (last && has_next) S.a_ready(nxt);
            if constexpr (SP2) {
            PG8_LDB(B0, 0, 0); PG8_LDB(B1, 0, 1); PG8_SCHED; PG8_LDA(At, 0, 0); PG8_STAGE(PG8_SA(1, 1), a1 + hstep, voffA);
            PG8_WAIT_V(8); PG8_WAIT_L(0); PG8_BAR; PG8_MMA(0, 0, At, B0); PG8_MMA(0, 1, At, B1); PG8_BAR; PG8_SCHED;
            PG8_LDA(At, 0, 1); PG8_STAGE(PG8_SB(0, 0), b2, voffB); PG8_STAGE(PG8_SB(0, 1), b2 + hstep, voffB); PG8_STAGE(PG8_SA(0, 0), a2, voffA);
            PG8_WAIT_V(8); PG8_WAIT_L(0); PG8_BAR; PG8_MMA(1, 0, At, B0); PG8_MMA(1, 1, At, B1); PG8_BAR; PG8_SCHED;
            PG8_LDB(B0, 1, 0); PG8_LDB(B1, 1, 1); PG8_SCHED; PG8_LDA(At, 1, 0); PG8_STAGE(PG8_SA(0, 1), a2 + hstep, voffA);
            PG8_WAIT_V(8); PG8_WAIT_L(0); PG8_BAR; PG8_MMA(0, 0, At, B0); PG8_MMA(0, 1, At, B1); PG8_BAR; PG8_SCHED;
            PG8_LDA(At, 1, 1); PG8_STAGE(PG8_SB(1, 0), b3, voffB); PG8_STAGE(PG8_SB(1, 1), b3 + hstep, voffB); PG8_STAGE(PG8_SA(1, 0), a3, voffA);
            PG8_WAIT_V(8); PG8_WAIT_L(0); PG8_BAR; PG8_MMA(1, 0, At, B0); PG8_MMA(1, 1, At, B1); PG8_BAR; PG8_SCHED;
            } else {
            PG8_LDB(B0, 0, 0); PG8_SCHED; PG8_LDA(At, 0, 0); PG8_STAGE(PG8_SA(1, 1), a1 + hstep, voffA);
            PG8_WAIT_L(8); PG8_BAR; PG8_WAIT_L(0); PG8_MMA(0, 0, At, B0); PG8_BAR; PG8_SCHED;
            PG8_LDB(B1, 0, 1); PG8_STAGE(PG8_SB(0, 0), b2, voffB);
            PG8_BAR; PG8_WAIT_L(0); PG8_MMA(0, 1, At, B1); PG8_BAR;
            PG8_LDA(At, 0, 1); PG8_STAGE(PG8_SA(0, 0), a2, voffA);
            PG8_BAR; PG8_WAIT_L(0); PG8_MMA(1, 0, At, B0); PG8_BAR; PG8_SCHED;
            PG8_STAGE(PG8_SB(0, 1), b2 + hstep, voffB);
            PG8_WAIT_V(6); PG8_BAR; PG8_MMA(1, 1, At, B1); PG8_BAR;
            PG8_LDB(B0, 1, 0); PG8_SCHED; PG8_LDA(At, 1, 0); PG8_STAGE(PG8_SA(0, 1), a2 + hstep, voffA);
            PG8_WAIT_L(8); PG8_BAR; PG8_WAIT_L(0); PG8_MMA(0, 0, At, B0); PG8_BAR; PG8_SCHED;
            PG8_LDB(B1, 1, 1); PG8_STAGE(PG8_SB(1, 0), b3, voffB);
            PG8_BAR; PG8_WAIT_L(0); PG8_MMA(0, 1, At, B1); PG8_BAR;
            PG8_LDA(At, 1, 1); PG8_STAGE(PG8_SA(1, 0), a3, voffA);
            PG8_BAR; PG8_WAIT_L(0); PG8_MMA(1, 0, At, B0); PG8_BAR; PG8_SCHED;
            PG8_STAGE(PG8_SB(1, 1), b3 + hstep, voffB);
            PG8_WAIT_V(6); PG8_BAR; PG8_MMA(1, 1, At, B1); PG8_BAR;
            }
        }
        if constexpr (ALIGN_EPI) { if (wr == 0) PG8_BAR; }
        if constexpr (!Epi::AFTER_DRAIN) { E(acc, cur, wr, wc, fr, fq); S.done(cur); }
        if (!has_next) break;
#pragma unroll
        for (int a = 0; a < 2; ++a)
#pragma unroll
            for (int b = 0; b < 2; ++b)
#pragma unroll
                for (int m = 0; m < 4; ++m)
#pragma unroll
                    for (int n = 0; n < 2; ++n) acc[a][b][m][n] = (f32x4){0.f, 0.f, 0.f, 0.f};
        cur = nxt; cA = nA; cB = nB; ++ui;
        if constexpr (ALIGN_EPI) { if (wr == 1) PG8_BAR; }
    }
    PG8_WAIT_V(0);
    if constexpr (!ALIGN_EPI) { if (wr == 0) PG8_BAR; }
    PG8_BAR;
    if constexpr (Epi::AFTER_DRAIN) { E.fused(acc, cur, wr, wc, fr, fq, lds, wid, lane); S.done(cur); }
#undef PG8_SA
#undef PG8_SB
#undef PG8_STAGE
#undef PG8_LDA
#undef PG8_LDB
#undef PG8_MMA
#undef PG8_WAIT_V
#undef PG8_WAIT_L
#undef PG8_BAR
#undef PG8_SCHED
}
}

#define GAS __attribute__((address_space(1)))
#define LAS __attribute__((address_space(3)))
typedef unsigned short bf16_t;
typedef unsigned u32x4 __attribute__((ext_vector_type(4)));
typedef unsigned u32x2 __attribute__((ext_vector_type(2)));
typedef int i32x4 __attribute__((ext_vector_type(4)));
typedef float f32x4 __attribute__((ext_vector_type(4)));
typedef float f32x16 __attribute__((ext_vector_type(16)));
typedef short bf16x8 __attribute__((ext_vector_type(8)));
using pg8::cvt_pk_bf16; using pg8::bf_lo; using pg8::bf_hi;

constexpr int NWAVES = 8, NTHREADS = 512;
constexpr int BATCH = 8, SEQ = 2048, DM = 2048, M = BATCH * SEQ, DFF = 5632;
constexpr int NIN = 3904, NIN_PAD = 4096;
constexpr float EPS = 1e-6f, LOG2E = 1.44269504088896f;
constexpr float QSCALE_A = 0.125f * LOG2E;
constexpr float QSCALE_B = 0.07216878364870322f * LOG2E;
constexpr float LAM_INIT = 0.2f;

constexpr size_t MiB = 1u << 20;
constexpr size_t WS_WGATE = 1 * MiB, WS_WUP = 23 * MiB, WS_WDOWN = 45 * MiB;
constexpr size_t WS_H = 67 * MiB;
constexpr size_t WS_BIG = 131 * MiB;
constexpr size_t WS_WIN = WS_BIG + 0, WS_WUQ = WS_BIG + 16 * MiB, WS_WUKV = WS_BIG + 18 * MiB, WS_WOUT = WS_BIG + 19 * MiB;
constexpr size_t WS_PROJ = WS_BIG + 27 * MiB;
constexpr size_t WS_QLAT = WS_BIG + 27 * MiB, WS_KVRAW = WS_BIG + 75 * MiB;
constexpr size_t WS_AO = WS_BIG + 27 * MiB;
constexpr size_t WS_DQ = WS_BIG + 149 * MiB, WS_DK = WS_BIG + 181 * MiB, WS_DVT = WS_BIG + 213 * MiB;
constexpr size_t WS_CQN = WS_BIG + 245 * MiB, WS_CKVN = WS_BIG + 261 * MiB, WS_KR = WS_BIG + 269 * MiB;
constexpr size_t DO_MQ = 0, DO_MK = 48 * MiB, DO_MVT = 96 * MiB;
constexpr size_t WS_G = WS_BIG, WS_ACT = WS_BIG + 176 * MiB;
constexpr size_t WS_WCIN = WS_BIG, WS_WCOUT = WS_BIG + 24 * MiB, WS_P = WS_BIG + 32 * MiB, WS_Z = WS_BIG + 96 * MiB;
constexpr size_t WS_END = WS_BIG + 352 * MiB;

constexpr int RING_BYTES = 131072;
constexpr int LDS_BYTES = 147456;

struct Args {
    const float* in[29]; float* out; unsigned char* ws;
};
#define CAS __attribute__((address_space(4)))
typedef const CAS Args* ArgP;

__device__ __forceinline__ float wave_sum(float v) {
#pragma unroll
    for (int o = 1; o < 64; o <<= 1) v += __shfl_xor(v, o);
    return v;
}
#define LDS_WAIT() asm volatile("s_waitcnt lgkmcnt(0)" ::: "memory")

#define TW_LOAD(it_, dst_, g0_, g1_) do { const int kb_ = (it_) / nblk, nb_ = (it_) % nblk, k0_ = 64 * kb_, n0_ = 32 * nb_; \
        _Pragma("unroll") for (int i_ = 0; i_ < 32; ++i_) { const int kk_ = 2 * i_ + (lane >> 5); dst_[i_] = W[(size_t)(k0_ + kk_) * N + n0_ + (lane & 31)]; } \
        if (gk) { g0_ = *(const f32x4*)(gk + k0_ + 8 * c); g1_ = *(const f32x4*)(gk + k0_ + 8 * c + 4); } } while (0)
template <int MODE>
__device__ __forceinline__ void transpose_weight(const float* W, int K, int N, bf16_t* WT, LAS float* scr, int gw, int NGW, int lane, const float* gk = nullptr) {
    const int nblk = N / 32, nitems = (K / 64) * nblk;
    const int c = lane & 7;
    float cur[32], nxt[32];
    f32x4 gc0 = {1.f, 1.f, 1.f, 1.f}, gc1 = gc0, gn0 = gc0, gn1 = gc0;
    int it = gw;
    if (it < nitems) TW_LOAD(it, cur, gc0, gc1);
    while (it < nitems) {
        const int itn = it + NGW;
        if (itn < nitems) TW_LOAD(itn, nxt, gn0, gn1);
        const int kb = it / nblk, nb = it % nblk, k0 = 64 * kb, n0 = 32 * nb;
        int drow = n0;
        if (MODE == 1) { if (n0 < 2048) drow = 4096 + n0; else if (n0 < 4096) { const int cc = n0 - 2048; drow = (cc >> 7) * 256 + (cc & 127); } else { const int cc = n0 - 4096; drow = (cc >> 7) * 256 + 128 + (cc & 127); } }
#pragma unroll
        for (int i = 0; i < 32; ++i) { const int kk = 2 * i + (lane >> 5); scr[kk * 33 + (lane & 31)] = cur[i]; }
        LDS_WAIT(); asm volatile("" ::: "memory");
#pragma unroll
        for (int j = 0; j < 4; ++j) { const int n = (lane >> 3) + 8 * j; const LAS float* sp = scr + (8 * c) * 33 + n;
            u32x4 o; o.x = cvt_pk_bf16(sp[0 * 33] * gc0[0], sp[1 * 33] * gc0[1]); o.y = cvt_pk_bf16(sp[2 * 33] * gc0[2], sp[3 * 33] * gc0[3]);
            o.z = cvt_pk_bf16(sp[4 * 33] * gc1[0], sp[5 * 33] * gc1[1]); o.w = cvt_pk_bf16(sp[6 * 33] * gc1[2], sp[7 * 33] * gc1[3]);
            *(u32x4*)(WT + (size_t)(drow + n) * K + k0 + 8 * c) = o; }
        LDS_WAIT(); asm volatile("" ::: "memory");
#pragma unroll
        for (int i = 0; i < 32; ++i) cur[i] = nxt[i];
        gc0 = gn0; gc1 = gn1; it = itn;
    }
}
__device__ __forceinline__ void rms_row_to_bf16(const float* xrow, const float* g, bf16_t* orow, int lane) {
    const f32x4* xr = (const f32x4*)xrow + lane; const f32x4* gr = (const f32x4*)g + lane;
    f32x4 v[8]; float s = 0.f;
#pragma unroll
    for (int j = 0; j < 8; ++j) { v[j] = xr[64 * j]; s += (v[j].x * v[j].x + v[j].y * v[j].y) + (v[j].z * v[j].z + v[j].w * v[j].w); }
    const float rstd = 1.0f / sqrtf(wave_sum(s) * (1.0f / DM) + EPS);
    u32x2* o8 = (u32x2*)orow + lane;
#pragma unroll
    for (int j = 0; j < 8; ++j) { const f32x4 gg = gr[64 * j]; u32x2 w; w.x = cvt_pk_bf16(v[j].x * rstd * gg.x, v[j].y * rstd * gg.y); w.y = cvt_pk_bf16(v[j].z * rstd * gg.z, v[j].w * rstd * gg.w); o8[64 * j] = w; }
}
__device__ __forceinline__ void rms_phase(const float* X, const float* g, bf16_t* H, int gw, int NGW, int lane) {
    for (int m = gw; m < M; m += 2 * NGW) {
        const int m2 = m + NGW; const bool two = m2 < M;
        const f32x4* xa = (const f32x4*)(X + (size_t)m * DM) + lane; const f32x4* xb = (const f32x4*)(X + (size_t)(two ? m2 : m) * DM) + lane; const f32x4* gr = (const f32x4*)g + lane;
        f32x4 va[8], vb[8]; float sa = 0.f, sb = 0.f;
#pragma unroll
        for (int j = 0; j < 8; ++j) { va[j] = xa[64 * j]; vb[j] = xb[64 * j]; }
#pragma unroll
        for (int j = 0; j < 8; ++j) { sa += (va[j].x * va[j].x + va[j].y * va[j].y) + (va[j].z * va[j].z + va[j].w * va[j].w); sb += (vb[j].x * vb[j].x + vb[j].y * vb[j].y) + (vb[j].z * vb[j].z + vb[j].w * vb[j].w); }
        const float ra = 1.0f / sqrtf(wave_sum(sa) * (1.0f / DM) + EPS), rb = 1.0f / sqrtf(wave_sum(sb) * (1.0f / DM) + EPS);
        u32x2* oa = (u32x2*)(H + (size_t)m * DM) + lane; u32x2* ob = (u32x2*)(H + (size_t)m2 * DM) + lane;
#pragma unroll
        for (int j = 0; j < 8; ++j) { const f32x4 gg = gr[64 * j]; u32x2 w; w.x = cvt_pk_bf16(va[j].x * ra * gg.x, va[j].y * ra * gg.y); w.y = cvt_pk_bf16(va[j].z * ra * gg.z, va[j].w * ra * gg.w); oa[64 * j] = w;
            if (two) { u32x2 w2; w2.x = cvt_pk_bf16(vb[j].x * rb * gg.x, vb[j].y * rb * gg.y); w2.y = cvt_pk_bf16(vb[j].z * rb * gg.z, vb[j].w * rb * gg.w); ob[64 * j] = w2; } }
    }
}
__device__ __forceinline__ void rms_phase_chunk(const float* X, const float* g, bf16_t* H, int v, int G, int wid, int lane) {
    for (int ch = v; ch < M / 64; ch += G)
    for (int i8 = 0; i8 < 8; i8 += 2) {
        const int m = ch * 64 + wid * 8 + i8; const int m2 = m + 1; const bool two = true;
        const f32x4* xa = (const f32x4*)(X + (size_t)m * DM) + lane; const f32x4* xb = (const f32x4*)(X + (size_t)(two ? m2 : m) * DM) + lane; const f32x4* gr = (const f32x4*)g + lane;
        f32x4 va[8], vb[8]; float sa = 0.f, sb = 0.f;
#pragma unroll
        for (int j = 0; j < 8; ++j) { va[j] = xa[64 * j]; vb[j] = xb[64 * j]; }
#pragma unroll
        for (int j = 0; j < 8; ++j) { sa += (va[j].x * va[j].x + va[j].y * va[j].y) + (va[j].z * va[j].z + va[j].w * va[j].w); sb += (vb[j].x * vb[j].x + vb[j].y * vb[j].y) + (vb[j].z * vb[j].z + vb[j].w * vb[j].w); }
        const float ra = 1.0f / sqrtf(wave_sum(sa) * (1.0f / DM) + EPS), rb = 1.0f / sqrtf(wave_sum(sb) * (1.0f / DM) + EPS);
        u32x2* oa = (u32x2*)(H + (size_t)m * DM) + lane; u32x2* ob = (u32x2*)(H + (size_t)m2 * DM) + lane;
#pragma unroll
        for (int j = 0; j < 8; ++j) { const f32x4 gg = gr[64 * j]; u32x2 w; w.x = cvt_pk_bf16(va[j].x * ra * gg.x, va[j].y * ra * gg.y); w.y = cvt_pk_bf16(va[j].z * ra * gg.z, va[j].w * ra * gg.w); oa[64 * j] = w;
            if (two) { u32x2 w2; w2.x = cvt_pk_bf16(vb[j].x * rb * gg.x, vb[j].y * rb * gg.y); w2.y = cvt_pk_bf16(vb[j].z * rb * gg.z, vb[j].w * rb * gg.w); ob[64 * j] = w2; } }
    }
}

__device__ __forceinline__ int perm16(int w) { return (w & 3) | (((w >> 3) & 1) << 2) | (((w >> 2) & 1) << 3); }

__device__ __forceinline__ void vt_tile8(const bf16_t* src, int ld, int hstride, bf16_t* vt, int t0, LAS unsigned char* lds, int tid) {
    LAS bf16_t* T = (LAS bf16_t*)lds;
    u32x4 v[2][8];
#pragma unroll
    for (int hb = 0; hb < 2; ++hb)
#pragma unroll
        for (int i = 0; i < 8; ++i) { const int c = tid + i * NTHREADS, r = c >> 6, hc = c & 63, hq = hc >> 4, cc = hc & 15; v[hb][i] = *(const u32x4*)(src + (size_t)r * ld + (hb * 4 + hq) * hstride + cc * 8); }
#pragma unroll
    for (int hb = 0; hb < 2; ++hb) {
#pragma unroll
        for (int i = 0; i < 8; ++i) { const int c = tid + i * NTHREADS, r = c >> 6, hc = c & 63; *(LAS u32x4*)(T + r * 520 + hc * 8) = v[hb][i]; }
        __syncthreads();
#pragma unroll
        for (int i = 0; i < 8; ++i) { const int c = tid + i * NTHREADS, hq = c >> 10, dv = (c >> 3) & 127, q8 = c & 7, blk = q8 >> 1, hh = q8 & 1;
            unsigned e[8];
#pragma unroll
            for (int j = 0; j < 8; ++j) { const int key = blk * 16 + 8 * (j >> 2) + 4 * hh + (j & 3); e[j] = T[key * 520 + hq * 128 + dv]; }
            u32x4 o; o.x = e[0] | (e[1] << 16); o.y = e[2] | (e[3] << 16); o.z = e[4] | (e[5] << 16); o.w = e[6] | (e[7] << 16);
            *(u32x4*)(vt + (size_t)((hb * 4 + hq) * 128 + dv) * SEQ + t0 + blk * 16 + hh * 8) = o; }
        __syncthreads();
    }
}

__device__ __forceinline__ void p2_phase(ArgP ap, LAS unsigned char* lds, int tid, int wid, int lane) {
    unsigned char* ws = ap->ws;
    const bf16_t* PROJ = (const bf16_t*)(ws + WS_PROJ);
    bf16_t* DQ = (bf16_t*)(ws + WS_DQ); bf16_t* DK = (bf16_t*)(ws + WS_DK); bf16_t* DVT = (bf16_t*)(ws + WS_DVT);
    bf16_t* CQN = (bf16_t*)(ws + WS_CQN); bf16_t* CKVN = (bf16_t*)(ws + WS_CKVN); bf16_t* KR = (bf16_t*)(ws + WS_KR);
    const float* dq_g = ap->in[5]; const float* dk_g = ap->in[6]; const float* qa_g = ap->in[12]; const float* kva_g = ap->in[14];
    const int G_ = gridDim.x, bx_ = blockIdx.x, v_ = (G_ % 8 == 0) ? (bx_ % 8) * (G_ / 8) + bx_ / 8 : bx_;
    for (int u = v_; u < M / 64; u += G_) {
        const int tok0 = u * 64;
        for (int i = 0; i < 8; ++i) {
            const int row = tok0 + wid * 8 + i; const bf16_t* p = PROJ + (size_t)row * NIN;
#pragma unroll
            for (int part = 0; part < 2; ++part) {
                const float* g = part ? dk_g : dq_g; const float sc = part ? 1.0f : QSCALE_A; bf16_t* dst = (part ? DK : DQ) + (size_t)row * 1024;
#pragma unroll
                for (int c = 0; c < 2; ++c) {
                    const u32x4 v = *(const u32x4*)(p + part * 1024 + c * 512 + lane * 8);
                    float f[8]; float ss = 0.f;
#pragma unroll
                    for (int q = 0; q < 4; ++q) { f[2 * q] = bf_lo(v[q]); f[2 * q + 1] = bf_hi(v[q]); ss += f[2 * q] * f[2 * q] + f[2 * q + 1] * f[2 * q + 1]; }
                    ss += __shfl_xor(ss, 1); ss += __shfl_xor(ss, 2); ss += __shfl_xor(ss, 4);
                    const float rstd = sc / sqrtf(ss * (1.0f / 64.0f) + EPS);
                    const float* gg = g + (lane & 7) * 8;
                    u32x4 o;
#pragma unroll
                    for (int q = 0; q < 4; ++q) o[q] = cvt_pk_bf16(f[2 * q] * rstd * gg[2 * q], f[2 * q + 1] * rstd * gg[2 * q + 1]);
                    *(u32x4*)(dst + c * 512 + lane * 8) = o;
                }
            }
            {
                const u32x4 v = *(const u32x4*)(p + 3072 + lane * 8); float f[8]; float ss = 0.f;
#pragma unroll
                for (int q = 0; q < 4; ++q) { f[2 * q] = bf_lo(v[q]); f[2 * q + 1] = bf_hi(v[q]); ss += f[2 * q] * f[2 * q] + f[2 * q + 1] * f[2 * q + 1]; }
                const float rstd = 1.0f / sqrtf(wave_sum(ss) * (1.0f / 512.0f) + EPS); const float* gg = qa_g + lane * 8; u32x4 o;
#pragma unroll
                for (int q = 0; q < 4; ++q) o[q] = cvt_pk_bf16(f[2 * q] * rstd * gg[2 * q], f[2 * q + 1] * rstd * gg[2 * q + 1]);
                *(u32x4*)(CQN + (size_t)row * 512 + lane * 8) = o;
            }
            {
                const int l2 = lane & 31; const u32x4 v = *(const u32x4*)(p + 3584 + l2 * 8); float f[8]; float ss = 0.f;
#pragma unroll
                for (int q = 0; q < 4; ++q) { f[2 * q] = bf_lo(v[q]); f[2 * q + 1] = bf_hi(v[q]); ss += f[2 * q] * f[2 * q] + f[2 * q + 1] * f[2 * q + 1]; }
                if (lane >= 32) ss = 0.f;
                const float rstd = 1.0f / sqrtf(wave_sum(ss) * (1.0f / 256.0f) + EPS); const float* gg = kva_g + l2 * 8; u32x4 o;
#pragma unroll
                for (int q = 0; q < 4; ++q) o[q] = cvt_pk_bf16(f[2 * q] * rstd * gg[2 * q], f[2 * q + 1] * rstd * gg[2 * q + 1]);
                if (lane < 32) *(u32x4*)(CKVN + (size_t)row * 256 + l2 * 8) = o;
            }
            if (lane < 8) *(u32x4*)(KR + (size_t)row * 64 + lane * 8) = *(const u32x4*)(p + 3840 + lane * 8);
        }
        const int b = tok0 / SEQ, t0 = tok0 % SEQ;
        vt_tile8(PROJ + (size_t)tok0 * NIN + 2048, NIN, 128, DVT + (size_t)(b * 8) * 128 * SEQ, t0, lds, tid);
    }
}

__device__ __forceinline__ float bfld(const bf16_t* p) { return __uint_as_float((unsigned)(*p) << 16); }
__device__ __forceinline__ void bfst(bf16_t* p, float v) { *p = (bf16_t)(cvt_pk_bf16(v, 0.f) & 0xffffu); }
__device__ __forceinline__ void p4_phase(ArgP ap, LAS unsigned char* lds, int tid, int wid, int lane) {
    unsigned char* ws = ap->ws;
    const bf16_t* QLAT = (const bf16_t*)(ws + WS_QLAT); const bf16_t* KVRAW = (const bf16_t*)(ws + WS_KVRAW); const bf16_t* KR = (const bf16_t*)(ws + WS_KR);
    bf16_t* MQ = (bf16_t*)((unsigned char*)ap->out + DO_MQ); bf16_t* MK = (bf16_t*)((unsigned char*)ap->out + DO_MK); bf16_t* MVT = (bf16_t*)((unsigned char*)ap->out + DO_MVT);
    const int* pos = (const int*)ap->in[1]; const float* mq_g = ap->in[16]; const float* mk_g = ap->in[17];
    const int l2 = lane & 31; const bool lo = lane < 32;
    const float inv_freq = __builtin_amdgcn_exp2f(-(float)l2 * 0.41524101186092029f);
    const float gq0 = mq_g[lane], gq1 = mq_g[64 + lane], gq2 = mq_g[128 + l2], gq3 = mq_g[160 + l2];
    const float gk0 = mk_g[lane], gk1 = mk_g[64 + lane], gk2 = mk_g[128 + l2], gk3 = mk_g[160 + l2];
    const int G_ = gridDim.x, bx_ = blockIdx.x, v_ = (G_ % 8 == 0) ? (bx_ % 8) * (G_ / 8) + bx_ / 8 : bx_;
    for (int u = v_; u < M / 64; u += G_) {
        const int tok0 = u * 64;
        for (int i = 0; i < 8; i += 2) {
            float qe0[2][8], qe1[2][8], qx1[2][8], qx2[2][8], ke0[2][8], ke1[2][8], kr1[2], kr2[2], cs[2], sn[2];
#pragma unroll
            for (int t = 0; t < 2; ++t) {
                const int row = tok0 + wid * 8 + i + t;
                const float ang = (float)pos[row] * inv_freq;
                const double rev = (double)ang * 0.15915494309189535; const float fr = (float)(rev - floor(rev));
                cs[t] = __builtin_amdgcn_cosf(fr); sn[t] = __builtin_amdgcn_sinf(fr);
                kr1[t] = bfld(KR + (size_t)row * 64 + l2); kr2[t] = bfld(KR + (size_t)row * 64 + 32 + l2);
#pragma unroll
                for (int h = 0; h < 8; ++h) {
                    const bf16_t* sq = QLAT + (size_t)row * 1536 + h * 192; const bf16_t* sk = KVRAW + (size_t)row * 2048 + h * 256;
                    qe0[t][h] = bfld(sq + lane); qe1[t][h] = bfld(sq + 64 + lane); qx1[t][h] = bfld(sq + 128 + l2); qx2[t][h] = bfld(sq + 160 + l2);
                    ke0[t][h] = bfld(sk + lane); ke1[t][h] = bfld(sk + 64 + lane); }
            }
#pragma unroll
            for (int t = 0; t < 2; ++t) {
                const int row = tok0 + wid * 8 + i + t;
#pragma unroll
                for (int h = 0; h < 8; ++h) {
                    {
                        const float e0 = qe0[t][h], e1 = qe1[t][h], x1 = qx1[t][h], x2 = qx2[t][h];
                        float ss = e0 * e0 + e1 * e1 + (lo ? x1 * x1 + x2 * x2 : 0.f);
                        const float rstd = QSCALE_B / sqrtf(wave_sum(ss) * (1.0f / 192.0f) + EPS);
                        const float n1 = x1 * rstd * gq2, n2 = x2 * rstd * gq3;
                        bf16_t* d = MQ + (size_t)row * 1536 + h * 192;
                        bfst(d + lane, e0 * rstd * gq0); bfst(d + 64 + lane, e1 * rstd * gq1);
                        if (lo) { bfst(d + 128 + l2, n1 * cs[t] - n2 * sn[t]); bfst(d + 160 + l2, n2 * cs[t] + n1 * sn[t]); }
                    }
                    {
                        const float e0 = ke0[t][h], e1 = ke1[t][h];
                        float ss = e0 * e0 + e1 * e1 + (lo ? kr1[t] * kr1[t] + kr2[t] * kr2[t] : 0.f);
                        const float rstd = 1.0f / sqrtf(wave_sum(ss) * (1.0f / 192.0f) + EPS);
                        const float n1 = kr1[t] * rstd * gk2, n2 = kr2[t] * rstd * gk3;
                        bf16_t* d = MK + (size_t)row * 1536 + h * 192;
                        bfst(d + lane, e0 * rstd * gk0); bfst(d + 64 + lane, e1 * rstd * gk1);
                        if (lo) { bfst(d + 128 + l2, n1 * cs[t] - n2 * sn[t]); bfst(d + 160 + l2, n2 * cs[t] + n1 * sn[t]); }
                    }
                }
            }
        }
        const int b = tok0 / SEQ, t0 = tok0 % SEQ;
        vt_tile8(KVRAW + (size_t)tok0 * 2048 + 128, 2048, 256, MVT + (size_t)(b * 8) * 128 * SEQ, t0, lds, tid);
    }
}


constexpr size_t WS_CTL = 0, CTL_ZERO_BYTES = 262144, WS_SS = 65536;
constexpr int MISC_OFF = RING_BYTES + 320;
#define XB_TMO      128
#define XB_XCNT(j)  (256  + 64 * (j))
#define XB_XSUB(j)  (1280 + 64 * (j))
#define XB_XGEN(j)  (2304 + 64 * (j))
#define XB_TOP      3328
#define XB_TOPGEN   3392
#define XCD_BAR_WORDS 3456
#define XB_SPIN_CAP (1u << 18)

__device__ __forceinline__ unsigned xb_ld(unsigned* p)              { return __hip_atomic_load(p, __ATOMIC_RELAXED, __HIP_MEMORY_SCOPE_AGENT); }
__device__ __forceinline__ unsigned xb_add(unsigned* p, unsigned v) { return __hip_atomic_fetch_add(p, v, __ATOMIC_RELAXED, __HIP_MEMORY_SCOPE_AGENT); }
__device__ __forceinline__ unsigned xb_xcc_id() { return (unsigned)__builtin_amdgcn_s_getreg((3 << 11) | 20) & 0xFu; }
#define XB_SPIN(cond, bar) do { unsigned _sp = 0; while (cond) { __builtin_amdgcn_s_sleep(1); \
    if ((++_sp & 255u) == 0u) { if (xb_ld(&(bar)[XB_TMO])) break; if (_sp > XB_SPIN_CAP) { atomicAdd(&(bar)[XB_TMO], 1u); break; } } } } while (0)

struct XcdBarrier {
    unsigned* bar; unsigned x;
    volatile LAS unsigned* st;
};

__device__ __forceinline__ XcdBarrier xcd_barrier_post(unsigned* bar, volatile LAS unsigned* st) {
    XcdBarrier b; b.bar = bar; b.x = xb_xcc_id(); b.st = st;
    if (threadIdx.x == 0) (void)xb_add(&bar[XB_XCNT(b.x)], 1u);
    return b;
}
__device__ __forceinline__ void xcd_barrier_complete(unsigned* bar, unsigned x, unsigned& nloc, unsigned& nx) {
    const unsigned G = gridDim.x * gridDim.y * gridDim.z;
    unsigned sum, cnt, mine, sp = 0u;
    for (;;) {
        sum = 0u; cnt = 0u; mine = 0u;
#pragma unroll
        for (unsigned j = 0; j < 16; ++j) { const unsigned c = xb_ld(&bar[XB_XCNT(j)]); sum += c; cnt += (c > 0u) ? 1u : 0u; mine = (j == x) ? c : mine; }
        if (sum == G) break;
        __builtin_amdgcn_s_sleep(1);
        if ((++sp & 255u) == 0u) { if (xb_ld(&bar[XB_TMO])) break; if (sp > XB_SPIN_CAP) { atomicAdd(&bar[XB_TMO], 1u); break; } }
    }
    nloc = mine > 0u ? mine : 1u; nx = cnt > 0u ? cnt : 1u;
}

__device__ __forceinline__ void xcd_barrier(const XcdBarrier& b) {
    asm volatile("s_waitcnt vmcnt(0)" ::: "memory");
    __syncthreads();
    if (threadIdx.x == 0) {
        unsigned* bar = b.bar; asm volatile("" : "+s"(bar));
        __builtin_amdgcn_s_waitcnt(0);
        unsigned nloc = b.st[0], nx = b.st[1];
        if (nloc == 0u) { xcd_barrier_complete(bar, b.x, nloc, nx); b.st[0] = nloc; b.st[1] = nx; }
        const unsigned old = xb_add(&bar[XB_XSUB(b.x)], 1u);
        const unsigned gen = old / nloc;
        if (old + 1u == (gen + 1u) * nloc) {
            __builtin_amdgcn_fence(__ATOMIC_RELEASE, "agent");
            asm volatile("s_waitcnt vmcnt(0)" ::: "memory");
            const unsigned og = xb_add(&bar[XB_TOP], 1u);
            const unsigned tg = og / nx;
            if (og + 1u == (tg + 1u) * nx) xb_add(&bar[XB_TOPGEN], 1u);
            else XB_SPIN(xb_ld(&bar[XB_TOPGEN]) == tg, bar);
            __builtin_amdgcn_fence(__ATOMIC_ACQUIRE, "agent");
            xb_add(&bar[XB_XGEN(b.x)], 1u);
            asm volatile("s_waitcnt vmcnt(0)" ::: "memory");
        } else {
            XB_SPIN(xb_ld(&bar[XB_XGEN(b.x)]) == gen, bar);
            __builtin_amdgcn_fence(__ATOMIC_ACQUIRE, "agent");
            asm volatile("s_waitcnt vmcnt(0)" ::: "memory");
        }
    }
    __syncthreads();
}

#define MFMA32(a, b, c) __builtin_amdgcn_mfma_f32_32x32x16_bf16((a), (b), (c), 0, 0, 0)
template <bool DIFF>
__device__ __forceinline__ void attn_unit(LAS unsigned char* lds, const bf16_t* Qg, const bf16_t* Kg, const bf16_t* VTg, bf16_t* AO,
                                          const int* pos, const float* rel_table, const float* subln_g, float lam,
                                          int b, int h, int qb, int tid_in, int wid, int lane_in, bool fresh) {
    int tid = tid_in; asm volatile("" : "+v"(tid)); const int lane = tid & 63; (void)lane_in;
    constexpr int DKH = DIFF ? 64 : 192, KROW = DIFF ? 128 : 192, KSTR = KROW + 8, VSTR = 72;
    constexpr int K_BYTES = 64 * KSTR * 2, V_BYTES = 128 * VSTR * 2, BUF = K_BYTES + V_BYTES;
    constexpr int POS_OFF = 2 * BUF, LUT_OFF = POS_OFF + 8192, TMM_OFF = LUT_OFF + 1280;
    constexpr int ROWS = DIFF ? 128 : 256, QLD = DIFF ? 1024 : 1536, KLD = QLD, CPR = KROW / 8, NKC = (64 * CPR) / NTHREADS, NKS = DKH / 16;
    static_assert(TMM_OFF + 256 <= RING_BYTES, "attention LDS");
    const int r = lane & 31, hh = lane >> 5;
    const int rg = DIFF ? (wid >> 1) : wid, hf = DIFF ? (wid & 1) : 0;
    const int qrow = b * SEQ + qb * ROWS + rg * 32 + r;
    const bf16_t* Kb = Kg + (size_t)b * SEQ * KLD + h * KROW;
    const bf16_t* Vb = VTg + (size_t)(b * 8 + h) * 128 * SEQ;

    int pq4 = 0;
    if (DIFF) {
        LAS int* P4 = (LAS int*)(lds + POS_OFF); LAS float* LUT = (LAS float*)(lds + LUT_OFF);
        if (fresh) for (int i = tid; i < SEQ; i += NTHREADS) P4[i] = 4 * pos[b * SEQ + i];
        if (fresh && tid < 257) { const int rel = tid - 128, n = rel < 0 ? -rel : rel;
            const int large = 8 + (n >= 12) + (n >= 16) + (n >= 23) + (n >= 32) + (n >= 46) + (n >= 64) + (n >= 91);
            const int bucket = (rel > 0 ? 16 : 0) + (n < 8 ? n : (large < 15 ? large : 15));
            LUT[tid] = rel_table[bucket * 8 + h] * LOG2E; }
        pq4 = 4 * pos[qrow];
    }
    bf16x8 qf[NKS];
    { const bf16_t* qp = Qg + (size_t)qrow * QLD + h * KROW + hf * 64 + 8 * hh;
#pragma unroll
      for (int ks = 0; ks < NKS; ++ks) qf[ks] = *(const bf16x8*)(qp + 16 * ks); }

    u32x4 kreg[NKC], vreg[2];
    auto load_tile = [&](int kt) {
#pragma unroll
        for (int i = 0; i < NKC; ++i) { const int c = tid + i * NTHREADS, row = c / CPR, cc = c % CPR; kreg[i] = *(const u32x4*)(Kb + (size_t)(kt * 64 + row) * KLD + cc * 8); }
#pragma unroll
        for (int i = 0; i < 2; ++i) { const int c = tid + i * NTHREADS, dv = c >> 3, cc = c & 7; vreg[i] = *(const u32x4*)(Vb + (size_t)dv * SEQ + kt * 64 + cc * 8); }
    };
    auto store_tile = [&](int buf) {
        LAS unsigned char* kb_ = lds + buf * BUF; LAS unsigned char* vb_ = kb_ + K_BYTES;
#pragma unroll
        for (int i = 0; i < NKC; ++i) { const int c = tid + i * NTHREADS, row = c / CPR, cc = c % CPR; *(LAS u32x4*)(kb_ + (row * KSTR + cc * 8) * 2) = kreg[i]; }
#pragma unroll
        for (int i = 0; i < 2; ++i) { const int c = tid + i * NTHREADS, dv = c >> 3, cc = c & 7; *(LAS u32x4*)(vb_ + (dv * VSTR + cc * 8) * 2) = vreg[i]; }
    };
    load_tile(0); store_tile(0);
    __syncthreads();
    int qmin4 = 0, qmax4 = 0; float bias_lo = 0.f, bias_hi = 0.f;
    if (DIFF) {
        if (fresh && tid < SEQ / 64) { const LAS int* P4 = (const LAS int*)(lds + POS_OFF) + tid * 64; int mn = P4[0], mx_ = P4[0];
            for (int i = 1; i < 64; ++i) { const int v = P4[i]; mn = v < mn ? v : mn; mx_ = v > mx_ ? v : mx_; }
            ((LAS int*)(lds + TMM_OFF))[2 * tid] = mn; ((LAS int*)(lds + TMM_OFF))[2 * tid + 1] = mx_; }
        qmin4 = pq4; qmax4 = pq4;
#pragma unroll
        for (int o = 1; o < 64; o <<= 1) { const int a_ = __shfl_xor(qmin4, o), b_ = __shfl_xor(qmax4, o); qmin4 = a_ < qmin4 ? a_ : qmin4; qmax4 = b_ > qmax4 ? b_ : qmax4; }
        bias_lo = *(const LAS float*)(lds + LUT_OFF);
        bias_hi = *(const LAS float*)(lds + LUT_OFF + 1024);
        __syncthreads();
    }

    f32x16 O[4];
#pragma unroll
    for (int d = 0; d < 4; ++d)
#pragma unroll
        for (int i = 0; i < 16; ++i) O[d][i] = 0.f;
    float m_used = -INFINITY, lsum = 0.f;

    for (int kt = 0; kt < SEQ / 64; ++kt) {
        const bool more = kt + 1 < SEQ / 64;
        if (more) load_tile(kt + 1);
        LAS unsigned char* kbuf = lds + (kt & 1) * BUF; LAS unsigned char* vbuf = kbuf + K_BYTES;
        f32x16 s[2];
        if (DIFF) {
            const int tmn = ((const LAS int*)(lds + TMM_OFF))[2 * kt], tmx = ((const LAS int*)(lds + TMM_OFF))[2 * kt + 1];
            const bool far_hi = __builtin_amdgcn_readfirstlane(tmn - qmax4) >= 512, far_lo = __builtin_amdgcn_readfirstlane(tmx - qmin4) <= -512;
            if (far_hi || far_lo) {
                const float cb = far_hi ? bias_hi : bias_lo;
#pragma unroll
                for (int kb = 0; kb < 2; ++kb)
#pragma unroll
                    for (int i = 0; i < 16; ++i) s[kb][i] = cb;
            } else {
#pragma unroll
                for (int kb = 0; kb < 2; ++kb) {
                    const LAS int* P4 = (const LAS int*)(lds + POS_OFF) + kt * 64 + 32 * kb + 4 * hh;
#pragma unroll
                    for (int g = 0; g < 4; ++g) { const i32x4 pk = *(const LAS i32x4*)(P4 + 8 * g);
#pragma unroll
                        for (int j = 0; j < 4; ++j) { int d = pk[j] - pq4; d = d < -512 ? -512 : (d > 512 ? 512 : d); s[kb][4 * g + j] = *(const LAS float*)(lds + LUT_OFF + 512 + d); } }
                }
            }
        } else {
#pragma unroll
            for (int kb = 0; kb < 2; ++kb)
#pragma unroll
                for (int i = 0; i < 16; ++i) s[kb][i] = 0.f;
        }
        {
            const LAS unsigned char* kp0 = kbuf + (r * KSTR + hf * 64 + 8 * hh) * 2; const LAS unsigned char* kp1 = kp0 + 32 * KSTR * 2;
#pragma unroll
            for (int ks = 0; ks < NKS; ++ks) { const bf16x8 kf0 = *(const LAS bf16x8*)(kp0 + 32 * ks), kf1 = *(const LAS bf16x8*)(kp1 + 32 * ks);
                s[0] = MFMA32(kf0, qf[ks], s[0]); s[1] = MFMA32(kf1, qf[ks], s[1]); }
        }
        float mx = s[0][0];
#pragma unroll
        for (int i = 1; i < 16; ++i) mx = fmaxf(mx, s[0][i]);
#pragma unroll
        for (int i = 0; i < 16; ++i) mx = fmaxf(mx, s[1][i]);
        mx = fmaxf(mx, __shfl_xor(mx, 32));
        const bool need = mx > m_used + 8.0f;
        if (__builtin_amdgcn_ballot_w64(need) != 0ull) {
            const float m_new = need ? mx : m_used;
            const float alpha = __builtin_amdgcn_exp2f(m_used - m_new);
            lsum *= alpha;
#pragma unroll
            for (int d = 0; d < 4; ++d) O[d] = O[d] * alpha;
            m_used = m_new;
        }
#pragma unroll
        for (int kb = 0; kb < 2; ++kb)
#pragma unroll
            for (int i = 0; i < 16; ++i) { const float p = __builtin_amdgcn_exp2f(s[kb][i] - m_used); s[kb][i] = p; lsum += p; }
#pragma unroll
        for (int kb = 0; kb < 2; ++kb)
#pragma unroll
            for (int st = 0; st < 2; ++st) {
                u32x4 pw;
#pragma unroll
                for (int q = 0; q < 4; ++q) pw[q] = cvt_pk_bf16(s[kb][8 * st + 2 * q], s[kb][8 * st + 2 * q + 1]);
                const bf16x8 pf = __builtin_bit_cast(bf16x8, pw);
                const LAS unsigned char* vp = vbuf + (r * VSTR + (2 * kb + st) * 16 + 8 * hh) * 2;
#pragma unroll
                for (int d = 0; d < 4; ++d) { const bf16x8 vf = *(const LAS bf16x8*)(vp + d * 32 * VSTR * 2); O[d] = MFMA32(vf, pf, O[d]); }
            }
        if (more) store_tile((kt + 1) & 1);
        __syncthreads();
    }
    const float ltot = lsum + __shfl_xor(lsum, 32);
    const float inv = 1.0f / ltot;
    if (DIFF) {
        LAS float* XO = (LAS float*)lds + (size_t)rg * 64 * 64 + lane;
        if (hf == 1) {
#pragma unroll
            for (int d = 0; d < 4; ++d)
#pragma unroll
                for (int i = 0; i < 16; ++i) XO[(d * 16 + i) * 64] = O[d][i] * inv;
        }
        __syncthreads();
        if (hf == 0) {
            float ss = 0.f;
#pragma unroll
            for (int d = 0; d < 4; ++d)
#pragma unroll
                for (int i = 0; i < 16; ++i) { const float o = O[d][i] * inv - lam * XO[(d * 16 + i) * 64]; O[d][i] = o; ss += o * o; }
            ss += __shfl_xor(ss, 32);
            const float rstd = (1.0f - LAM_INIT) / sqrtf(ss * (1.0f / 128.0f) + EPS);
            bf16_t* op = AO + (size_t)qrow * 2048 + h * 128 + 4 * hh;
#pragma unroll
            for (int d = 0; d < 4; ++d)
#pragma unroll
                for (int g = 0; g < 4; ++g) { const f32x4 gg = *(const f32x4*)(subln_g + 32 * d + 8 * g + 4 * hh);
                    u32x2 w; w.x = cvt_pk_bf16(O[d][4 * g] * rstd * gg.x, O[d][4 * g + 1] * rstd * gg.y); w.y = cvt_pk_bf16(O[d][4 * g + 2] * rstd * gg.z, O[d][4 * g + 3] * rstd * gg.w);
                    *(u32x2*)(op + 32 * d + 8 * g) = w; }
        }
        __syncthreads();
    } else {
        bf16_t* op = AO + (size_t)qrow * 2048 + 1024 + h * 128 + 4 * hh;
#pragma unroll
        for (int d = 0; d < 4; ++d)
#pragma unroll
            for (int g = 0; g < 4; ++g) { u32x2 w; w.x = cvt_pk_bf16(O[d][4 * g] * inv, O[d][4 * g + 1] * inv); w.y = cvt_pk_bf16(O[d][4 * g + 2] * inv, O[d][4 * g + 3] * inv);
                *(u32x2*)(op + 32 * d + 8 * g) = w; }
    }
}

__device__ __forceinline__ void attn_phase_mla(ArgP ap, LAS unsigned char* lds, int tid, int wid, int lane) {
    const bf16_t* MQ = (const bf16_t*)((unsigned char*)ap->out + DO_MQ); const bf16_t* MK = (const bf16_t*)((unsigned char*)ap->out + DO_MK); const bf16_t* MVT = (const bf16_t*)((unsigned char*)ap->out + DO_MVT);
    bf16_t* AO = (bf16_t*)(ap->ws + WS_AO);
    const int G = gridDim.x, bx = blockIdx.x, v = (G % 8 == 0) ? (bx % 8) * (G / 8) + bx / 8 : bx;
    const bool fast = (512 % G == 0); const int per = fast ? 512 / G : 0;
    for (int i = 0; ; ++i) { int u; if (fast) { if (i >= per) break; u = v * per + i; } else { u = bx + i * G; if (u >= 512) break; }
        const int qb = u & 7, h = (u >> 3) & 7, b = u >> 6;
        attn_unit<false>(lds, MQ, MK, MVT, AO, nullptr, nullptr, nullptr, 0.f, b, h, qb, tid, wid, lane, true); }
}
__device__ __forceinline__ void attn_phase_diff(ArgP ap, LAS unsigned char* lds, int tid, int wid, int lane) {
    unsigned char* ws = ap->ws;
    const bf16_t* DQ = (const bf16_t*)(ws + WS_DQ); const bf16_t* DK = (const bf16_t*)(ws + WS_DK); const bf16_t* DVT = (const bf16_t*)(ws + WS_DVT);
    bf16_t* AO = (bf16_t*)(ws + WS_AO);
    const int* pos = (const int*)ap->in[1];
    float d1 = 0.f, d2 = 0.f;
    { const float q1 = ap->in[7][lane], k1 = ap->in[8][lane], q2 = ap->in[9][lane], k2 = ap->in[10][lane]; d1 = wave_sum(q1 * k1); d2 = wave_sum(q2 * k2); }
    const float lam = expf(d1) - expf(d2) + LAM_INIT;
    const int G = gridDim.x, bx = blockIdx.x, v = (G % 8 == 0) ? (bx % 8) * (G / 8) + bx / 8 : bx;
    const bool fast = (1024 % G == 0 && 1024 / G <= 16 && 16 % (1024 / G) == 0); const int per = fast ? 1024 / G : 0;
    for (int i = 0; ; ++i) { int u; bool fresh; if (fast) { if (i >= per) break; u = v * per + i; fresh = (i == 0); } else { u = bx + i * G; if (u >= 1024) break; fresh = true; }
        const int qb = u & 15, h = (u >> 4) & 7, b = u >> 7;
        attn_unit<true>(lds, DQ, DK, DVT, AO, pos, ap->in[2], ap->in[11], lam, b, h, qb, tid, wid, lane, fresh); }
}

__global__ void __launch_bounds__(NTHREADS, 2) fwd_megakernel(Args a) {
    extern __shared__ __attribute__((aligned(16))) unsigned char lds_raw[];
    LAS unsigned char* lds = (LAS unsigned char*)lds_raw;
    cg::grid_group grid = cg::this_grid();
    if (gridDim.x == 0x7fffffffu) grid.sync();
    { int t_ = threadIdx.x; if (t_ < 32) ((volatile LAS unsigned*)(lds + MISC_OFF))[t_] = 0u; }
    __syncthreads();
    XcdBarrier bar;
    { ArgP ap0 = (ArgP)__builtin_amdgcn_kernarg_segment_ptr(); bar = xcd_barrier_post((unsigned*)(ap0->ws + WS_CTL), (volatile LAS unsigned*)(lds + MISC_OFF) + 8); }
#define ARGP() ArgP ap = (ArgP)__builtin_amdgcn_kernarg_segment_ptr(); asm volatile("" : "+s"(ap)); unsigned char* ws = ap->ws; (void)ws; bf16_t* H = (bf16_t*)(ws + WS_H); bf16_t* WG = (bf16_t*)(ws + WS_WGATE); bf16_t* WU = (bf16_t*)(ws + WS_WUP); bf16_t* WD = (bf16_t*)(ws + WS_WDOWN); (void)H; (void)WG; (void)WU; (void)WD;
#define FRESH_IDS() int tid = threadIdx.x; asm volatile("" : "+v"(tid)); const int lane = tid & 63, wid = __builtin_amdgcn_readfirstlane(tid >> 6); const int gw = blockIdx.x * NWAVES + wid; (void)gw; (void)lane;
    const int G = gridDim.x, NGW = G * NWAVES;
    typedef pg8::StaticOrder SO;

#ifndef PH_MASK
#define PH_MASK 0xffffffffu
#endif
#define PH(k) if ((PH_MASK >> (k)) & 1u)
    PH(0) { FRESH_IDS(); ARGP(); LAS float* scr = (LAS float*)(lds + wid * 16384);
    transpose_weight<0>(ap->in[4], DM, NIN, (bf16_t*)(ws + WS_WIN), scr, gw, NGW, lane);
    transpose_weight<0>(ap->in[13], 512, 1536, (bf16_t*)(ws + WS_WUQ), scr, gw, NGW, lane);
    transpose_weight<0>(ap->in[15], 256, 2048, (bf16_t*)(ws + WS_WUKV), scr, gw, NGW, lane);
    transpose_weight<0>(ap->in[18], DM, DM, (bf16_t*)(ws + WS_WOUT), scr, gw, NGW, lane);
    transpose_weight<0>(ap->in[24], DM, DFF, WG, scr, gw, NGW, lane, ap->in[23]);
    transpose_weight<0>(ap->in[25], DM, DFF, WU, scr, gw, NGW, lane, ap->in[23]);
    transpose_weight<0>(ap->in[28], DFF, DM, WD, scr, gw, NGW, lane);
    { const int G_ = gridDim.x, bx_ = blockIdx.x, v_ = (G_ % 8 == 0) ? (bx_ % 8) * (G_ / 8) + bx_ / 8 : bx_; rms_phase_chunk(ap->in[0], ap->in[3], H, v_, G_, wid, lane); } }
    xcd_barrier(bar);
    PH(1) { ARGP(); pg8::Gemm g{H, (const bf16_t*)(ws + WS_WIN), M, NIN_PAD, DM}; SO S; S.init(M, NIN_PAD, G, (int)blockIdx.x);
      pg8::EpiStoreBf16 E{(bf16_t*)(ws + WS_PROJ), NIN, NIN, nullptr};
      pg8::gemm_phase<pg8::EpiStoreBf16, SO, true, true>(lds, g, S, E); }
    xcd_barrier(bar);
    PH(2) { FRESH_IDS(); ARGP(); p2_phase(ap, lds, tid, wid, lane); }
    xcd_barrier(bar);
    PH(3) { ARGP(); pg8::Gemm g{(const bf16_t*)(ws + WS_CQN), (const bf16_t*)(ws + WS_WUQ), M, 1536, 512}; SO S; S.init(M, 1536, G, (int)blockIdx.x);
      pg8::EpiStoreBf16 E{(bf16_t*)(ws + WS_QLAT), 1536, 1536, nullptr};
      pg8::gemm_phase<pg8::EpiStoreBf16, SO, true, true>(lds, g, S, E); }
    PH(3) { ARGP(); pg8::Gemm g{(const bf16_t*)(ws + WS_CKVN), (const bf16_t*)(ws + WS_WUKV), M, 2048, 256}; SO S; S.init(M, 2048, G, (int)blockIdx.x);
      pg8::EpiStoreBf16 E{(bf16_t*)(ws + WS_KVRAW), 2048, 2048, nullptr};
      pg8::gemm_phase<pg8::EpiStoreBf16, SO, true, true>(lds, g, S, E); }
    xcd_barrier(bar);
    PH(4) { FRESH_IDS(); ARGP(); p4_phase(ap, lds, tid, wid, lane); }
    xcd_barrier(bar);
    PH(5) { FRESH_IDS(); ARGP(); attn_phase_mla(ap, lds, tid, wid, lane); }
    PH(5) { FRESH_IDS(); ARGP(); attn_phase_diff(ap, lds, tid, wid, lane); }
    xcd_barrier(bar);
    PH(6) { ARGP(); pg8::Gemm g{(const bf16_t*)(ws + WS_AO), (const bf16_t*)(ws + WS_WOUT), M, DM, DM}; SO S; S.init(M, DM, G, (int)blockIdx.x);
      pg8::EpiResidF32 E{ap->in[0], ap->out, DM, H, (float*)(ws + WS_SS)};
      pg8::gemm_phase<pg8::EpiResidF32, SO, true, true>(lds, g, S, E); }
    xcd_barrier(bar);
    {
        if (0 == 1) {
            PH(7) { FRESH_IDS(); ARGP(); LAS float* scr = (LAS float*)(lds + wid * 16384);
            transpose_weight<1>(ap->in[20], DM, 3 * DM, (bf16_t*)(ws + WS_WCIN), scr, gw, NGW, lane, ap->in[19]);
            transpose_weight<0>(ap->in[22], DM, DM, (bf16_t*)(ws + WS_WCOUT), scr, gw, NGW, lane);
            transpose_weight<0>(ap->in[24] + (size_t)DM * DFF, DM, DFF, WG, scr, gw, NGW, lane, ap->in[23] + DM);
            transpose_weight<0>(ap->in[25] + (size_t)DM * DFF, DM, DFF, WU, scr, gw, NGW, lane, ap->in[23] + DM);
            transpose_weight<0>(ap->in[28] + (size_t)DM * DFF, DFF, DM, WD, scr, gw, NGW, lane); }
            xcd_barrier(bar);
            PH(8) { ARGP(); pg8::Gemm g{H, (const bf16_t*)(ws + WS_WCIN), M, 2 * DM, DM}; SO S; S.init(M, 2 * DM, G, (int)blockIdx.x);
              pg8::EpiMulBf16 E{(bf16_t*)(ws + WS_P), DM, (const float*)(ws + WS_SS) + M};
              pg8::gemm_phase<pg8::EpiMulBf16, SO, true, true>(lds, g, S, E); }
            xcd_barrier(bar);
            PH(9) { ARGP(); pg8::Gemm g{H, (const bf16_t*)(ws + WS_WCIN) + (size_t)2 * DM * DM, M, DM, DM}; SO S; S.init(M, DM, G, (int)blockIdx.x);
              pg8::EpiConvGate<false> E{(const bf16_t*)(ws + WS_P), ap->in[21], nullptr, (bf16_t*)(ws + WS_Z), DM, SEQ, (const float*)(ws + WS_SS) + M};
              pg8::gemm_phase<pg8::EpiConvGate<false>, SO, true, true>(lds, g, S, E); }
            xcd_barrier(bar);
            PH(10) { ARGP(); pg8::Gemm g{(const bf16_t*)(ws + WS_Z), (const bf16_t*)(ws + WS_WCOUT), M, DM, DM}; SO S; S.init(M, DM, G, (int)blockIdx.x);
              pg8::EpiResidF32 E{ap->out, ap->out, DM, H, (float*)(ws + WS_SS) + 2 * M};
              pg8::gemm_phase<pg8::EpiResidF32, SO, true, true>(lds, g, S, E); }
            xcd_barrier(bar);
        }
        constexpr int NA = 20 * 256, NR = 2 * 256;
        PH(12) { ARGP(); pg8::Gemm g{H, WG, M, NA, DM}; SO S; S.init(M, NA, G, (int)blockIdx.x);
          pg8::EpiStoreBf16 E{(bf16_t*)(ws + WS_G), DFF, NA, (const float*)(ws + WS_SS) + (0 ? 2 * M : 0)};
          pg8::gemm_phase<pg8::EpiStoreBf16, SO, true, true>(lds, g, S, E); }
        xcd_barrier(bar);
        PH(12) { ARGP(); const int half = G / 2; const float* ssp = (const float*)(ws + WS_SS) + (0 ? 2 * M : 0);
          if ((int)blockIdx.x < half) {
            pg8::Gemm g{H, WG + (size_t)NA * DM, M, NR, DM}; pg8::SubsetOrder S{(M / 256) * 2, 2, half, (int)blockIdx.x};
            pg8::EpiStoreBf16 E{(bf16_t*)(ws + WS_G) + NA, DFF, NR, ssp};
            pg8::gemm_phase<pg8::EpiStoreBf16, pg8::SubsetOrder, true, true>(lds, g, S, E);
          } else {
            pg8::Gemm g{H, WU, M, NR, DM}; pg8::SubsetOrder S{(M / 256) * 2, 2, G - half, (int)blockIdx.x - half};
            pg8::EpiConvGate<true> E{(const bf16_t*)(ws + WS_G), ap->in[26] + (size_t)0 * 3 * DFF, ap->in[27] + (size_t)0 * DFF, (bf16_t*)(ws + WS_ACT), DFF, SEQ, ssp};
            pg8::gemm_phase<pg8::EpiConvGate<true>, pg8::SubsetOrder, true, true>(lds, g, S, E);
          } }
        xcd_barrier(bar);
        PH(13) { ARGP(); pg8::Gemm g{H, WU + (size_t)NR * DM, M, NA, DM}; SO S; S.init(M, NA, G, (int)blockIdx.x);
          pg8::EpiConvGate<true> E{(const bf16_t*)(ws + WS_G) + NR, ap->in[26] + (size_t)0 * 3 * DFF + NR, ap->in[27] + (size_t)0 * DFF + NR, (bf16_t*)(ws + WS_ACT) + NR, DFF, SEQ, (const float*)(ws + WS_SS) + (0 ? 2 * M : 0)};
          pg8::gemm_phase<pg8::EpiConvGate<true>, SO, true, true>(lds, g, S, E); }
        xcd_barrier(bar);
        PH(14) { ARGP(); pg8::Gemm g{(const bf16_t*)(ws + WS_ACT), WD, M, DM, DFF}; SO S; S.init(M, DM, G, (int)blockIdx.x);
          pg8::EpiResidF32 E{ap->out, ap->out, DM, 0 ? (bf16_t*)nullptr : H, (float*)(ws + WS_SS) + M};
          pg8::gemm_phase<pg8::EpiResidF32, SO, true, true>(lds, g, S, E); }
        if (0 == 0) xcd_barrier(bar);
    }
    {
        if (1 == 1) {
            PH(7) { FRESH_IDS(); ARGP(); LAS float* scr = (LAS float*)(lds + wid * 16384);
            transpose_weight<1>(ap->in[20], DM, 3 * DM, (bf16_t*)(ws + WS_WCIN), scr, gw, NGW, lane, ap->in[19]);
            transpose_weight<0>(ap->in[22], DM, DM, (bf16_t*)(ws + WS_WCOUT), scr, gw, NGW, lane);
            transpose_weight<0>(ap->in[24] + (size_t)DM * DFF, DM, DFF, WG, scr, gw, NGW, lane, ap->in[23] + DM);
            transpose_weight<0>(ap->in[25] + (size_t)DM * DFF, DM, DFF, WU, scr, gw, NGW, lane, ap->in[23] + DM);
            transpose_weight<0>(ap->in[28] + (size_t)DM * DFF, DFF, DM, WD, scr, gw, NGW, lane); }
            xcd_barrier(bar);
            PH(8) { ARGP(); pg8::Gemm g{H, (const bf16_t*)(ws + WS_WCIN), M, 2 * DM, DM}; SO S; S.init(M, 2 * DM, G, (int)blockIdx.x);
              pg8::EpiMulBf16 E{(bf16_t*)(ws + WS_P), DM, (const float*)(ws + WS_SS) + M};
              pg8::gemm_phase<pg8::EpiMulBf16, SO, true, true>(lds, g, S, E); }
            xcd_barrier(bar);
            PH(9) { ARGP(); pg8::Gemm g{H, (const bf16_t*)(ws + WS_WCIN) + (size_t)2 * DM * DM, M, DM, DM}; SO S; S.init(M, DM, G, (int)blockIdx.x);
              pg8::EpiConvGate<false> E{(const bf16_t*)(ws + WS_P), ap->in[21], nullptr, (bf16_t*)(ws + WS_Z), DM, SEQ, (const float*)(ws + WS_SS) + M};
              pg8::gemm_phase<pg8::EpiConvGate<false>, SO, true, true>(lds, g, S, E); }
            xcd_barrier(bar);
            PH(10) { ARGP(); pg8::Gemm g{(const bf16_t*)(ws + WS_Z), (const bf16_t*)(ws + WS_WCOUT), M, DM, DM}; SO S; S.init(M, DM, G, (int)blockIdx.x);
              pg8::EpiResidF32 E{ap->out, ap->out, DM, H, (float*)(ws + WS_SS) + 2 * M};
              pg8::gemm_phase<pg8::EpiResidF32, SO, true, true>(lds, g, S, E); }
            xcd_barrier(bar);
        }
        constexpr int NA = 20 * 256, NR = 2 * 256;
        PH(12) { ARGP(); pg8::Gemm g{H, WG, M, NA, DM}; SO S; S.init(M, NA, G, (int)blockIdx.x);
          pg8::EpiStoreBf16 E{(bf16_t*)(ws + WS_G), DFF, NA, (const float*)(ws + WS_SS) + (1 ? 2 * M : 0)};
          pg8::gemm_phase<pg8::EpiStoreBf16, SO, true, true>(lds, g, S, E); }
        xcd_barrier(bar);
        PH(12) { ARGP(); const int half = G / 2; const float* ssp = (const float*)(ws + WS_SS) + (1 ? 2 * M : 0);
          if ((int)blockIdx.x < half) {
            pg8::Gemm g{H, WG + (size_t)NA * DM, M, NR, DM}; pg8::SubsetOrder S{(M / 256) * 2, 2, half, (int)blockIdx.x};
            pg8::EpiStoreBf16 E{(bf16_t*)(ws + WS_G) + NA, DFF, NR, ssp};
            pg8::gemm_phase<pg8::EpiStoreBf16, pg8::SubsetOrder, true, true>(lds, g, S, E);
          } else {
            pg8::Gemm g{H, WU, M, NR, DM}; pg8::SubsetOrder S{(M / 256) * 2, 2, G - half, (int)blockIdx.x - half};
            pg8::EpiConvGate<true> E{(const bf16_t*)(ws + WS_G), ap->in[26] + (size_t)1 * 3 * DFF, ap->in[27] + (size_t)1 * DFF, (bf16_t*)(ws + WS_ACT), DFF, SEQ, ssp};
            pg8::gemm_phase<pg8::EpiConvGate<true>, pg8::SubsetOrder, true, true>(lds, g, S, E);
          } }
        xcd_barrier(bar);
        PH(13) { ARGP(); pg8::Gemm g{H, WU + (size_t)NR * DM, M, NA, DM}; SO S; S.init(M, NA, G, (int)blockIdx.x);
          pg8::EpiConvGate<true> E{(const bf16_t*)(ws + WS_G) + NR, ap->in[26] + (size_t)1 * 3 * DFF + NR, ap->in[27] + (size_t)1 * DFF + NR, (bf16_t*)(ws + WS_ACT) + NR, DFF, SEQ, (const float*)(ws + WS_SS) + (1 ? 2 * M : 0)};
          pg8::gemm_phase<pg8::EpiConvGate<true>, SO, true, true>(lds, g, S, E); }
        xcd_barrier(bar);
        PH(14) { ARGP(); pg8::Gemm g{(const bf16_t*)(ws + WS_ACT), WD, M, DM, DFF}; SO S; S.init(M, DM, G, (int)blockIdx.x);
          pg8::EpiResidF32 E{ap->out, ap->out, DM, 1 ? (bf16_t*)nullptr : H, (float*)(ws + WS_SS) + M};
          pg8::gemm_phase<pg8::EpiResidF32, SO, true, true>(lds, g, S, E); }
        if (1 == 0) xcd_barrier(bar);
    }
}

extern "C" void kernel_launch(void* const* d_in, const int* in_sizes, int n_in, void* d_out, int out_size, void* d_ws, size_t ws_size, hipStream_t stream) {
    static int grid = 0;
    if (grid == 0) {
        if (n_in != 29 || out_size != M * DM || ws_size < WS_END) { fprintf(stderr, "kernel_launch: unexpected shapes n_in %d out %d ws %zu (need %zu)\n", n_in, out_size, ws_size, (size_t)WS_END); grid = -1; return; }
        int dev = 0, cus = 0, per_cu = 0;
        hipGetDevice(&dev); hipDeviceGetAttribute(&cus, hipDeviceAttributeMultiprocessorCount, dev);
        hipFuncSetAttribute((const void*)fwd_megakernel, hipFuncAttributeMaxDynamicSharedMemorySize, LDS_BYTES);
        hipOccupancyMaxActiveBlocksPerMultiprocessor(&per_cu, (const void*)fwd_megakernel, NTHREADS, LDS_BYTES);
        if (per_cu < 1) { fprintf(stderr, "kernel_launch: occupancy query says %d blocks/CU\n", per_cu); per_cu = 1; }
        (void)hipGetLastError();
        grid = cus * per_cu;
    }
    if (grid < 0) return;
    if (hipMemsetAsync((char*)d_ws + WS_CTL, 0, CTL_ZERO_BYTES, stream) != hipSuccess) { fprintf(stderr, "kernel_launch: memset failed\n"); return; }
    Args a{};
    for (int i = 0; i < 29; ++i) a.in[i] = (const float*)d_in[i];
    a.out = (float*)d_out; a.ws = (unsigned char*)d_ws;
    void* args[] = {&a};
    hipError_t e = hipLaunchCooperativeKernel((const void*)fwd_megakernel, dim3(grid), dim3(NTHREADS), args, LDS_BYTES, stream);
    if (e != hipSuccess) fprintf(stderr, "cooperative launch failed: %s (grid %d)\n", hipGetErrorString(e), grid);
}
```

```cpp
#include <hip/hip_runtime.h>
#include <hip/hip_cooperative_groups.h>
#include <cstdio>
#include <cstdint>
namespace cg = cooperative_groups;
namespace pg8 {
#define PG8_LAS __attribute__((address_space(3)))
typedef unsigned short bf16_t;
typedef short bf16x8 __attribute__((ext_vector_type(8)));
typedef float f32x4 __attribute__((ext_vector_type(4)));
typedef unsigned u32x4 __attribute__((ext_vector_type(4)));
constexpr int BM = 256, BK = 64, HALF = 128, HTB = HALF * BK * 2  , STAGE_BYTES = 8 * HTB, NXCD = 8, WGM = 8;

__host__ __device__ __forceinline__ int lds_byte(int r, int c) { const int st = (r >> 4) * 2 + (c >> 5), rr = r & 15, cc = c & 31, ob = rr * 64 + cc * 2; return st * 1024 + (ob ^ (((ob >> 9) & 1) << 5)); }
__host__ __device__ __forceinline__ void stage_rc(int b, int& R, int& C) { const int st = b / 1024, sb = b % 1024, swz = sb ^ (((sb >> 9) & 1) << 5); R = (st >> 1) * 16 + swz / 64; C = (st & 1) * 32 + (swz % 64) / 2; }
__host__ __device__ __forceinline__ int perm32(int rho) { const int n = rho >> 4, i = rho & 15; return 8 * (i >> 2) + 4 * n + (i & 3); }

struct Unit { int pm, pn; };
struct Gemm { const bf16_t* A; const bf16_t* Bt; int M, N, K; };

struct StaticOrder {
    int nM, nN, nwg, G, c;
    __host__ __device__ void init(int M, int N, int G_, int c_) { nM = M / BM; nN = N / BM; nwg = nM * nN; G = G_; c = c_; }
    __host__ __device__ bool next(int i, Unit& u) const {
        const long L = (long)i * G + c; if (L >= nwg) return false;
        int wgid = (int)L; { const int q = nwg / NXCD, r = nwg % NXCD, xcd = wgid % NXCD, off = wgid / NXCD; wgid = (xcd < r ? xcd * (q + 1) : r * (q + 1) + (xcd - r) * q) + off; }
        const int nig = WGM * nN, gid = wgid / nig, fm = gid * WGM, gsz = (nM - fm) < WGM ? (nM - fm) : WGM;
        u.pm = fm + ((wgid % nig) % gsz); u.pn = (wgid % nig) / gsz; return true;
    }
    __device__ __forceinline__ void a_ready(const Unit&) const {}
    __device__ __forceinline__ void done(const Unit&) const {}
};


typedef __bf16 bf16x2_t __attribute__((ext_vector_type(2)));
typedef float f32x2_t __attribute__((ext_vector_type(2)));
__device__ __forceinline__ unsigned cvt_pk_bf16(float lo, float hi) { f32x2_t f = {lo, hi}; bf16x2_t r = __builtin_convertvector(f, bf16x2_t); return __builtin_bit_cast(unsigned, r); }
__device__ __forceinline__ float bf_lo(unsigned w) { return __uint_as_float(w << 16); }
__device__ __forceinline__ float bf_hi(unsigned w) { return __uint_as_float(w & 0xffff0000u); }

struct SubsetOrder {
    int n, nN, R, r;
    __device__ __forceinline__ bool next(int i, Unit& u) const { const int k = r + i * R; if (k >= n) return false; u.pm = k / nN; u.pn = k % nN; return true; }
    __device__ __forceinline__ void a_ready(const Unit&) const {}
    __device__ __forceinline__ void done(const Unit&) const {}
};
__device__ __forceinline__ float row_rstd(const float* ss, int row) { return ss ? 1.0f / sqrtf(ss[row] * (1.0f / 2048.0f) + 1e-6f) : 1.0f; }
struct EpiStoreBf16 {
    static constexpr bool PERM = true, AFTER_DRAIN = false;
    bf16_t* O; int ldc; int ncols; const float* ss;
    __device__ __forceinline__ void operator()(f32x4 (&acc)[2][2][4][2], const Unit& u, int wr, int wc, int fr, int fq) const {
        const int row0 = u.pm * BM + wr * 64 + fr; const int col0 = u.pn * BM + wc * 32 + 8 * fq;
        float rs[2][4];
#pragma unroll
        for (int ai = 0; ai < 2; ++ai)
#pragma unroll
            for (int m = 0; m < 4; ++m) rs[ai][m] = row_rstd(ss, row0 + ai * HALF + m * 16);
#pragma unroll
        for (int ai = 0; ai < 2; ++ai)
#pragma unroll
            for (int m = 0; m < 4; ++m) { const int row = row0 + ai * HALF + m * 16; bf16_t* rowp = O + (size_t)row * ldc + col0;
#pragma unroll
                for (int bj = 0; bj < 2; ++bj) { const f32x4 v0 = acc[ai][bj][m][0] * rs[ai][m], v1 = acc[ai][bj][m][1] * rs[ai][m];
                    u32x4 w; w.x = cvt_pk_bf16(v0[0], v0[1]); w.y = cvt_pk_bf16(v0[2], v0[3]); w.z = cvt_pk_bf16(v1[0], v1[1]); w.w = cvt_pk_bf16(v1[2], v1[3]);
                    if (col0 + bj * HALF < ncols) *(u32x4*)(rowp + bj * HALF) = w; } }
    }
};
typedef unsigned u32x2e __attribute__((ext_vector_type(2)));
struct EpiResidF32 {
    static constexpr bool PERM = false, AFTER_DRAIN = false;
    const float* base; float* out; int ldc; bf16_t* xb; float* ss;
    __device__ __forceinline__ void operator()(f32x4 (&acc)[2][2][4][2], const Unit& u, int wr, int wc, int fr, int fq) const {
        const int row0 = u.pm * BM + wr * 64 + fr; const int col0 = u.pn * BM + wc * 32 + 4 * fq;
#pragma unroll
        for (int ai = 0; ai < 2; ++ai)
#pragma unroll
            for (int m = 0; m < 4; ++m) { const size_t off = (size_t)(row0 + ai * HALF + m * 16) * ldc + col0;
#pragma unroll
                for (int bj = 0; bj < 2; ++bj)
#pragma unroll
                    for (int n = 0; n < 2; ++n) acc[ai][bj][m][n] += *(const f32x4*)(base + off + bj * HALF + n * 16);
                if (m == 3) asm volatile("" : "+v"(acc[ai][0][0][0]), "+v"(acc[ai][0][0][1]), "+v"(acc[ai][1][0][0]), "+v"(acc[ai][1][0][1]), "+v"(acc[ai][0][1][0]), "+v"(acc[ai][0][1][1]), "+v"(acc[ai][1][1][0]), "+v"(acc[ai][1][1][1]),
                                             "+v"(acc[ai][0][2][0]), "+v"(acc[ai][0][2][1]), "+v"(acc[ai][1][2][0]), "+v"(acc[ai][1][2][1]), "+v"(acc[ai][0][3][0]), "+v"(acc[ai][0][3][1]), "+v"(acc[ai][1][3][0]), "+v"(acc[ai][1][3][1]) :: "memory"); }
        asm volatile("" ::: "memory");
#pragma unroll
        for (int ai = 0; ai < 2; ++ai)
#pragma unroll
            for (int m = 0; m < 4; ++m) { const int row = row0 + ai * HALF + m * 16; const size_t off = (size_t)row * ldc + col0; float sq = 0.f;
#pragma unroll
                for (int bj = 0; bj < 2; ++bj)
#pragma unroll
                    for (int n = 0; n < 2; ++n) { const f32x4 v = acc[ai][bj][m][n]; *(f32x4*)(out + off + bj * HALF + n * 16) = v;
                        if (xb) { u32x2e w; w.x = cvt_pk_bf16(v[0], v[1]); w.y = cvt_pk_bf16(v[2], v[3]); *(u32x2e*)(xb + off + bj * HALF + n * 16) = w; sq += (v[0] * v[0] + v[1] * v[1]) + (v[2] * v[2] + v[3] * v[3]); } }
                if (xb) { sq += __shfl_xor(sq, 16); sq += __shfl_xor(sq, 32); if (fq == 0) atomicAdd(ss + row, sq); } }
    }
};
struct EpiMulBf16 {
    static constexpr bool PERM = true, AFTER_DRAIN = false;
    bf16_t* O; int ldc; const float* ss;
    __device__ __forceinline__ void operator()(f32x4 (&acc)[2][2][4][2], const Unit& u, int wr, int wc, int fr, int fq) const {
        const int row0 = u.pm * BM + wr * 64 + fr; const int col0 = u.pn * HALF + wc * 32 + 8 * fq;
        float rs[2][4];
#pragma unroll
        for (int ai = 0; ai < 2; ++ai)
#pragma unroll
            for (int m = 0; m < 4; ++m) rs[ai][m] = row_rstd(ss, row0 + ai * HALF + m * 16);
#pragma unroll
        for (int ai = 0; ai < 2; ++ai)
#pragma unroll
            for (int m = 0; m < 4; ++m) { const int row = row0 + ai * HALF + m * 16; bf16_t* rowp = O + (size_t)row * ldc + col0; const float rs2 = rs[ai][m] * rs[ai][m];
                const f32x4 v0 = acc[ai][0][m][0] * acc[ai][1][m][0] * rs2, v1 = acc[ai][0][m][1] * acc[ai][1][m][1] * rs2;
                u32x4 w; w.x = cvt_pk_bf16(v0[0], v0[1]); w.y = cvt_pk_bf16(v0[2], v0[3]); w.z = cvt_pk_bf16(v1[0], v1[1]); w.w = cvt_pk_bf16(v1[2], v1[3]);
                *(u32x4*)rowp = w; }
    }
};
#define PG8_DPP(old_, src_, ctrl_) ((unsigned)__builtin_amdgcn_update_dpp((int)(old_), (int)(src_), (ctrl_), 0xf, 0xf, false))
template <bool SILU> struct EpiConvGate {
    static constexpr bool PERM = true, AFTER_DRAIN = false;
    const bf16_t* G; const float* cw; const float* bias; bf16_t* O; int ldc; int seq; const float* ss;
    __device__ __forceinline__ void operator()(f32x4 (&acc)[2][2][4][2], const Unit& u, int wr, int wc, int fr, int fq) const {
        const int row0 = u.pm * BM + wr * 64 + fr;
        float rs[2][4];
#pragma unroll
        for (int ai = 0; ai < 2; ++ai)
#pragma unroll
            for (int m = 0; m < 4; ++m) rs[ai][m] = row_rstd(ss, row0 + ai * HALF + m * 16);
        u32x4 own[1][4], halo[1];
        const u32x4 z4 = {0u, 0u, 0u, 0u};
#define PG8_ISSUE(g_, buf_) do { const int bj_ = (g_) >> 1, ai_ = (g_) & 1; const int col0_ = u.pn * BM + bj_ * HALF + wc * 32 + 8 * fq; \
            const int rowb_ = row0 + ai_ * HALF; const bf16_t* gp_ = G + (size_t)rowb_ * ldc + col0_; \
            _Pragma("unroll") for (int m_ = 0; m_ < 4; ++m_) own[buf_][m_] = *(const u32x4*)(gp_ + (size_t)(16 * m_) * ldc); \
            const int blk_ = rowb_ - fr; u32x4 hv_ = z4; \
            if (fr == 0) { if ((blk_ & (seq - 1)) != 0) hv_ = *(const u32x4*)(gp_ - ldc); } \
            else if (fr == 15) { if (((blk_ + 64) & (seq - 1)) != 0) hv_ = *(const u32x4*)(gp_ + (size_t)49 * ldc); } \
            halo[buf_] = hv_; } while (0)
#pragma unroll
        for (int g = 0; g < 4; ++g) {
            const int bj = g >> 1, ai = g & 1, buf = 0; const int col0 = u.pn * BM + bj * HALF + wc * 32 + 8 * fq;
            PG8_ISSUE(g, 0);
            float w0[8], w1[8], w2[8], bb[8];
#pragma unroll
            for (int q = 0; q < 2; ++q) { const f32x4 a = *(const f32x4*)(cw + col0 + 4 * q), b = *(const f32x4*)(cw + ldc + col0 + 4 * q), c = *(const f32x4*)(cw + 2 * ldc + col0 + 4 * q);
                const f32x4 d = bias ? *(const f32x4*)(bias + col0 + 4 * q) : (f32x4){0.f, 0.f, 0.f, 0.f};
#pragma unroll
                for (int j = 0; j < 4; ++j) { w0[4 * q + j] = a[j]; w1[4 * q + j] = b[j]; w2[4 * q + j] = c[j]; bb[4 * q + j] = d[j]; } }
#pragma unroll
            for (int m = 0; m < 4; ++m) {
                u32x4 gm, gn; const u32x4 g0 = own[buf][m];
#pragma unroll
                for (int q = 0; q < 4; ++q) {
                    const unsigned oldp = m > 0 ? PG8_DPP(0u, own[buf][m > 0 ? m - 1 : 0][q], 0x121) : halo[buf][q];
                    const unsigned oldn = m < 3 ? PG8_DPP(0u, own[buf][m < 3 ? m + 1 : 3][q], 0x12F) : halo[buf][q];
                    gm[q] = PG8_DPP(oldp, g0[q], 0x111);
                    gn[q] = PG8_DPP(oldn, g0[q], 0x101);
                }
                float r[8];
#pragma unroll
                for (int q = 0; q < 4; ++q) {
                    const float c0 = w0[2 * q] * bf_lo(gm[q]) + w1[2 * q] * bf_lo(g0[q]) + w2[2 * q] * bf_lo(gn[q]) + bb[2 * q];
                    const float c1 = w0[2 * q + 1] * bf_hi(gm[q]) + w1[2 * q + 1] * bf_hi(g0[q]) + w2[2 * q + 1] * bf_hi(gn[q]) + bb[2 * q + 1];
                    float f0 = c0, f1 = c1;
                    if (SILU) { f0 = c0 * __builtin_amdgcn_rcpf(1.0f + __builtin_amdgcn_exp2f(-1.44269504089f * c0)); f1 = c1 * __builtin_amdgcn_rcpf(1.0f + __builtin_amdgcn_exp2f(-1.44269504089f * c1)); }
                    r[2 * q] = f0 * rs[ai][m]; r[2 * q + 1] = f1 * rs[ai][m]; }
                const f32x4 v0 = acc[ai][bj][m][0], v1 = acc[ai][bj][m][1];
                f32x4 pk; pk[0] = __uint_as_float(cvt_pk_bf16(v0[0] * r[0], v0[1] * r[1])); pk[1] = __uint_as_float(cvt_pk_bf16(v0[2] * r[2], v0[3] * r[3]));
                pk[2] = __uint_as_float(cvt_pk_bf16(v1[0] * r[4], v1[1] * r[5])); pk[3] = __uint_as_float(cvt_pk_bf16(v1[2] * r[6], v1[3] * r[7]));
                acc[ai][bj][m][0] = pk;
            }
            asm volatile("" : "+v"(acc[ai][bj][0][0]), "+v"(acc[ai][bj][1][0]), "+v"(acc[ai][bj][2][0]), "+v"(acc[ai][bj][3][0]) :: "memory");
        }
#pragma unroll
        for (int bj = 0; bj < 2; ++bj) {
            const int col0 = u.pn * BM + bj * HALF + wc * 32 + 8 * fq;
#pragma unroll
            for (int ai = 0; ai < 2; ++ai)
#pragma unroll
                for (int m = 0; m < 4; ++m) { const int row = row0 + ai * HALF + m * 16; *(f32x4*)(O + (size_t)row * ldc + col0) = acc[ai][bj][m][0]; }
        }
    }
};

template <class Epi, class Sched, bool ALIGN_EPI = false, bool SP2 = false>
__device__ __forceinline__ void gemm_phase(PG8_LAS unsigned char* lds, const Gemm g, const Sched& S, const Epi& E) {
    int tid_ = threadIdx.x; asm volatile("" : "+v"(tid_));
    const int tid = tid_, wid = __builtin_amdgcn_readfirstlane(tid >> 6), lane = tid & 63, wr = wid >> 2, wc = wid & 3, fr = lane & 15, fq = lane >> 4;
    const int K = g.K, nt = K / BK;
    unsigned voffA[2], voffB[2];
#pragma unroll
    for (int i = 0; i < 2; ++i) { int R, C; stage_rc(tid * 16 + i * 8192, R, C); const int Rb = Epi::PERM ? ((R & ~31) + perm32(R & 31)) : R;
        voffA[i] = (unsigned)(R * K + C) * 2u; voffB[i] = (unsigned)(Rb * K + C) * 2u; }
    const size_t kstep = (size_t)(BK * 2);
    const size_t hstep = (size_t)HALF * K * 2;
    const size_t tstep = 2 * hstep;
    const unsigned ldsw = (unsigned)wid * 1024u;
    const int aoff = lds_byte(wr * 64 + fr, fq * 8), boff = lds_byte(wc * 32 + fr, fq * 8);
#define PG8_SA(b, h) (((b) * 2 + (h)) * HTB)
#define PG8_SB(b, h) ((4 + (b) * 2 + (h)) * HTB)
#define PG8_STAGE(bufoff, gbase, voff) do { _Pragma("unroll") for (int _i = 0; _i < 2; ++_i) \
        __builtin_amdgcn_global_load_lds((const unsigned*)((const char*)(gbase) + (voff)[_i]), (PG8_LAS unsigned*)(lds + (bufoff) + ldsw + _i * 8192), 16, 0, 0); } while (0)
#define PG8_LDA(dst, b, h) do { _Pragma("unroll") for (int m = 0; m < 4; ++m) _Pragma("unroll") for (int k = 0; k < 2; ++k) dst[m][k] = *(const PG8_LAS bf16x8*)(lds + PG8_SA(b, h) + aoff + m * 2048 + k * 1024); } while (0)
#define PG8_LDB(dst, b, h) do { _Pragma("unroll") for (int n = 0; n < 2; ++n) _Pragma("unroll") for (int k = 0; k < 2; ++k) dst[n][k] = *(const PG8_LAS bf16x8*)(lds + PG8_SB(b, h) + boff + n * 2048 + k * 1024); } while (0)
#define PG8_MMA(ai, bj, At, Bt) do { __builtin_amdgcn_s_setprio(1); _Pragma("unroll") for (int m = 0; m < 4; ++m) _Pragma("unroll") for (int n = 0; n < 2; ++n) _Pragma("unroll") for (int k = 0; k < 2; ++k) \
        acc[ai][bj][m][n] = __builtin_amdgcn_mfma_f32_16x16x32_bf16(Bt[n][k], At[m][k], acc[ai][bj][m][n], 0, 0, 0); __builtin_amdgcn_s_setprio(0); } while (0)
#define PG8_WAIT_V(n) asm volatile("s_waitcnt vmcnt(" #n ")" ::: "memory")
#define PG8_WAIT_L(n) asm volatile("s_waitcnt lgkmcnt(" #n ")" ::: "memory")
#define PG8_BAR __builtin_amdgcn_s_barrier()
#define PG8_SCHED __builtin_amdgcn_sched_barrier(0)
    Unit cur, nxt; int ui = 0;
    if (!S.next(0, cur)) return;
    f32x4 acc[2][2][4][2];
#pragma unroll
    for (int a = 0; a < 2; ++a)
#pragma unroll
        for (int b = 0; b < 2; ++b)
#pragma unroll
            for (int m = 0; m < 4; ++m)
#pragma unroll
                for (int n = 0; n < 2; ++n) acc[a][b][m][n] = (f32x4){0.f, 0.f, 0.f, 0.f};
    bf16x8 At[4][2], B0[2][2], B1[2][2];
    const char* cA = (const char*)g.A + (size_t)cur.pm * tstep; const char* cB = (const char*)g.Bt + (size_t)cur.pn * tstep;
    S.a_ready(cur);
    if constexpr (SP2) {
        PG8_STAGE(PG8_SB(0, 0), cB, voffB); PG8_STAGE(PG8_SB(0, 1), cB + hstep, voffB); PG8_STAGE(PG8_SA(0, 0), cA, voffA); PG8_STAGE(PG8_SA(0, 1), cA + hstep, voffA);
        if (wr == 1) PG8_BAR;
        PG8_WAIT_V(2); PG8_BAR;
        PG8_STAGE(PG8_SB(1, 0), cB + kstep, voffB); PG8_STAGE(PG8_SA(1, 0), cA + kstep, voffA); PG8_STAGE(PG8_SB(1, 1), cB + hstep + kstep, voffB);
        PG8_WAIT_V(6); PG8_BAR;
    } else {
        PG8_STAGE(PG8_SB(0, 0), cB, voffB); PG8_STAGE(PG8_SA(0, 0), cA, voffA); PG8_STAGE(PG8_SB(0, 1), cB + hstep, voffB); PG8_STAGE(PG8_SA(0, 1), cA + hstep, voffA);
        if (wr == 1) PG8_BAR;
        PG8_WAIT_V(4); PG8_BAR;
        PG8_STAGE(PG8_SB(1, 0), cB + kstep, voffB); PG8_STAGE(PG8_SA(1, 0), cA + kstep, voffA); PG8_STAGE(PG8_SB(1, 1), cB + hstep + kstep, voffB);
        PG8_WAIT_V(6); PG8_BAR;
    }
    for (;;) {
        const bool has_next = S.next(ui + 1, nxt);
        const char* nA = has_next ? (const char*)g.A + (size_t)nxt.pm * tstep : cA; const char* nB = has_next ? (const char*)g.Bt + (size_t)nxt.pn * tstep : cB;
        for (int t = 0; t < nt; t += 2) {
            const bool last = (t == nt - 2);
            const char* a1 = cA + (size_t)(t + 1) * kstep;
            const char* a2 = last ? nA : cA + (size_t)(t + 2) * kstep; const char* b2 = last ? nB : cB + (size_t)(t + 2) * kstep;
            const char* a3 = a2 + kstep; const char* b3 = b2 + kstep;
            if (last && has_next) S.a_ready(nxt);
            if constexpr (SP2) {
            PG8_LDB(B0, 0, 0); PG8_LDB(B1, 0, 1); PG8_SCHED; PG8_LDA(At, 0, 0); PG8_STAGE(PG8_SA(1, 1), a1 + hstep, voffA);
            PG8_WAIT_V(8); PG8_WAIT_L(0); PG8_BAR; PG8_MMA(0, 0, At, B0); PG8_MMA(0, 1, At, B1); PG8_BAR; PG8_SCHED;
            PG8_LDA(At, 0, 1); PG8_STAGE(PG8_SB(0, 0), b2, voffB); PG8_STAGE(PG8_SB(0, 1), b2 + hstep, voffB); PG8_STAGE(PG8_SA(0, 0), a2, voffA);
            PG8_WAIT_V(8); PG8_WAIT_L(0); PG8_BAR; PG8_MMA(1, 0, At, B0); PG8_MMA(1, 1, At, B1); PG8_BAR; PG8_SCHED;
            PG8_LDB(B0, 1, 0); PG8_LDB(B1, 1, 1); PG8_SCHED; PG8_LDA(At, 1, 0); PG8_STAGE(PG8_SA(0, 1), a2 + hstep, voffA);
            PG8_WAIT_V(8); PG8_WAIT_L(0); PG8_BAR; PG8_MMA(0, 0, At, B0); PG8_MMA(0, 1, At, B1); PG8_BAR; PG8_SCHED;
            PG8_LDA(At, 1, 1); PG8_STAGE(PG8_SB(1, 0), b3, voffB); PG8_STAGE(PG8_SB(1, 1), b3 + hstep, voffB); PG8_STAGE(PG8_SA(1, 0), a3, voffA);
            PG8_WAIT_V(8); PG8_WAIT_L(0); PG8_BAR; PG8_MMA(1, 0, At, B0); PG8_MMA(1, 1, At, B1); PG8_BAR; PG8_SCHED;
            } else {
            PG8_LDB(B0, 0, 0); PG8_SCHED; PG8_LDA(At, 0, 0); PG8_STAGE(PG8_SA(1, 1), a1 + hstep, voffA);
            PG8_WAIT_L(8); PG8_BAR; PG8_WAIT_L(0); PG8_MMA(0, 0, At, B0); PG8_BAR; PG8_SCHED;
            PG8_LDB(B1, 0, 1); PG8_STAGE(PG8_SB(0, 0), b2, voffB);
            PG8_BAR; PG8_WAIT_L(0); PG8_MMA(0, 1, At, B1); PG8_BAR;
            PG8_LDA(At, 0, 1); PG8_STAGE(PG8_SA(0, 0), a2, voffA);
            PG8_BAR; PG8_WAIT_L(0); PG8_MMA(1, 0, At, B0); PG8_BAR; PG8_SCHED;
            PG8_STAGE(PG8_SB(0, 1), b2 + hstep, voffB);
            PG8_WAIT_V(6); PG8_BAR; PG8_MMA(1, 1, At, B1); PG8_BAR;
            PG8_LDB(B0, 1, 0); PG8_SCHED; PG8_LDA(At, 1, 0); PG8_STAGE(PG8_SA(0, 1), a2 + hstep, voffA);
            PG8_WAIT_L(8); PG8_BAR; PG8_WAIT_L(0); PG8_MMA(0, 0, At, B0); PG8_BAR; PG8_SCHED;
            PG8_LDB(B1, 1, 1); PG8_STAGE(PG8_SB(1, 0), b3, voffB);
            PG8_BAR; PG8_WAIT_L(0); PG8_MMA(0, 1, At, B1); PG8_BAR;
            PG8_LDA(At, 1, 1); PG8_STAGE(PG8_SA(1, 0), a3, voffA);
            PG8_BAR; PG8_WAIT_L(0); PG8_MMA(1, 0, At, B0); PG8_BAR; PG8_SCHED;
            PG8_STAGE(PG8_SB(1, 1), b3 + hstep, voffB);
            PG8_WAIT_V(6); PG8_BAR; PG8_MMA(1, 1, At, B1); PG8_BAR;
            }
        }
        if constexpr (ALIGN_EPI) { if (wr == 0) PG8_BAR; }
        if constexpr (!Epi::AFTER_DRAIN) { E(acc, cur, wr, wc, fr, fq); S.done(cur); }
        if (!has_next) break;
#pragma unroll
        for (int a = 0; a < 2; ++a)
#pragma unroll
            for (int b = 0; b < 2; ++b)
#pragma unroll
                for (int m = 0; m < 4; ++m)
#pragma unroll
                    for (int n = 0; n < 2; ++n) acc[a][b][m][n] = (f32x4){0.f, 0.f, 0.f, 0.f};
        cur = nxt; cA = nA; cB = nB; ++ui;
        if constexpr (ALIGN_EPI) { if (wr == 1) PG8_BAR; }
    }
    PG8_WAIT_V(0);
    if constexpr (!ALIGN_EPI) { if (wr == 0) PG8_BAR; }
    PG8_BAR;
    if constexpr (Epi::AFTER_DRAIN) { E.fused(acc, cur, wr, wc, fr, fq, lds, wid, lane); S.done(cur); }
#undef PG8_SA
#undef PG8_SB
#undef PG8_STAGE
#undef PG8_LDA
#undef PG8_LDB
#undef PG8_MMA
#undef PG8_WAIT_V
#undef PG8_WAIT_L
#undef PG8_BAR
#undef PG8_SCHED
}
}

#define GAS __attribute__((address_space(1)))
#define LAS __attribute__((address_space(3)))
typedef unsigned short bf16_t;
typedef unsigned u32x4 __attribute__((ext_vector_type(4)));
typedef unsigned u32x2 __attribute__((ext_vector_type(2)));
typedef int i32x4 __attribute__((ext_vector_type(4)));
typedef float f32x4 __attribute__((ext_vector_type(4)));
typedef float f32x16 __attribute__((ext_vector_type(16)));
typedef short bf16x8 __attribute__((ext_vector_type(8)));
using pg8::cvt_pk_bf16; using pg8::bf_lo; using pg8::bf_hi;

constexpr int NWAVES = 8, NTHREADS = 512;
constexpr int BATCH = 8, SEQ = 2048, DM = 2048, M = BATCH * SEQ, DFF = 5632;
constexpr int NIN = 3904, NIN_PAD = 4096;
constexpr float EPS = 1e-6f, LOG2E = 1.44269504088896f;
constexpr float QSCALE_A = 0.125f * LOG2E;
constexpr float QSCALE_B = 0.07216878364870322f * LOG2E;
constexpr float LAM_INIT = 0.2f;

constexpr size_t MiB = 1u << 20;
constexpr size_t WS_WGATE = 1 * MiB, WS_WUP = 23 * MiB, WS_WDOWN = 45 * MiB;
constexpr size_t WS_H = 67 * MiB;
constexpr size_t WS_BIG = 131 * MiB;
constexpr size_t WS_WIN = WS_BIG + 0, WS_WUQ = WS_BIG + 16 * MiB, WS_WUKV = WS_BIG + 18 * MiB, WS_WOUT = WS_BIG + 19 * MiB;
constexpr size_t WS_PROJ = WS_BIG + 27 * MiB;
constexpr size_t WS_QLAT = WS_BIG + 27 * MiB, WS_KVRAW = WS_BIG + 75 * MiB;
constexpr size_t WS_AO = WS_BIG + 27 * MiB;
constexpr size_t WS_DQ = WS_BIG + 149 * MiB, WS_DK = WS_BIG + 181 * MiB, WS_DVT = WS_BIG + 213 * MiB;
constexpr size_t WS_CQN = WS_BIG + 245 * MiB, WS_CKVN = WS_BIG + 261 * MiB, WS_KR = WS_BIG + 269 * MiB;
constexpr size_t DO_MQ = 0, DO_MK = 48 * MiB, DO_MVT = 96 * MiB;
constexpr size_t WS_G = WS_BIG, WS_ACT = WS_BIG + 176 * MiB;
constexpr size_t WS_WCIN = WS_BIG, WS_WCOUT = WS_BIG + 24 * MiB, WS_P = WS_BIG + 32 * MiB, WS_Z = WS_BIG + 96 * MiB;
constexpr size_t WS_END = WS_BIG + 352 * MiB;

constexpr int RING_BYTES = 131072;
constexpr int LDS_BYTES = 147456;

struct Args {
    const float* in[29]; float* out; unsigned char* ws;
};
#define CAS __attribute__((address_space(4)))
typedef const CAS Args* ArgP;

__device__ __forceinline__ float wave_sum(float v) {
#pragma unroll
    for (int o = 1; o < 64; o <<= 1) v += __shfl_xor(v, o);
    return v;
}
#define LDS_WAIT() asm volatile("s_waitcnt lgkmcnt(0)" ::: "memory")

#define TW_LOAD(it_, dst_, g0_, g1_) do { const int kb_ = (it_) / nblk, nb_ = (it_) % nblk, k0_ = 64 * kb_, n0_ = 32 * nb_; \
        _Pragma("unroll") for (int i_ = 0; i_ < 32; ++i_) { const int kk_ = 2 * i_ + (lane >> 5); dst_[i_] = W[(size_t)(k0_ + kk_) * N + n0_ + (lane & 31)]; } \
        if (gk) { g0_ = *(const f32x4*)(gk + k0_ + 8 * c); g1_ = *(const f32x4*)(gk + k0_ + 8 * c + 4); } } while (0)
template <int MODE>
__device__ __forceinline__ void transpose_weight(const float* W, int K, int N, bf16_t* WT, LAS float* scr, int gw, int NGW, int lane, const float* gk = nullptr) {
    const int nblk = N / 32, nitems = (K / 64) * nblk;
    const int c = lane & 7;
    float cur[32], nxt[32];
    f32x4 gc0 = {1.f, 1.f, 1.f, 1.f}, gc1 = gc0, gn0 = gc0, gn1 = gc0;
    int it = gw;
    if (it < nitems) TW_LOAD(it, cur, gc0, gc1);
    while (it < nitems) {
        const int itn = it + NGW;
        if (itn < nitems) TW_LOAD(itn, nxt, gn0, gn1);
        const int kb = it / nblk, nb = it % nblk, k0 = 64 * kb, n0 = 32 * nb;
        int drow = n0;
        if (MODE == 1) { if (n0 < 2048) drow = 4096 + n0; else if (n0 < 4096) { const int cc = n0 - 2048; drow = (cc >> 7) * 256 + (cc & 127); } else { const int cc = n0 - 4096; drow = (cc >> 7) * 256 + 128 + (cc & 127); } }
#pragma unroll
        for (int i = 0; i < 32; ++i) { const int kk = 2 * i + (lane >> 5); scr[kk * 33 + (lane & 31)] = cur[i]; }
        LDS_WAIT(); asm volatile("" ::: "memory");
#pragma unroll
        for (int j = 0; j < 4; ++j) { const int n = (lane >> 3) + 8 * j; const LAS float* sp = scr + (8 * c) * 33 + n;
            u32x4 o; o.x = cvt_pk_bf16(sp[0 * 33] * gc0[0], sp[1 * 33] * gc0[1]); o.y = cvt_pk_bf16(sp[2 * 33] * gc0[2], sp[3 * 33] * gc0[3]);
            o.z = cvt_pk_bf16(sp[4 * 33] * gc1[0], sp[5 * 33] * gc1[1]); o.w = cvt_pk_bf16(sp[6 * 33] * gc1[2], sp[7 * 33] * gc1[3]);
            *(u32x4*)(WT + (size_t)(drow + n) * K + k0 + 8 * c) = o; }
        LDS_WAIT(); asm volatile("" ::: "memory");
#pragma unroll
        for (int i = 0; i < 32; ++i) cur[i] = nxt[i];
        gc0 = gn0; gc1 = gn1; it = itn;
    }
}
__device__ __forceinline__ void rms_row_to_bf16(const float* xrow, const float* g, bf16_t* orow, int lane) {
    const f32x4* xr = (const f32x4*)xrow + lane; const f32x4* gr = (const f32x4*)g + lane;
    f32x4 v[8]; float s = 0.f;
#pragma unroll
    for (int j = 0; j < 8; ++j) { v[j] = xr[64 * j]; s += (v[j].x * v[j].x + v[j].y * v[j].y) + (v[j].z * v[j].z + v[j].w * v[j].w); }
    const float rstd = 1.0f / sqrtf(wave_sum(s) * (1.0f / DM) + EPS);
    u32x2* o8 = (u32x2*)orow + lane;
#pragma unroll
    for (int j = 0; j < 8; ++j) { const f32x4 gg = gr[64 * j]; u32x2 w; w.x = cvt_pk_bf16(v[j].x * rstd * gg.x, v[j].y * rstd * gg.y); w.y = cvt_pk_bf16(v[j].z * rstd * gg.z, v[j].w * rstd * gg.w); o8[64 * j] = w; }
}
__device__ __forceinline__ void rms_phase(const float* X, const float* g, bf16_t* H, int gw, int NGW, int lane) {
    for (int m = gw; m < M; m += 2 * NGW) {
        const int m2 = m + NGW; const bool two = m2 < M;
        const f32x4* xa = (const f32x4*)(X + (size_t)m * DM) + lane; const f32x4* xb = (const f32x4*)(X + (size_t)(two ? m2 : m) * DM) + lane; const f32x4* gr = (const f32x4*)g + lane;
        f32x4 va[8], vb[8]; float sa = 0.f, sb = 0.f;
#pragma unroll
        for (int j = 0; j < 8; ++j) { va[j] = xa[64 * j]; vb[j] = xb[64 * j]; }
#pragma unroll
        for (int j = 0; j < 8; ++j) { sa += (va[j].x * va[j].x + va[j].y * va[j].y) + (va[j].z * va[j].z + va[j].w * va[j].w); sb += (vb[j].x * vb[j].x + vb[j].y * vb[j].y) + (vb[j].z * vb[j].z + vb[j].w * vb[j].w); }
        const float ra = 1.0f / sqrtf(wave_sum(sa) * (1.0f / DM) + EPS), rb = 1.0f / sqrtf(wave_sum(sb) * (1.0f / DM) + EPS);
        u32x2* oa = (u32x2*)(H + (size_t)m * DM) + lane; u32x2* ob = (u32x2*)(H + (size_t)m2 * DM) + lane;
#pragma unroll
        for (int j = 0; j < 8; ++j) { const f32x4 gg = gr[64 * j]; u32x2 w; w.x = cvt_pk_bf16(va[j].x * ra * gg.x, va[j].y * ra * gg.y); w.y = cvt_pk_bf16(va[j].z * ra * gg.z, va[j].w * ra * gg.w); oa[64 * j] = w;
            if (two) { u32x2 w2; w2.x = cvt_pk_bf16(vb[j].x * rb * gg.x, vb[j].y * rb * gg.y); w2.y = cvt_pk_bf16(vb[j].z * rb * gg.z, vb[j].w * rb * gg.w); ob[64 * j] = w2; } }
    }
}

__device__ __forceinline__ int perm16(int w) { return (w & 3) | (((w >> 3) & 1) << 2) | (((w >> 2) & 1) << 3); }

__device__ __forceinline__ void vt_tile8(const bf16_t* src, int ld, int hstride, bf16_t* vt, int t0, LAS unsigned char* lds, int tid) {
    LAS bf16_t* T = (LAS bf16_t*)lds;
    u32x4 v[2][8];
#pragma unroll
    for (int hb = 0; hb < 2; ++hb)
#pragma unroll
        for (int i = 0; i < 8; ++i) { const int c = tid + i * NTHREADS, r = c >> 6, hc = c & 63, hq = hc >> 4, cc = hc & 15; v[hb][i] = *(const u32x4*)(src + (size_t)r * ld + (hb * 4 + hq) * hstride + cc * 8); }
#pragma unroll
    for (int hb = 0; hb < 2; ++hb) {
#pragma unroll
        for (int i = 0; i < 8; ++i) { const int c = tid + i * NTHREADS, r = c >> 6, hc = c & 63; *(LAS u32x4*)(T + r * 520 + hc * 8) = v[hb][i]; }
        __syncthreads();
#pragma unroll
        for (int i = 0; i < 8; ++i) { const int c = tid + i * NTHREADS, hq = c >> 10, dv = (c >> 3) & 127, q8 = c & 7, blk = q8 >> 1, hh = q8 & 1;
            unsigned e[8];
#pragma unroll
            for (int j = 0; j < 8; ++j) { const int key = blk * 16 + 8 * (j >> 2) + 4 * hh + (j & 3); e[j] = T[key * 520 + hq * 128 + dv]; }
            u32x4 o; o.x = e[0] | (e[1] << 16); o.y = e[2] | (e[3] << 16); o.z = e[4] | (e[5] << 16); o.w = e[6] | (e[7] << 16);
            *(u32x4*)(vt + (size_t)((hb * 4 + hq) * 128 + dv) * SEQ + t0 + blk * 16 + hh * 8) = o; }
        __syncthreads();
    }
}

__device__ __forceinline__ void p2_phase(ArgP ap, LAS unsigned char* lds, int tid, int wid, int lane) {
    unsigned char* ws = ap->ws;
    const bf16_t* PROJ = (const bf16_t*)(ws + WS_PROJ);
    bf16_t* DQ = (bf16_t*)(ws + WS_DQ); bf16_t* DK = (bf16_t*)(ws + WS_DK); bf16_t* DVT = (bf16_t*)(ws + WS_DVT);
    bf16_t* CQN = (bf16_t*)(ws + WS_CQN); bf16_t* CKVN = (bf16_t*)(ws + WS_CKVN); bf16_t* KR = (bf16_t*)(ws + WS_KR);
    const float* dq_g = ap->in[5]; const float* dk_g = ap->in[6]; const float* qa_g = ap->in[12]; const float* kva_g = ap->in[14];
    for (int u = blockIdx.x; u < M / 64; u += gridDim.x) {
        const int tok0 = u * 64;
        for (int i0 = 0; i0 < 8; i0 += 4) {
          u32x4 va[4][4], vcq[4], vckv[4], vkr[4];
#pragma unroll
          for (int rr = 0; rr < 4; ++rr) { const bf16_t* p = PROJ + (size_t)(tok0 + wid * 8 + i0 + rr) * NIN;
#pragma unroll
              for (int j = 0; j < 4; ++j) va[rr][j] = *(const u32x4*)(p + (j >> 1) * 1024 + (j & 1) * 512 + lane * 8);
              vcq[rr] = *(const u32x4*)(p + 3072 + lane * 8); vckv[rr] = *(const u32x4*)(p + 3584 + (lane & 31) * 8); vkr[rr] = *(const u32x4*)(p + 3840 + (lane & 7) * 8); }
#pragma unroll
          for (int rr = 0; rr < 4; ++rr) {
            const int row = tok0 + wid * 8 + i0 + rr;
#pragma unroll
            for (int part = 0; part < 2; ++part) {
                const float* g = part ? dk_g : dq_g; const float sc = part ? 1.0f : QSCALE_A; bf16_t* dst = (part ? DK : DQ) + (size_t)row * 1024;
#pragma unroll
                for (int c = 0; c < 2; ++c) {
                    const u32x4 v = va[rr][part * 2 + c];
                    float f[8]; float ss = 0.f;
#pragma unroll
                    for (int q = 0; q < 4; ++q) { f[2 * q] = bf_lo(v[q]); f[2 * q + 1] = bf_hi(v[q]); ss += f[2 * q] * f[2 * q] + f[2 * q + 1] * f[2 * q + 1]; }
                    ss += __shfl_xor(ss, 1); ss += __shfl_xor(ss, 2); ss += __shfl_xor(ss, 4);
                    const float rstd = sc / sqrtf(ss * (1.0f / 64.0f) + EPS);
                    const float* gg = g + (lane & 7) * 8;
                    u32x4 o;
#pragma unroll
                    for (int q = 0; q < 4; ++q) o[q] = cvt_pk_bf16(f[2 * q] * rstd * gg[2 * q], f[2 * q + 1] * rstd * gg[2 * q + 1]);
                    *(u32x4*)(dst + c * 512 + lane * 8) = o;
                }
            }
            {
                const u32x4 v = vcq[rr]; float f[8]; float ss = 0.f;
#pragma unroll
                for (int q = 0; q < 4; ++q) { f[2 * q] = bf_lo(v[q]); f[2 * q + 1] = bf_hi(v[q]); ss += f[2 * q] * f[2 * q] + f[2 * q + 1] * f[2 * q + 1]; }
                const float rstd = 1.0f / sqrtf(wave_sum(ss) * (1.0f / 512.0f) + EPS); const float* gg = qa_g + lane * 8; u32x4 o;
#pragma unroll
                for (int q = 0; q < 4; ++q) o[q] = cvt_pk_bf16(f[2 * q] * rstd * gg[2 * q], f[2 * q + 1] * rstd * gg[2 * q + 1]);
                *(u32x4*)(CQN + (size_t)row * 512 + lane * 8) = o;
            }
            {
                const int l2 = lane & 31; const u32x4 v = vckv[rr]; float f[8]; float ss = 0.f;
#pragma unroll
                for (int q = 0; q < 4; ++q) { f[2 * q] = bf_lo(v[q]); f[2 * q + 1] = bf_hi(v[q]); ss += f[2 * q] * f[2 * q] + f[2 * q + 1] * f[2 * q + 1]; }
                if (lane >= 32) ss = 0.f;
                const float rstd = 1.0f / sqrtf(wave_sum(ss) * (1.0f / 256.0f) + EPS); const float* gg = kva_g + l2 * 8; u32x4 o;
#pragma unroll
                for (int q = 0; q < 4; ++q) o[q] = cvt_pk_bf16(f[2 * q] * rstd * gg[2 * q], f[2 * q + 1] * rstd * gg[2 * q + 1]);
                if (lane < 32) *(u32x4*)(CKVN + (size_t)row * 256 + l2 * 8) = o;
            }
            if (lane < 8) *(u32x4*)(KR + (size_t)row * 64 + lane * 8) = vkr[rr];
          }
        }
        const int b = tok0 / SEQ, t0 = tok0 % SEQ;
        vt_tile8(PROJ + (size_t)tok0 * NIN + 2048, NIN, 128, DVT + (size_t)(b * 8) * 128 * SEQ, t0, lds, tid);
    }
}

__device__ __forceinline__ float bfld(const bf16_t* p) { return __uint_as_float((unsigned)(*p) << 16); }
__device__ __forceinline__ void bfst(bf16_t* p, float v) { *p = (bf16_t)(cvt_pk_bf16(v, 0.f) & 0xffffu); }
__device__ __forceinline__ void p4_phase(ArgP ap, LAS unsigned char* lds, int tid, int wid, int lane) {
    unsigned char* ws = ap->ws;
    const bf16_t* QLAT = (const bf16_t*)(ws + WS_QLAT); const bf16_t* KVRAW = (const bf16_t*)(ws + WS_KVRAW); const bf16_t* KR = (const bf16_t*)(ws + WS_KR);
    bf16_t* MQ = (bf16_t*)((unsigned char*)ap->out + DO_MQ); bf16_t* MK = (bf16_t*)((unsigned char*)ap->out + DO_MK); bf16_t* MVT = (bf16_t*)((unsigned char*)ap->out + DO_MVT);
    const int* pos = (const int*)ap->in[1]; const float* mq_g = ap->in[16]; const float* mk_g = ap->in[17];
    const int l2 = lane & 31; const bool lo = lane < 32;
    const float inv_freq = __builtin_amdgcn_exp2f(-(float)l2 * 0.41524101186092029f);
    const float gq0 = mq_g[lane], gq1 = mq_g[64 + lane], gq2 = mq_g[128 + l2], gq3 = mq_g[160 + l2];
    const float gk0 = mk_g[lane], gk1 = mk_g[64 + lane], gk2 = mk_g[128 + l2], gk3 = mk_g[160 + l2];
    for (int u = blockIdx.x; u < M / 64; u += gridDim.x) {
        const int tok0 = u * 64;
        for (int i = 0; i < 8; i += 2) {
            float qe0[2][8], qe1[2][8], qx1[2][8], qx2[2][8], ke0[2][8], ke1[2][8], kr1[2], kr2[2], cs[2], sn[2];
#pragma unroll
            for (int t = 0; t < 2; ++t) {
                const int row = tok0 + wid * 8 + i + t;
                const float ang = (float)pos[row] * inv_freq;
                const double rev = (double)ang * 0.15915494309189535; const float fr = (float)(rev - floor(rev));
                cs[t] = __builtin_amdgcn_cosf(fr); sn[t] = __builtin_amdgcn_sinf(fr);
                kr1[t] = bfld(KR + (size_t)row * 64 + l2); kr2[t] = bfld(KR + (size_t)row * 64 + 32 + l2);
#pragma unroll
                for (int h = 0; h < 8; ++h) {
                    const bf16_t* sq = QLAT + (size_t)row * 1536 + h * 192; const bf16_t* sk = KVRAW + (size_t)row * 2048 + h * 256;
                    qe0[t][h] = bfld(sq + lane); qe1[t][h] = bfld(sq + 64 + lane); qx1[t][h] = bfld(sq + 128 + l2); qx2[t][h] = bfld(sq + 160 + l2);
                    ke0[t][h] = bfld(sk + lane); ke1[t][h] = bfld(sk + 64 + lane); }
            }
#pragma unroll
            for (int t = 0; t < 2; ++t) {
                const int row = tok0 + wid * 8 + i + t;
#pragma unroll
                for (int h = 0; h < 8; ++h) {
                    {
                        const float e0 = qe0[t][h], e1 = qe1[t][h], x1 = qx1[t][h], x2 = qx2[t][h];
                        float ss = e0 * e0 + e1 * e1 + (lo ? x1 * x1 + x2 * x2 : 0.f);
                        const float rstd = QSCALE_B / sqrtf(wave_sum(ss) * (1.0f / 192.0f) + EPS);
                        const float n1 = x1 * rstd * gq2, n2 = x2 * rstd * gq3;
                        bf16_t* d = MQ + (size_t)row * 1536 + h * 192;
                        bfst(d + lane, e0 * rstd * gq0); bfst(d + 64 + lane, e1 * rstd * gq1);
                        if (lo) { bfst(d + 128 + l2, n1 * cs[t] - n2 * sn[t]); bfst(d + 160 + l2, n2 * cs[t] + n1 * sn[t]); }
                    }
                    {
                        const float e0 = ke0[t][h], e1 = ke1[t][h];
                        float ss = e0 * e0 + e1 * e1 + (lo ? kr1[t] * kr1[t] + kr2[t] * kr2[t] : 0.f);
                        const float rstd = 1.0f / sqrtf(wave_sum(ss) * (1.0f / 192.0f) + EPS);
                        const float n1 = kr1[t] * rstd * gk2, n2 = kr2[t] * rstd * gk3;
                        bf16_t* d = MK + (size_t)row * 1536 + h * 192;
                        bfst(d + lane, e0 * rstd * gk0); bfst(d + 64 + lane, e1 * rstd * gk1);
                        if (lo) { bfst(d + 128 + l2, n1 * cs[t] - n2 * sn[t]); bfst(d + 160 + l2, n2 * cs[t] + n1 * sn[t]); }
                    }
                }
            }
        }
        const int b = tok0 / SEQ, t0 = tok0 % SEQ;
        vt_tile8(KVRAW + (size_t)tok0 * 2048 + 128, 2048, 256, MVT + (size_t)(b * 8) * 128 * SEQ, t0, lds, tid);
    }
}


constexpr size_t WS_CTL = 0, CTL_ZERO_BYTES = 262144, WS_SS = 65536;
constexpr int MISC_OFF = RING_BYTES + 320;
#define XB_TMO      128
#define XB_XCNT(j)  (256  + 64 * (j))
#define XB_XSUB(j)  (1280 + 64 * (j))
#define XB_XGEN(j)  (2304 + 64 * (j))
#define XB_TOP      3328
#define XB_TOPGEN   3392
#define XCD_BAR_WORDS 3456
#define XB_SPIN_CAP (1u << 18)

__device__ __forceinline__ unsigned xb_ld(unsigned* p)              { return __hip_atomic_load(p, __ATOMIC_RELAXED, __HIP_MEMORY_SCOPE_AGENT); }
__device__ __forceinline__ unsigned xb_add(unsigned* p, unsigned v) { return __hip_atomic_fetch_add(p, v, __ATOMIC_RELAXED, __HIP_MEMORY_SCOPE_AGENT); }
__device__ __forceinline__ unsigned xb_xcc_id() { return (unsigned)__builtin_amdgcn_s_getreg((3 << 11) | 20) & 0xFu; }
#define XB_SPIN(cond, bar) do { unsigned _sp = 0; while (cond) { __builtin_amdgcn_s_sleep(1); \
    if ((++_sp & 255u) == 0u) { if (xb_ld(&(bar)[XB_TMO])) break; if (_sp > XB_SPIN_CAP) { atomicAdd(&(bar)[XB_TMO], 1u); break; } } } } while (0)

struct XcdBarrier {
    unsigned* bar; unsigned x;
    volatile LAS unsigned* st;
};

__device__ __forceinline__ XcdBarrier xcd_barrier_post(unsigned* bar, volatile LAS unsigned* st) {
    XcdBarrier b; b.bar = bar; b.x = xb_xcc_id(); b.st = st;
    if (threadIdx.x == 0) (void)xb_add(&bar[XB_XCNT(b.x)], 1u);
    return b;
}
__device__ __forceinline__ void xcd_barrier_complete(unsigned* bar, unsigned x, unsigned& nloc, unsigned& nx) {
    const unsigned G = gridDim.x * gridDim.y * gridDim.z;
    unsigned sum, cnt, mine, sp = 0u;
    for (;;) {
        sum = 0u; cnt = 0u; mine = 0u;
#pragma unroll
        for (unsigned j = 0; j < 16; ++j) { const unsigned c = xb_ld(&bar[XB_XCNT(j)]); sum += c; cnt += (c > 0u) ? 1u : 0u; mine = (j == x) ? c : mine; }
        if (sum == G) break;
        __builtin_amdgcn_s_sleep(1);
        if ((++sp & 255u) == 0u) { if (xb_ld(&bar[XB_TMO])) break; if (sp > XB_SPIN_CAP) { atomicAdd(&bar[XB_TMO], 1u); break; } }
    }
    nloc = mine > 0u ? mine : 1u; nx = cnt > 0u ? cnt : 1u;
}

__device__ __forceinline__ void xcd_barrier(const XcdBarrier& b) {
    asm volatile("s_waitcnt vmcnt(0)" ::: "memory");
    __syncthreads();
    if (threadIdx.x == 0) {
        unsigned* bar = b.bar; asm volatile("" : "+s"(bar));
        __builtin_amdgcn_s_waitcnt(0);
        unsigned nloc = b.st[0], nx = b.st[1];
        if (nloc == 0u) { xcd_barrier_complete(bar, b.x, nloc, nx); b.st[0] = nloc; b.st[1] = nx; }
        const unsigned old = xb_add(&bar[XB_XSUB(b.x)], 1u);
        const unsigned gen = old / nloc;
        if (old + 1u == (gen + 1u) * nloc) {
            __builtin_amdgcn_fence(__ATOMIC_RELEASE, "agent");
            asm volatile("s_waitcnt vmcnt(0)" ::: "memory");
            const unsigned og = xb_add(&bar[XB_TOP], 1u);
            const unsigned tg = og / nx;
            if (og + 1u == (tg + 1u) * nx) xb_add(&bar[XB_TOPGEN], 1u);
            else XB_SPIN(xb_ld(&bar[XB_TOPGEN]) == tg, bar);
            __builtin_amdgcn_fence(__ATOMIC_ACQUIRE, "agent");
            xb_add(&bar[XB_XGEN(b.x)], 1u);
            asm volatile("s_waitcnt vmcnt(0)" ::: "memory");
        } else {
            XB_SPIN(xb_ld(&bar[XB_XGEN(b.x)]) == gen, bar);
            __builtin_amdgcn_fence(__ATOMIC_ACQUIRE, "agent");
            asm volatile("s_waitcnt vmcnt(0)" ::: "memory");
        }
    }
    __syncthreads();
}

#define MFMA32(a, b, c) __builtin_amdgcn_mfma_f32_32x32x16_bf16((a), (b), (c), 0, 0, 0)
template <bool DIFF>
__device__ __forceinline__ void attn_unit(LAS unsigned char* lds, const bf16_t* Qg, const bf16_t* Kg, const bf16_t* VTg, bf16_t* AO,
                                          const int* pos, const float* rel_table, const float* subln_g, float lam,
                                          int b, int h, int qb, int tid_in, int wid, int lane_in, bool fresh) {
    int tid = tid_in; asm volatile("" : "+v"(tid)); const int lane = tid & 63; (void)lane_in;
    constexpr int DKH = DIFF ? 64 : 192, KROW = DIFF ? 128 : 192, KSTR = KROW + 8, VSTR = 72;
    constexpr int K_BYTES = 64 * KSTR * 2, V_BYTES = 128 * VSTR * 2, BUF = K_BYTES + V_BYTES;
    constexpr int POS_OFF = 2 * BUF, LUT_OFF = POS_OFF + 8192, TMM_OFF = LUT_OFF + 1280;
    constexpr int ROWS = DIFF ? 128 : 256, QLD = DIFF ? 1024 : 1536, KLD = QLD, CPR = KROW / 8, NKC = (64 * CPR) / NTHREADS, NKS = DKH / 16;
    static_assert(TMM_OFF + 256 <= RING_BYTES, "attention LDS");
    const int r = lane & 31, hh = lane >> 5;
    const int rg = DIFF ? (wid >> 1) : wid, hf = DIFF ? (wid & 1) : 0;
    const int qrow = b * SEQ + qb * ROWS + rg * 32 + r;
    const bf16_t* Kb = Kg + (size_t)b * SEQ * KLD + h * KROW;
    const bf16_t* Vb = VTg + (size_t)(b * 8 + h) * 128 * SEQ;

    int pq4 = 0;
    if (DIFF) {
        LAS int* P4 = (LAS int*)(lds + POS_OFF); LAS float* LUT = (LAS float*)(lds + LUT_OFF);
        if (fresh) for (int i = tid; i < SEQ; i += NTHREADS) P4[i] = 4 * pos[b * SEQ + i];
        if (fresh && tid < 257) { const int rel = tid - 128, n = rel < 0 ? -rel : rel;
            const int large = 8 + (n >= 12) + (n >= 16) + (n >= 23) + (n >= 32) + (n >= 46) + (n >= 64) + (n >= 91);
            const int bucket = (rel > 0 ? 16 : 0) + (n < 8 ? n : (large < 15 ? large : 15));
            LUT[tid] = rel_table[bucket * 8 + h] * LOG2E; }
        pq4 = 4 * pos[qrow];
    }
    bf16x8 qf[NKS];
    { const bf16_t* qp = Qg + (size_t)qrow * QLD + h * KROW + hf * 64 + 8 * hh;
#pragma unroll
      for (int ks = 0; ks < NKS; ++ks) qf[ks] = *(const bf16x8*)(qp + 16 * ks); }

    u32x4 kreg[NKC], vreg[2];
    auto load_tile = [&](int kt) {
#pragma unroll
        for (int i = 0; i < NKC; ++i) { const int c = tid + i * NTHREADS, row = c / CPR, cc = c % CPR; kreg[i] = *(const u32x4*)(Kb + (size_t)(kt * 64 + row) * KLD + cc * 8); }
#pragma unroll
        for (int i = 0; i < 2; ++i) { const int c = tid + i * NTHREADS, dv = c >> 3, cc = c & 7; vreg[i] = *(const u32x4*)(Vb + (size_t)dv * SEQ + kt * 64 + cc * 8); }
    };
    auto store_tile = [&](int buf) {
        LAS unsigned char* kb_ = lds + buf * BUF; LAS unsigned char* vb_ = kb_ + K_BYTES;
#pragma unroll
        for (int i = 0; i < NKC; ++i) { const int c = tid + i * NTHREADS, row = c / CPR, cc = c % CPR; *(LAS u32x4*)(kb_ + (row * KSTR + cc * 8) * 2) = kreg[i]; }
#pragma unroll
        for (int i = 0; i < 2; ++i) { const int c = tid + i * NTHREADS, dv = c >> 3, cc = c & 7; *(LAS u32x4*)(vb_ + (dv * VSTR + cc * 8) * 2) = vreg[i]; }
    };
    load_tile(0); store_tile(0);
    __syncthreads();
    int qmin4 = 0, qmax4 = 0; float bias_lo = 0.f, bias_hi = 0.f;
    if (DIFF) {
        if (fresh && tid < SEQ / 64) { const LAS int* P4 = (const LAS int*)(lds + POS_OFF) + tid * 64; int mn = P4[0], mx_ = P4[0];
            for (int i = 1; i < 64; ++i) { const int v = P4[i]; mn = v < mn ? v : mn; mx_ = v > mx_ ? v : mx_; }
            ((LAS int*)(lds + TMM_OFF))[2 * tid] = mn; ((LAS int*)(lds + TMM_OFF))[2 * tid + 1] = mx_; }
        qmin4 = pq4; qmax4 = pq4;
#pragma unroll
        for (int o = 1; o < 64; o <<= 1) { const int a_ = __shfl_xor(qmin4, o), b_ = __shfl_xor(qmax4, o); qmin4 = a_ < qmin4 ? a_ : qmin4; qmax4 = b_ > qmax4 ? b_ : qmax4; }
        bias_lo = *(const LAS float*)(lds + LUT_OFF);
        bias_hi = *(const LAS float*)(lds + LUT_OFF + 1024);
        __syncthreads();
    }

    f32x16 O[4];
#pragma unroll
    for (int d = 0; d < 4; ++d)
#pragma unroll
        for (int i = 0; i < 16; ++i) O[d][i] = 0.f;
    float m_used = -INFINITY, lsum = 0.f;

    for (int kt = 0; kt < SEQ / 64; ++kt) {
        const bool more = kt + 1 < SEQ / 64;
        if (more) load_tile(kt + 1);
        LAS unsigned char* kbuf = lds + (kt & 1) * BUF; LAS unsigned char* vbuf = kbuf + K_BYTES;
        f32x16 s[2];
        if (DIFF) {
            const int tmn = ((const LAS int*)(lds + TMM_OFF))[2 * kt], tmx = ((const LAS int*)(lds + TMM_OFF))[2 * kt + 1];
            const bool far_hi = __builtin_amdgcn_readfirstlane(tmn - qmax4) >= 512, far_lo = __builtin_amdgcn_readfirstlane(tmx - qmin4) <= -512;
            if (far_hi || far_lo) {
                const float cb = far_hi ? bias_hi : bias_lo;
#pragma unroll
                for (int kb = 0; kb < 2; ++kb)
#pragma unroll
                    for (int i = 0; i < 16; ++i) s[kb][i] = cb;
            } else {
#pragma unroll
                for (int kb = 0; kb < 2; ++kb) {
                    const LAS int* P4 = (const LAS int*)(lds + POS_OFF) + kt * 64 + 32 * kb + 4 * hh;
#pragma unroll
                    for (int g = 0; g < 4; ++g) { const i32x4 pk = *(const LAS i32x4*)(P4 + 8 * g);
#pragma unroll
                        for (int j = 0; j < 4; ++j) { int d = pk[j] - pq4; d = d < -512 ? -512 : (d > 512 ? 512 : d); s[kb][4 * g + j] = *(const LAS float*)(lds + LUT_OFF + 512 + d); } }
                }
            }
        } else {
#pragma unroll
            for (int kb = 0; kb < 2; ++kb)
#pragma unroll
                for (int i = 0; i < 16; ++i) s[kb][i] = 0.f;
        }
        {
            const LAS unsigned char* kp0 = kbuf + (r * KSTR + hf * 64 + 8 * hh) * 2; const LAS unsigned char* kp1 = kp0 + 32 * KSTR * 2;
#pragma unroll
            for (int ks = 0; ks < NKS; ++ks) { const bf16x8 kf0 = *(const LAS bf16x8*)(kp0 + 32 * ks), kf1 = *(const LAS bf16x8*)(kp1 + 32 * ks);
                s[0] = MFMA32(kf0, qf[ks], s[0]); s[1] = MFMA32(kf1, qf[ks], s[1]); }
        }
        float mx = s[0][0];
#pragma unroll
        for (int i = 1; i < 16; ++i) mx = fmaxf(mx, s[0][i]);
#pragma unroll
        for (int i = 0; i < 16; ++i) mx = fmaxf(mx, s[1][i]);
        mx = fmaxf(mx, __shfl_xor(mx, 32));
        const bool need = mx > m_used + 8.0f;
        if (__builtin_amdgcn_ballot_w64(need) != 0ull) {
            const float m_new = need ? mx : m_used;
            const float alpha = __builtin_amdgcn_exp2f(m_used - m_new);
            lsum *= alpha;
#pragma unroll
            for (int d = 0; d < 4; ++d) O[d] = O[d] * alpha;
            m_used = m_new;
        }
#pragma unroll
        for (int kb = 0; kb < 2; ++kb)
#pragma unroll
            for (int i = 0; i < 16; ++i) { const float p = __builtin_amdgcn_exp2f(s[kb][i] - m_used); s[kb][i] = p; lsum += p; }
#pragma unroll
        for (int kb = 0; kb < 2; ++kb)
#pragma unroll
            for (int st = 0; st < 2; ++st) {
                u32x4 pw;
#pragma unroll
                for (int q = 0; q < 4; ++q) pw[q] = cvt_pk_bf16(s[kb][8 * st + 2 * q], s[kb][8 * st + 2 * q + 1]);
                const bf16x8 pf = __builtin_bit_cast(bf16x8, pw);
                const LAS unsigned char* vp = vbuf + (r * VSTR + (2 * kb + st) * 16 + 8 * hh) * 2;
#pragma unroll
                for (int d = 0; d < 4; ++d) { const bf16x8 vf = *(const LAS bf16x8*)(vp + d * 32 * VSTR * 2); O[d] = MFMA32(vf, pf, O[d]); }
            }
        if (more) store_tile((kt + 1) & 1);
        __syncthreads();
    }
    const float ltot = lsum + __shfl_xor(lsum, 32);
    const float inv = 1.0f / ltot;
    if (DIFF) {
        LAS float* XO = (LAS float*)lds + (size_t)rg * 64 * 64 + lane;
        if (hf == 1) {
#pragma unroll
            for (int d = 0; d < 4; ++d)
#pragma unroll
                for (int i = 0; i < 16; ++i) XO[(d * 16 + i) * 64] = O[d][i] * inv;
        }
        __syncthreads();
        if (hf == 0) {
            float ss = 0.f;
#pragma unroll
            for (int d = 0; d < 4; ++d)
#pragma unroll
                for (int i = 0; i < 16; ++i) { const float o = O[d][i] * inv - lam * XO[(d * 16 + i) * 64]; O[d][i] = o; ss += o * o; }
            ss += __shfl_xor(ss, 32);
            const float rstd = (1.0f - LAM_INIT) / sqrtf(ss * (1.0f / 128.0f) + EPS);
            bf16_t* op = AO + (size_t)qrow * 2048 + h * 128 + 4 * hh;
#pragma unroll
            for (int d = 0; d < 4; ++d)
#pragma unroll
                for (int g = 0; g < 4; ++g) { const f32x4 gg = *(const f32x4*)(subln_g + 32 * d + 8 * g + 4 * hh);
                    u32x2 w; w.x = cvt_pk_bf16(O[d][4 * g] * rstd * gg.x, O[d][4 * g + 1] * rstd * gg.y); w.y = cvt_pk_bf16(O[d][4 * g + 2] * rstd * gg.z, O[d][4 * g + 3] * rstd * gg.w);
                    *(u32x2*)(op + 32 * d + 8 * g) = w; }
        }
        __syncthreads();
    } else {
        bf16_t* op = AO + (size_t)qrow * 2048 + 1024 + h * 128 + 4 * hh;
#pragma unroll
        for (int d = 0; d < 4; ++d)
#pragma unroll
            for (int g = 0; g < 4; ++g) { u32x2 w; w.x = cvt_pk_bf16(O[d][4 * g] * inv, O[d][4 * g + 1] * inv); w.y = cvt_pk_bf16(O[d][4 * g + 2] * inv, O[d][4 * g + 3] * inv);
                *(u32x2*)(op + 32 * d + 8 * g) = w; }
    }
}

__device__ __forceinline__ void attn_phase_mla(ArgP ap, LAS unsigned char* lds, int tid, int wid, int lane) {
    const bf16_t* MQ = (const bf16_t*)((unsigned char*)ap->out + DO_MQ); const bf16_t* MK = (const bf16_t*)((unsigned char*)ap->out + DO_MK); const bf16_t* MVT = (const bf16_t*)((unsigned char*)ap->out + DO_MVT);
    bf16_t* AO = (bf16_t*)(ap->ws + WS_AO);
    const int G = gridDim.x, bx = blockIdx.x, v = (G % 8 == 0) ? (bx % 8) * (G / 8) + bx / 8 : bx;
    const bool fast = (512 % G == 0); const int per = fast ? 512 / G : 0;
    for (int i = 0; ; ++i) { int u; if (fast) { if (i >= per) break; u = v * per + i; } else { u = bx + i * G; if (u >= 512) break; }
        const int qb = u & 7, h = (u >> 3) & 7, b = u >> 6;
        attn_unit<false>(lds, MQ, MK, MVT, AO, nullptr, nullptr, nullptr, 0.f, b, h, qb, tid, wid, lane, true); }
}
__device__ __forceinline__ void attn_phase_diff(ArgP ap, LAS unsigned char* lds, int tid, int wid, int lane) {
    unsigned char* ws = ap->ws;
    const bf16_t* DQ = (const bf16_t*)(ws + WS_DQ); const bf16_t* DK = (const bf16_t*)(ws + WS_DK); const bf16_t* DVT = (const bf16_t*)(ws + WS_DVT);
    bf16_t* AO = (bf16_t*)(ws + WS_AO);
    const int* pos = (const int*)ap->in[1];
    float d1 = 0.f, d2 = 0.f;
    { const float q1 = ap->in[7][lane], k1 = ap->in[8][lane], q2 = ap->in[9][lane], k2 = ap->in[10][lane]; d1 = wave_sum(q1 * k1); d2 = wave_sum(q2 * k2); }
    const float lam = expf(d1) - expf(d2) + LAM_INIT;
    const int G = gridDim.x, bx = blockIdx.x, v = (G % 8 == 0) ? (bx % 8) * (G / 8) + bx / 8 : bx;
    const bool fast = (1024 % G == 0 && 1024 / G <= 16 && 16 % (1024 / G) == 0); const int per = fast ? 1024 / G : 0;
    for (int i = 0; ; ++i) { int u; bool fresh; if (fast) { if (i >= per) break; u = v * per + i; fresh = (i == 0); } else { u = bx + i * G; if (u >= 1024) break; fresh = true; }
        const int qb = u & 15, h = (u >> 4) & 7, b = u >> 7;
        attn_unit<true>(lds, DQ, DK, DVT, AO, pos, ap->in[2], ap->in[11], lam, b, h, qb, tid, wid, lane, fresh); }
}

__global__ void __launch_bounds__(NTHREADS, 2) fwd_megakernel(Args a) {
    extern __shared__ __attribute__((aligned(16))) unsigned char lds_raw[];
    LAS unsigned char* lds = (LAS unsigned char*)lds_raw;
    cg::grid_group grid = cg::this_grid();
    if (gridDim.x == 0x7fffffffu) grid.sync();
    { int t_ = threadIdx.x; if (t_ < 32) ((volatile LAS unsigned*)(lds + MISC_OFF))[t_] = 0u; }
    __syncthreads();
    XcdBarrier bar;
    { ArgP ap0 = (ArgP)__builtin_amdgcn_kernarg_segment_ptr(); bar = xcd_barrier_post((unsigned*)(ap0->ws + WS_CTL), (volatile LAS unsigned*)(lds + MISC_OFF) + 8); }
#define ARGP() ArgP ap = (ArgP)__builtin_amdgcn_kernarg_segment_ptr(); asm volatile("" : "+s"(ap)); unsigned char* ws = ap->ws; (void)ws; bf16_t* H = (bf16_t*)(ws + WS_H); bf16_t* WG = (bf16_t*)(ws + WS_WGATE); bf16_t* WU = (bf16_t*)(ws + WS_WUP); bf16_t* WD = (bf16_t*)(ws + WS_WDOWN); (void)H; (void)WG; (void)WU; (void)WD;
#define FRESH_IDS() int tid = threadIdx.x; asm volatile("" : "+v"(tid)); const int lane = tid & 63, wid = __builtin_amdgcn_readfirstlane(tid >> 6); const int gw = blockIdx.x * NWAVES + wid; (void)gw; (void)lane;
    const int G = gridDim.x, NGW = G * NWAVES;
    typedef pg8::StaticOrder SO;

#ifndef PH_MASK
#define PH_MASK 0xffffffffu
#endif
#define PH(k) if ((PH_MASK >> (k)) & 1u)
    PH(0) { FRESH_IDS(); ARGP(); LAS float* scr = (LAS float*)(lds + wid * 16384);
    transpose_weight<0>(ap->in[4], DM, NIN, (bf16_t*)(ws + WS_WIN), scr, gw, NGW, lane);
    transpose_weight<0>(ap->in[13], 512, 1536, (bf16_t*)(ws + WS_WUQ), scr, gw, NGW, lane);
    transpose_weight<0>(ap->in[15], 256, 2048, (bf16_t*)(ws + WS_WUKV), scr, gw, NGW, lane);
    transpose_weight<0>(ap->in[18], DM, DM, (bf16_t*)(ws + WS_WOUT), scr, gw, NGW, lane);
    transpose_weight<0>(ap->in[24], DM, DFF, WG, scr, gw, NGW, lane, ap->in[23]);
    transpose_weight<0>(ap->in[25], DM, DFF, WU, scr, gw, NGW, lane, ap->in[23]);
    transpose_weight<0>(ap->in[28], DFF, DM, WD, scr, gw, NGW, lane);
    rms_phase(ap->in[0], ap->in[3], H, gw, NGW, lane); }
    xcd_barrier(bar);
    PH(1) { ARGP(); pg8::Gemm g{H, (const bf16_t*)(ws + WS_WIN), M, NIN_PAD, DM}; SO S; S.init(M, NIN_PAD, G, (int)blockIdx.x);
      pg8::EpiStoreBf16 E{(bf16_t*)(ws + WS_PROJ), NIN, NIN, nullptr};
      pg8::gemm_phase<pg8::EpiStoreBf16, SO, true, true>(lds, g, S, E); }
    xcd_barrier(bar);
    PH(2) { FRESH_IDS(); ARGP(); p2_phase(ap, lds, tid, wid, lane); }
    xcd_barrier(bar);
    PH(3) { ARGP(); pg8::Gemm g{(const bf16_t*)(ws + WS_CQN), (const bf16_t*)(ws + WS_WUQ), M, 1536, 512}; SO S; S.init(M, 1536, G, (int)blockIdx.x);
      pg8::EpiStoreBf16 E{(bf16_t*)(ws + WS_QLAT), 1536, 1536, nullptr};
      pg8::gemm_phase<pg8::EpiStoreBf16, SO, true, true>(lds, g, S, E); }
    PH(3) { ARGP(); pg8::Gemm g{(const bf16_t*)(ws + WS_CKVN), (const bf16_t*)(ws + WS_WUKV), M, 2048, 256}; SO S; S.init(M, 2048, G, (int)blockIdx.x);
      pg8::EpiStoreBf16 E{(bf16_t*)(ws + WS_KVRAW), 2048, 2048, nullptr};
      pg8::gemm_phase<pg8::EpiStoreBf16, SO, true, true>(lds, g, S, E); }
    xcd_barrier(bar);
    PH(4) { FRESH_IDS(); ARGP(); p4_phase(ap, lds, tid, wid, lane); }
    xcd_barrier(bar);
    PH(5) { FRESH_IDS(); ARGP(); attn_phase_mla(ap, lds, tid, wid, lane); }
    PH(5) { FRESH_IDS(); ARGP(); attn_phase_diff(ap, lds, tid, wid, lane); }
    xcd_barrier(bar);
    PH(6) { ARGP(); pg8::Gemm g{(const bf16_t*)(ws + WS_AO), (const bf16_t*)(ws + WS_WOUT), M, DM, DM}; SO S; S.init(M, DM, G, (int)blockIdx.x);
      pg8::EpiResidF32 E{ap->in[0], ap->out, DM, H, (float*)(ws + WS_SS)};
      pg8::gemm_phase<pg8::EpiResidF32, SO, true, true>(lds, g, S, E); }
    xcd_barrier(bar);
    {
        if (0 == 1) {
            PH(7) { FRESH_IDS(); ARGP(); LAS float* scr = (LAS float*)(lds + wid * 16384);
            transpose_weight<1>(ap->in[20], DM, 3 * DM, (bf16_t*)(ws + WS_WCIN), scr, gw, NGW, lane, ap->in[19]);
            transpose_weight<0>(ap->in[22], DM, DM, (bf16_t*)(ws + WS_WCOUT), scr, gw, NGW, lane);
            transpose_weight<0>(ap->in[24] + (size_t)DM * DFF, DM, DFF, WG, scr, gw, NGW, lane, ap->in[23] + DM);
            transpose_weight<0>(ap->in[25] + (size_t)DM * DFF, DM, DFF, WU, scr, gw, NGW, lane, ap->in[23] + DM);
            transpose_weight<0>(ap->in[28] + (size_t)DM * DFF, DFF, DM, WD, scr, gw, NGW, lane); }
            xcd_barrier(bar);
            PH(8) { ARGP(); pg8::Gemm g{H, (const bf16_t*)(ws + WS_WCIN), M, 2 * DM, DM}; SO S; S.init(M, 2 * DM, G, (int)blockIdx.x);
              pg8::EpiMulBf16 E{(bf16_t*)(ws + WS_P), DM, (const float*)(ws + WS_SS) + M};
              pg8::gemm_phase<pg8::EpiMulBf16, SO, true, true>(lds, g, S, E); }
            xcd_barrier(bar);
            PH(9) { ARGP(); pg8::Gemm g{H, (const bf16_t*)(ws + WS_WCIN) + (size_t)2 * DM * DM, M, DM, DM}; SO S; S.init(M, DM, G, (int)blockIdx.x);
              pg8::EpiConvGate<false> E{(const bf16_t*)(ws + WS_P), ap->in[21], nullptr, (bf16_t*)(ws + WS_Z), DM, SEQ, (const float*)(ws + WS_SS) + M};
              pg8::gemm_phase<pg8::EpiConvGate<false>, SO, true, true>(lds, g, S, E); }
            xcd_barrier(bar);
            PH(10) { ARGP(); pg8::Gemm g{(const bf16_t*)(ws + WS_Z), (const bf16_t*)(ws + WS_WCOUT), M, DM, DM}; SO S; S.init(M, DM, G, (int)blockIdx.x);
              pg8::EpiResidF32 E{ap->out, ap->out, DM, H, (float*)(ws + WS_SS) + 2 * M};
              pg8::gemm_phase<pg8::EpiResidF32, SO, true, true>(lds, g, S, E); }
            xcd_barrier(bar);
        }
        constexpr int NA = 20 * 256, NR = 2 * 256;
        PH(12) { ARGP(); pg8::Gemm g{H, WG, M, NA, DM}; SO S; S.init(M, NA, G, (int)blockIdx.x);
          pg8::EpiStoreBf16 E{(bf16_t*)(ws + WS_G), DFF, NA, (const float*)(ws + WS_SS) + (0 ? 2 * M : 0)};
          pg8::gemm_phase<pg8::EpiStoreBf16, SO, true, true>(lds, g, S, E); }
        xcd_barrier(bar);
        PH(12) { ARGP(); const int half = G / 2; const float* ssp = (const float*)(ws + WS_SS) + (0 ? 2 * M : 0);
          if ((int)blockIdx.x < half) {
            pg8::Gemm g{H, WG + (size_t)NA * DM, M, NR, DM}; pg8::SubsetOrder S{(M / 256) * 2, 2, half, (int)blockIdx.x};
            pg8::EpiStoreBf16 E{(bf16_t*)(ws + WS_G) + NA, DFF, NR, ssp};
            pg8::gemm_phase<pg8::EpiStoreBf16, pg8::SubsetOrder, true, true>(lds, g, S, E);
          } else {
            pg8::Gemm g{H, WU, M, NR, DM}; pg8::SubsetOrder S{(M / 256) * 2, 2, G - half, (int)blockIdx.x - half};
            pg8::EpiConvGate<true> E{(const bf16_t*)(ws + WS_G), ap->in[26] + (size_t)0 * 3 * DFF, ap->in[27] + (size_t)0 * DFF, (bf16_t*)(ws + WS_ACT), DFF, SEQ, ssp};
            pg8::gemm_phase<pg8::EpiConvGate<true>, pg8::SubsetOrder, true, true>(lds, g, S, E);
          } }
        xcd_barrier(bar);
        PH(13) { ARGP(); pg8::Gemm g{H, WU + (size_t)NR * DM, M, NA, DM}; SO S; S.init(M, NA, G, (int)blockIdx.x);
          pg8::EpiConvGate<true> E{(const bf16_t*)(ws + WS_G) + NR, ap->in[26] + (size_t)0 * 3 * DFF + NR, ap->in[27] + (size_t)0 * DFF + NR, (bf16_t*)(ws + WS_ACT) + NR, DFF, SEQ, (const float*)(ws + WS_SS) + (0 ? 2 * M : 0)};
          pg8::gemm_phase<pg8::EpiConvGate<true>, SO, true, true>(lds, g, S, E); }
        xcd_barrier(bar);
        PH(14) { ARGP(); pg8::Gemm g{(const bf16_t*)(ws + WS_ACT), WD, M, DM, DFF}; SO S; S.init(M, DM, G, (int)blockIdx.x);
          pg8::EpiResidF32 E{ap->out, ap->out, DM, 0 ? (bf16_t*)nullptr : H, (float*)(ws + WS_SS) + M};
          pg8::gemm_phase<pg8::EpiResidF32, SO, true, true>(lds, g, S, E); }
        if (0 == 0) xcd_barrier(bar);
    }
    {
        if (1 == 1) {
            PH(7) { FRESH_IDS(); ARGP(); LAS float* scr = (LAS float*)(lds + wid * 16384);
            transpose_weight<1>(ap->in[20], DM, 3 * DM, (bf16_t*)(ws + WS_WCIN), scr, gw, NGW, lane, ap->in[19]);
            transpose_weight<0>(ap->in[22], DM, DM, (bf16_t*)(ws + WS_WCOUT), scr, gw, NGW, lane);
            transpose_weight<0>(ap->in[24] + (size_t)DM * DFF, DM, DFF, WG, scr, gw, NGW, lane, ap->in[23] + DM);
            transpose_weight<0>(ap->in[25] + (size_t)DM * DFF, DM, DFF, WU, scr, gw, NGW, lane, ap->in[23] + DM);
            transpose_weight<0>(ap->in[28] + (size_t)DM * DFF, DFF, DM, WD, scr, gw, NGW, lane); }
            xcd_barrier(bar);
            PH(8) { ARGP(); pg8::Gemm g{H, (const bf16_t*)(ws + WS_WCIN), M, 2 * DM, DM}; SO S; S.init(M, 2 * DM, G, (int)blockIdx.x);
              pg8::EpiMulBf16 E{(bf16_t*)(ws + WS_P), DM, (const float*)(ws + WS_SS) + M};
              pg8::gemm_phase<pg8::EpiMulBf16, SO, true, true>(lds, g, S, E); }
            xcd_barrier(bar);
            PH(9) { ARGP(); pg8::Gemm g{H, (const bf16_t*)(ws + WS_WCIN) + (size_t)2 * DM * DM, M, DM, DM}; SO S; S.init(M, DM, G, (int)blockIdx.x);
              pg8::EpiConvGate<false> E{(const bf16_t*)(ws + WS_P), ap->in[21], nullptr, (bf16_t*)(ws + WS_Z), DM, SEQ, (const float*)(ws + WS_SS) + M};
              pg8::gemm_phase<pg8::EpiConvGate<false>, SO, true, true>(lds, g, S, E); }
            xcd_barrier(bar);
            PH(10) { ARGP(); pg8::Gemm g{(const bf16_t*)(ws + WS_Z), (const bf16_t*)(ws + WS_WCOUT), M, DM, DM}; SO S; S.init(M, DM, G, (int)blockIdx.x);
              pg8::EpiResidF32 E{ap->out, ap->out, DM, H, (float*)(ws + WS_SS) + 2 * M};
              pg8::gemm_phase<pg8::EpiResidF32, SO, true, true>(lds, g, S, E); }
            xcd_barrier(bar);
        }
        constexpr int NA = 20 * 256, NR = 2 * 256;
        PH(12) { ARGP(); pg8::Gemm g{H, WG, M, NA, DM}; SO S; S.init(M, NA, G, (int)blockIdx.x);
          pg8::EpiStoreBf16 E{(bf16_t*)(ws + WS_G), DFF, NA, (const float*)(ws + WS_SS) + (1 ? 2 * M : 0)};
          pg8::gemm_phase<pg8::EpiStoreBf16, SO, true, true>(lds, g, S, E); }
        xcd_barrier(bar);
        PH(12) { ARGP(); const int half = G / 2; const float* ssp = (const float*)(ws + WS_SS) + (1 ? 2 * M : 0);
          if ((int)blockIdx.x < half) {
            pg8::Gemm g{H, WG + (size_t)NA * DM, M, NR, DM}; pg8::SubsetOrder S{(M / 256) * 2, 2, half, (int)blockIdx.x};
            pg8::EpiStoreBf16 E{(bf16_t*)(ws + WS_G) + NA, DFF, NR, ssp};
            pg8::gemm_phase<pg8::EpiStoreBf16, pg8::SubsetOrder, true, true>(lds, g, S, E);
          } else {
            pg8::Gemm g{H, WU, M, NR, DM}; pg8::SubsetOrder S{(M / 256) * 2, 2, G - half, (int)blockIdx.x - half};
            pg8::EpiConvGate<true> E{(const bf16_t*)(ws + WS_G), ap->in[26] + (size_t)1 * 3 * DFF, ap->in[27] + (size_t)1 * DFF, (bf16_t*)(ws + WS_ACT), DFF, SEQ, ssp};
            pg8::gemm_phase<pg8::EpiConvGate<true>, pg8::SubsetOrder, true, true>(lds, g, S, E);
          } }
        xcd_barrier(bar);
        PH(13) { ARGP(); pg8::Gemm g{H, WU + (size_t)NR * DM, M, NA, DM}; SO S; S.init(M, NA, G, (int)blockIdx.x);
          pg8::EpiConvGate<true> E{(const bf16_t*)(ws + WS_G) + NR, ap->in[26] + (size_t)1 * 3 * DFF + NR, ap->in[27] + (size_t)1 * DFF + NR, (bf16_t*)(ws + WS_ACT) + NR, DFF, SEQ, (const float*)(ws + WS_SS) + (1 ? 2 * M : 0)};
          pg8::gemm_phase<pg8::EpiConvGate<true>, SO, true, true>(lds, g, S, E); }
        xcd_barrier(bar);
        PH(14) { ARGP(); pg8::Gemm g{(const bf16_t*)(ws + WS_ACT), WD, M, DM, DFF}; SO S; S.init(M, DM, G, (int)blockIdx.x);
          pg8::EpiResidF32 E{ap->out, ap->out, DM, 1 ? (bf16_t*)nullptr : H, (float*)(ws + WS_SS) + M};
          pg8::gemm_phase<pg8::EpiResidF32, SO, true, true>(lds, g, S, E); }
        if (1 == 0) xcd_barrier(bar);
    }
}

extern "C" void kernel_launch(void* const* d_in, const int* in_sizes, int n_in, void* d_out, int out_size, void* d_ws, size_t ws_size, hipStream_t stream) {
    static int grid = 0;
    if (grid == 0) {
        if (n_in != 29 || out_size != M * DM || ws_size < WS_END) { fprintf(stderr, "kernel_launch: unexpected shapes n_in %d out %d ws %zu (need %zu)\n", n_in, out_size, ws_size, (size_t)WS_END); grid = -1; return; }
        int dev = 0, cus = 0, per_cu = 0;
        hipGetDevice(&dev); hipDeviceGetAttribute(&cus, hipDeviceAttributeMultiprocessorCount, dev);
        hipFuncSetAttribute((const void*)fwd_megakernel, hipFuncAttributeMaxDynamicSharedMemorySize, LDS_BYTES);
        hipOccupancyMaxActiveBlocksPerMultiprocessor(&per_cu, (const void*)fwd_megakernel, NTHREADS, LDS_BYTES);
        if (per_cu < 1) { fprintf(stderr, "kernel_launch: occupancy query says %d blocks/CU\n", per_cu); per_cu = 1; }
        (void)hipGetLastError();
        grid = cus * per_cu;
    }
    if (grid < 0) return;
    if (hipMemsetAsync((char*)d_ws + WS_CTL, 0, CTL_ZERO_BYTES, stream) != hipSuccess) { fprintf(stderr, "kernel_launch: memset failed\n"); return; }
    Args a{};
    for (int i = 0; i < 29; ++i) a.in[i] = (const float*)d_in[i];
    a.out = (float*)d_out; a.ws = (unsigned char*)d_ws;
    void* args[] = {&a};
    hipError_t e = hipLaunchCooperativeKernel((const void*)fwd_megakernel, dim3(grid), dim3(NTHREADS), args, LDS_BYTES, stream);
    if (e != hipSuccess) fprintf(stderr, "cooperative launch failed: %s (grid %d)\n", hipGetErrorString(e), grid);
}
```
